# Optimizing an MI355X kernel written in HIP

```python
import jax, jax.numpy as jnp
from jax import lax
import numpy as np

D_MODEL = 2048
BATCH = 4
SEQ = 4096
DEPTH = 1

N_META = 16
BLOCK = 128
HEAD_DIM = 64
ATTN_HEADS = D_MODEL // 128
ATTN_WIDTH = ATTN_HEADS * HEAD_DIM
SSM_HEAD_DIM = 64
SSM_HEADS = D_MODEL // 64
SSM_WIDTH = SSM_HEADS * SSM_HEAD_DIM
SSM_GROUPS = 4
SSM_STATE = 128
CONV_WIDTH = 4
CONV_CH = SSM_WIDTH + 2 * SSM_GROUPS * SSM_STATE
MIX_WIDTH = ATTN_WIDTH + SSM_WIDTH
IN_COLS = 3 * ATTN_WIDTH + ATTN_HEADS + SSM_WIDTH + CONV_CH + SSM_HEADS
N_EXPERTS = 32
TOP_K = 4
D_FF = D_MODEL
SWIGLU_LIMIT = 7.0
SWIGLU_ALPHA = 1.702
EPS = 1e-5

kernel_name = "hymba_fox_ssd_moe_block"


def rms_norm(x, g):
    xf = x.astype(jnp.float32)
    y = xf * lax.rsqrt(jnp.mean(xf * xf, axis=-1, keepdims=True) + EPS)
    return (y * g.astype(jnp.float32)).astype(x.dtype)


def forgetting_attention(q, k, v, log_f):
    L = q.shape[1]
    c = jnp.cumsum(log_f, axis=1).transpose(0, 2, 1)
    scale = HEAD_DIM ** -0.5
    bounds = [(0, N_META)] + [(N_META + i * BLOCK, N_META + (i + 1) * BLOCK)
                              for i in range((L - N_META) // BLOCK)]
    outs = []
    for q0, q1 in bounds:
        s = jnp.einsum('bqhd,bkhd->bhqk', q[:, q0:q1], k[:, :q1]).astype(jnp.float32) * scale
        bias = c[:, :, q0:q1, None] - c[:, :, None, :q1]
        causal = jnp.arange(q0, q1)[:, None] >= jnp.arange(q1)[None, :]
        p = jax.nn.softmax(jnp.where(causal, s + bias, -jnp.inf), axis=-1)
        outs.append(jnp.einsum('bhqk,bkhd->bqhd', p.astype(v.dtype), v[:, :q1]))
    return jnp.concatenate(outs, axis=1)


def causal_depthwise_conv(x, w, b):
    K = w.shape[0]
    L = x.shape[1]
    xp = jnp.pad(x, ((0, 0), (K - 1, 0), (0, 0)))
    out = w[0] * xp[:, 0:L]
    for kk in range(1, K):
        out = out + w[kk] * xp[:, kk:kk + L]
    return out + b


def ssd_chunked(xs, a, Bm, Cm):
    b, Lp, H, P = xs.shape
    G, N = Bm.shape[2], Bm.shape[3]
    nc, hg = Lp // BLOCK, H // G
    xs = xs.reshape(b, nc, BLOCK, G, hg, P)
    a = a.reshape(b, nc, BLOCK, G, hg).transpose(0, 3, 4, 1, 2)
    Bm = Bm.reshape(b, nc, BLOCK, G, N)
    Cm = Cm.reshape(b, nc, BLOCK, G, N)
    a_cs = jnp.cumsum(a, axis=-1)
    li = jnp.arange(BLOCK)
    tri = li[:, None] >= li[None, :]
    seg = a_cs[..., :, None] - a_cs[..., None, :]
    decay = jnp.exp(jnp.where(tri, seg, -jnp.inf))
    cb = jnp.einsum('bclgn,bcsgn->bgcls', Cm, Bm)
    m = cb[:, :, None] * decay
    y_diag = jnp.einsum('bghcls,bcsghp->bclghp', m, xs)
    decay_states = jnp.exp(a_cs[..., -1:] - a_cs)
    states = jnp.einsum('bclgn,bghcl,bclghp->bcghpn', Bm, decay_states, xs)
    chunk_sum = a_cs[..., -1]
    incl = jnp.cumsum(chunk_sum, axis=-1)
    excl = incl - chunk_sum
    zi = jnp.arange(nc)
    before = zi[:, None] > zi[None, :]
    dec = jnp.exp(jnp.where(before, excl[..., :, None] - incl[..., None, :], -jnp.inf))
    prev_states = jnp.einsum('bghzc,bcghpn->bzghpn', dec, states)
    y_off = jnp.einsum('bclgn,bcghpn,bghcl->bclghp', Cm, prev_states, jnp.exp(a_cs))
    return (y_diag + y_off).reshape(b, Lp, H, P)


def ssd_mixer(z, xbc, dt_raw, conv_w, conv_b, dt_bias, a_log, d_skip, norm_g):
    b, L, _ = z.shape
    xbc = jax.nn.silu(causal_depthwise_conv(xbc, conv_w, conv_b))
    xs, Bm, Cm = jnp.split(xbc, [SSM_WIDTH, SSM_WIDTH + SSM_GROUPS * SSM_STATE], axis=-1)
    xs = xs.reshape(b, L, SSM_HEADS, SSM_HEAD_DIM)
    Bm = Bm.reshape(b, L, SSM_GROUPS, SSM_STATE).astype(jnp.float32)
    Cm = Cm.reshape(b, L, SSM_GROUPS, SSM_STATE).astype(jnp.float32)
    dt = jax.nn.softplus(dt_raw.astype(jnp.float32) + dt_bias.astype(jnp.float32))
    A = -jnp.exp(a_log.astype(jnp.float32))
    pad = BLOCK - N_META
    def lpad(t):
        return jnp.pad(t, ((0, 0), (pad, 0)) + ((0, 0),) * (t.ndim - 2))
    y = ssd_chunked(lpad(xs.astype(jnp.float32) * dt[..., None]), lpad(dt * A), lpad(Bm), lpad(Cm))[:, pad:]
    y = y + d_skip.astype(jnp.float32)[:, None] * xs.astype(jnp.float32)
    y = y.reshape(b, L, SSM_WIDTH)
    y = y * jax.nn.silu(z.astype(jnp.float32))
    return rms_norm(y, norm_g).astype(z.dtype)


def moe_ffn(x, w_router, b_router, w_gate_up, b_gate_up, w_down, b_down):
    b, L, D = x.shape
    t = x.reshape(b * L, D)
    logits = (t @ w_router + b_router).astype(jnp.float32)
    top_v, top_i = lax.top_k(logits, TOP_K)
    top_w = jax.nn.softmax(top_v, axis=-1)
    gates = jnp.sum(jax.nn.one_hot(top_i, N_EXPERTS, dtype=jnp.float32) * top_w[..., None], axis=1)
    y = jnp.zeros_like(t)
    for e in range(N_EXPERTS):
        gu = t @ w_gate_up[e] + b_gate_up[e]
        g = jnp.minimum(gu[:, :D_FF], SWIGLU_LIMIT)
        u = jnp.clip(gu[:, D_FF:], -SWIGLU_LIMIT, SWIGLU_LIMIT)
        hdn = g * jax.nn.sigmoid(SWIGLU_ALPHA * g) * (u + 1.0)
        y = y + gates[:, e:e + 1].astype(t.dtype) * (hdn @ w_down[e] + b_down[e])
    return y.reshape(b, L, D)


def setup_inputs(seed: int = 0) -> dict:
    key = jax.random.key(seed)
    ks = jax.random.split(key, 24)
    f32 = jnp.float32
    def nrm(k, shape, scale):
        return jax.random.normal(k, shape, f32) * scale
    dt0 = jnp.exp(jax.random.uniform(ks[9], (DEPTH, SSM_HEADS), f32, np.log(1e-3), np.log(1e-1)))
    return {
        "x": nrm(ks[0], (BATCH, SEQ, D_MODEL), 1.0),
        "meta_tokens": nrm(ks[1], (N_META, D_MODEL), 1.0),
        "norm_mix_g": 1.0 + nrm(ks[2], (DEPTH, D_MODEL), 0.02),
        "w_in": nrm(ks[3], (DEPTH, D_MODEL, IN_COLS), D_MODEL ** -0.5),
        "fgate_b": 3.0 + nrm(ks[4], (DEPTH, ATTN_HEADS), 0.5),
        "attn_norm_g": 1.0 + nrm(ks[5], (DEPTH, ATTN_WIDTH), 0.02),
        "conv_w": nrm(ks[6], (DEPTH, CONV_WIDTH, CONV_CH), CONV_WIDTH ** -0.5),
        "conv_b": nrm(ks[7], (DEPTH, CONV_CH), 0.02),
        "dt_bias": dt0 + jnp.log(-jnp.expm1(-dt0)),
        "a_log": jnp.log(jax.random.uniform(ks[10], (DEPTH, SSM_HEADS), f32, 1.0, 16.0)),
        "d_skip": 1.0 + nrm(ks[11], (DEPTH, SSM_HEADS), 0.1),
        "ssm_norm_g": 1.0 + nrm(ks[12], (DEPTH, SSM_WIDTH), 0.02),
        "w_out": nrm(ks[13], (DEPTH, MIX_WIDTH, D_MODEL), MIX_WIDTH ** -0.5),
        "norm_ffn_g": 1.0 + nrm(ks[14], (DEPTH, D_MODEL), 0.02),
        "w_router": nrm(ks[15], (DEPTH, D_MODEL, N_EXPERTS), D_MODEL ** -0.5),
        "b_router": nrm(ks[16], (DEPTH, N_EXPERTS), 0.01),
        "w_gate_up": nrm(ks[17], (DEPTH, N_EXPERTS, D_MODEL, 2 * D_FF), D_MODEL ** -0.5),
        "b_gate_up": nrm(ks[18], (DEPTH, N_EXPERTS, 2 * D_FF), 0.01),
        "w_down": nrm(ks[19], (DEPTH, N_EXPERTS, D_FF, D_MODEL), D_FF ** -0.5),
        "b_down": nrm(ks[20], (DEPTH, N_EXPERTS, D_MODEL), 0.01),
        "final_norm_g": 1.0 + nrm(ks[21], (D_MODEL,), 0.02),
    }


def reference(x, meta_tokens, norm_mix_g, w_in, fgate_b, attn_norm_g, conv_w, conv_b,
              dt_bias, a_log, d_skip, ssm_norm_g, w_out, norm_ffn_g, w_router, b_router,
              w_gate_up, b_gate_up, w_down, b_down, final_norm_g):
    b = x.shape[0]
    h = jnp.concatenate([jnp.broadcast_to(meta_tokens[None].astype(x.dtype), (b, N_META, D_MODEL)), x], axis=1)
    L = h.shape[1]
    sizes = [ATTN_WIDTH, ATTN_WIDTH, ATTN_WIDTH, ATTN_HEADS, SSM_WIDTH, CONV_CH, SSM_HEADS]
    offs = []
    run = 0
    for s_ in sizes[:-1]:
        run += s_
        offs.append(run)
    for l in range(DEPTH):
        n = rms_norm(h, norm_mix_g[l])
        proj = n @ w_in[l]
        q, k, v, f_logit, z, xbc, dt_raw = jnp.split(proj, offs, axis=-1)
        q = q.reshape(b, L, ATTN_HEADS, HEAD_DIM)
        k = k.reshape(b, L, ATTN_HEADS, HEAD_DIM)
        v = v.reshape(b, L, ATTN_HEADS, HEAD_DIM)
        log_f = jax.nn.log_sigmoid(f_logit.astype(jnp.float32) + fgate_b[l].astype(jnp.float32))
        attn = forgetting_attention(q, k, v, log_f).reshape(b, L, ATTN_WIDTH)
        attn = rms_norm(attn, attn_norm_g[l])
        ssm = ssd_mixer(z, xbc, dt_raw, conv_w[l], conv_b[l], dt_bias[l], a_log[l], d_skip[l], ssm_norm_g[l])
        mixed = jnp.concatenate([attn, ssm.astype(attn.dtype)], axis=-1) @ w_out[l]
        h = h + mixed.astype(h.dtype)
        n2 = rms_norm(h, norm_ffn_g[l])
        h = h + moe_ffn(n2, w_router[l], b_router[l], w_gate_up[l], b_gate_up[l], w_down[l], b_down[l]).astype(h.dtype)
    return rms_norm(h[:, N_META:], final_norm_g)
```

```cpp
#include <hip/hip_runtime.h>
#include <cstdio>
#include <cstdint>

#ifndef MK_ONE_LAUNCH
#define MK_ONE_LAUNCH 1
#endif

#define GAS __attribute__((address_space(1)))
#define LAS __attribute__((address_space(3)))
typedef unsigned short bf16_t;
typedef float f32x4 __attribute__((ext_vector_type(4)));
typedef float f32x16 __attribute__((ext_vector_type(16)));
typedef unsigned u32x4 __attribute__((ext_vector_type(4)));
typedef unsigned u32x2 __attribute__((ext_vector_type(2)));

constexpr int NB = 4, SEQ = 4096, DM = 2048, NMETA = 16;
constexpr int M = NB * SEQ;
constexpr int LP = 4224;
constexpr int ROW_META = 112, ROW_REAL = 128;
constexpr int SR = NB * LP;
constexpr int AH = 16, HD = 64, AW = 1024;
constexpr int SH = 32, SP = 64, SW = 2048, SG = 4, SN = 128, CC = 3072;
constexpr int INC = 8240;
constexpr int C_Q = 0, C_K = 1024, C_V = 2048, C_F = 3072, C_Z = 3088, C_X = 5136, C_DT = 8208;
constexpr int NE = 32, TOPK = 4, FF = 2048;
constexpr float EPS = 1e-5f, LOG2E = 1.4426950408889634f, QSCALE = 0.125f * 1.4426950408889634f;
constexpr int NTHREADS = 512, NWAVES = 8;

constexpr size_t MiB = 1ull << 20;
constexpr size_t WS_CTL = 0, CTL_ZERO_BYTES = 1 * MiB;
constexpr size_t WS_XN   = 2 * MiB;
constexpr size_t WS_Q    = WS_XN   + (size_t)(M + 256) * DM * 2;
constexpr size_t WS_K    = WS_Q    + (size_t)M * AW * 2;
constexpr size_t WS_V    = WS_K    + (size_t)SR * AW * 2;
constexpr size_t WS_Z    = WS_V    + (size_t)SR * AW * 2;
constexpr size_t WS_XBC  = WS_Z    + (size_t)M * SW * 2;
constexpr size_t WS_XC   = WS_XBC  + (size_t)SR * CC * 2;
constexpr size_t WS_FDT  = WS_XC   + (size_t)SR * CC * 2;
constexpr size_t WS_DT   = WS_FDT  + (size_t)SR * 48 * 4;
constexpr size_t WS_CF   = WS_DT   + (size_t)SR * 32 * 4;
constexpr size_t WS_O    = WS_CF   + (size_t)SR * 16 * 4;
constexpr size_t WS_YS   = WS_O    + (size_t)M * AW * 2;
constexpr size_t WS_A2   = WS_YS   + (size_t)M * SW * 2;
constexpr size_t WS_XN2  = WS_A2   + (size_t)M * 3072 * 2;
constexpr size_t WS_TOKE = WS_XN2  + (size_t)M * DM * 2;
constexpr size_t WS_TOKP = WS_TOKE + (size_t)M * 4 * 4;
constexpr size_t WS_LIST = WS_TOKP + (size_t)M * 4 * 4;
constexpr size_t WS_LISTW= WS_LIST + (size_t)NE * M * 4;
constexpr int HROWS = 65536 + NE * 256;
constexpr size_t WS_H    = WS_LISTW+ (size_t)NE * M * 4;
constexpr size_t WS_Y    = WS_H    + (size_t)HROWS * FF * 2;
constexpr size_t WS_END  = WS_Y    + (size_t)HROWS * DM * 2;
constexpr int CW_BAR = 4096;
constexpr int CW_CNT = 8192;

__device__ __forceinline__ float bf2f(bf16_t v) { return __uint_as_float((unsigned)v << 16); }
__device__ __forceinline__ unsigned f2bf(float f) { unsigned u = __float_as_uint(f); return (u + 0x7fffu + ((u >> 16) & 1u)) >> 16; }
__device__ __forceinline__ unsigned pk2(float lo, float hi) { return f2bf(lo) | (f2bf(hi) << 16); }
__device__ __forceinline__ float wave_sum(float v) {
#pragma unroll
    for (int o = 1; o < 64; o <<= 1) v += __shfl_xor(v, o);
    return v;
}
__device__ __forceinline__ float sigmoidf_(float x) { return 1.0f / (1.0f + __expf(-x)); }
__device__ __forceinline__ float siluf_(float x) { return x / (1.0f + __expf(-x)); }
__device__ __forceinline__ float softplusf_(float x) { return x > 20.f ? x : log1pf(expf(x)); }
__device__ __forceinline__ float logsigmoidf_(float x) { return x < 0.f ? x - log1pf(expf(x)) : -log1pf(expf(-x)); }

#define XB_TMO      128
#define XB_XCNT(j)  (256  + 64 * (j))
#define XB_XSUB(j)  (1280 + 64 * (j))
#define XB_XGEN(j)  (2304 + 64 * (j))
#define XB_TOP      3328
#define XB_TOPGEN   3392
#define XCD_BAR_WORDS 3456
#define XB_SPIN_CAP (1u << 23)
__device__ __forceinline__ unsigned xb_ld(unsigned* p)              { return __hip_atomic_load(p, __ATOMIC_RELAXED, __HIP_MEMORY_SCOPE_AGENT); }
__device__ __forceinline__ unsigned xb_add(unsigned* p, unsigned v) { return __hip_atomic_fetch_add(p, v, __ATOMIC_RELAXED, __HIP_MEMORY_SCOPE_AGENT); }
__device__ __forceinline__ unsigned xb_xcc_id() { return (unsigned)__builtin_amdgcn_s_getreg((3 << 11) | 20) & 0xFu; }
#define XB_SPIN(cond, bar) do { unsigned _sp = 0; while (cond) { __builtin_amdgcn_s_sleep(1); \
    if ((++_sp & 255u) == 0u) { if (xb_ld(&(bar)[XB_TMO])) break; if (_sp > XB_SPIN_CAP) { atomicAdd(&(bar)[XB_TMO], 1u); break; } } } } while (0)
struct XcdBarrier { unsigned* bar; unsigned x; volatile LAS unsigned* st; };
__device__ __forceinline__ XcdBarrier xcd_barrier_post(unsigned* bar, volatile LAS unsigned* st) {
    XcdBarrier b; b.bar = bar; b.x = xb_xcc_id(); b.st = st;
    if (threadIdx.x == 0) (void)xb_add(&bar[XB_XCNT(b.x)], 1u);
    return b;
}
__device__ __forceinline__ void xcd_barrier_complete(unsigned* bar, unsigned x, unsigned& nloc, unsigned& nx) {
    const unsigned G = gridDim.x * gridDim.y * gridDim.z;
    unsigned sum, cnt, mine, sp = 0u;
    for (;;) {
        sum = 0u; cnt = 0u; mine = 0u;
#pragma unroll
        for (unsigned j = 0; j < 16; ++j) { const unsigned c = xb_ld(&bar[XB_XCNT(j)]); sum += c; cnt += (c > 0u) ? 1u : 0u; mine = (j == x) ? c : mine; }
        if (sum == G) break;
        __builtin_amdgcn_s_sleep(1);
        if ((++sp & 255u) == 0u) { if (xb_ld(&bar[XB_TMO])) break; if (sp > XB_SPIN_CAP) { atomicAdd(&bar[XB_TMO], 1u); break; } }
    }
    nloc = mine > 0u ? mine : 1u; nx = cnt > 0u ? cnt : 1u;
}
__device__ __forceinline__ void xcd_barrier(const XcdBarrier& b) {
    asm volatile("s_waitcnt vmcnt(0)" ::: "memory");
    __syncthreads();
    if (threadIdx.x == 0) {
        unsigned* bar = b.bar;
        __builtin_amdgcn_s_waitcnt(0);
        unsigned nloc = b.st[0], nx = b.st[1];
        if (nloc == 0u) { xcd_barrier_complete(bar, b.x, nloc, nx); b.st[0] = nloc; b.st[1] = nx; }
        const unsigned old = xb_add(&bar[XB_XSUB(b.x)], 1u);
        const unsigned gen = old / nloc;
        if (old + 1u == (gen + 1u) * nloc) {
            __builtin_amdgcn_fence(__ATOMIC_RELEASE, "agent");
            asm volatile("s_waitcnt vmcnt(0)" ::: "memory");
            const unsigned og = xb_add(&bar[XB_TOP], 1u);
            const unsigned tg = og / nx;
            if (og + 1u == (tg + 1u) * nx) xb_add(&bar[XB_TOPGEN], 1u);
            else XB_SPIN(xb_ld(&bar[XB_TOPGEN]) == tg, bar);
            __builtin_amdgcn_fence(__ATOMIC_ACQUIRE, "agent");
            xb_add(&bar[XB_XGEN(b.x)], 1u);
            asm volatile("s_waitcnt vmcnt(0)" ::: "memory");
        } else {
            XB_SPIN(xb_ld(&bar[XB_XGEN(b.x)]) == gen, bar);
            __builtin_amdgcn_fence(__ATOMIC_ACQUIRE, "agent");
            asm volatile("s_waitcnt vmcnt(0)" ::: "memory");
        }
    }
    __syncthreads();
}

struct Params { const float* in[21]; float* out; unsigned char* ws; int ph_lo, ph_hi; };
enum { I_X = 0, I_META, I_GMIX, I_WIN, I_FB, I_GATT, I_CW, I_CB, I_DTB, I_ALOG, I_DSKIP, I_GSSM, I_WOUT, I_GFFN, I_WR, I_BR, I_WGU, I_BGU, I_WD, I_BD, I_GFIN };
struct Frame {
    LAS unsigned char* lds; int tid, lane, wave, gw, NGW;
    const float* const* in; float* out; unsigned char* ws; unsigned* ctl;
};
constexpr int LDS_BYTES = 147456;
constexpr int MISC_OFF = 131072;

__device__ __forceinline__ void rmsnorm_row_bf16(const float* src, const float* gain, bf16_t* dst, int lane) {
    f32x4 v[8]; float ss = 0.f;
#pragma unroll
    for (int j = 0; j < 8; ++j) { v[j] = *(const f32x4*)(src + 4 * lane + 256 * j); ss += (v[j].x * v[j].x + v[j].y * v[j].y) + (v[j].z * v[j].z + v[j].w * v[j].w); }
    const float rstd = rsqrtf(wave_sum(ss) * (1.f / DM) + EPS);
#pragma unroll
    for (int j = 0; j < 8; ++j) { const f32x4 g = *(const f32x4*)(gain + 4 * lane + 256 * j);
        u32x2 w; w.x = pk2(v[j].x * rstd * g.x, v[j].y * rstd * g.y); w.y = pk2(v[j].z * rstd * g.z, v[j].w * rstd * g.w);
        *(u32x2*)(dst + 4 * lane + 256 * j) = w; }
}
__device__ __forceinline__ void ph0_prologue(Frame& F) {
    bf16_t* XN = (bf16_t*)(F.ws + WS_XN);
    for (int row = F.gw; row < M + 256; row += F.NGW) {
        bf16_t* dst = XN + (size_t)row * DM;
        if (row < M) rmsnorm_row_bf16(F.in[I_X] + (size_t)row * DM, F.in[I_GMIX], dst, F.lane);
        else if (row < M + NMETA) rmsnorm_row_bf16(F.in[I_META] + (size_t)(row - M) * DM, F.in[I_GMIX], dst, F.lane);
        else {
#pragma unroll
            for (int j = 0; j < 8; ++j) *(u32x2*)(dst + 4 * F.lane + 256 * j) = (u32x2){0u, 0u};
        }
    }
    const int gt = blockIdx.x * NTHREADS + F.tid, GT = gridDim.x * NTHREADS;
    for (int i = gt; i < NB * ROW_META * (AW / 8); i += GT) { const int r = i / (AW / 8), c = i % (AW / 8); const int sr = (r / ROW_META) * LP + (r % ROW_META);
        *(u32x4*)((bf16_t*)(F.ws + WS_K) + (size_t)sr * AW + c * 8) = (u32x4){0u, 0u, 0u, 0u};
        *(u32x4*)((bf16_t*)(F.ws + WS_V) + (size_t)sr * AW + c * 8) = (u32x4){0u, 0u, 0u, 0u}; }
    for (int i = gt; i < NB * ROW_META * (CC / 8); i += GT) { const int r = i / (CC / 8), c = i % (CC / 8); const int sr = (r / ROW_META) * LP + (r % ROW_META);
        *(u32x4*)((bf16_t*)(F.ws + WS_XBC) + (size_t)sr * CC + c * 8) = (u32x4){0u, 0u, 0u, 0u}; }
    for (int i = gt; i < NB * ROW_META * 12; i += GT) { const int r = i / 12, c = i % 12; const int sr = (r / ROW_META) * LP + (r % ROW_META);
        *(f32x4*)((float*)(F.ws + WS_FDT) + (size_t)sr * 48 + c * 4) = (f32x4){0.f, 0.f, 0.f, 0.f}; }
}

template <class AF, class BF, class SF>
__device__ __forceinline__ void gemm_tile_f32(Frame& F, int K, AF af, BF bf, SF sf) {
    LAS float* As = (LAS float*)F.lds;
    LAS float* Bs = As + 64 * 17 + 16;
    const int wr = F.wave >> 2, wc = F.wave & 3, l31 = F.lane & 31, hi = F.lane >> 5;
    f32x16 acc0, acc1;
#pragma unroll
    for (int i = 0; i < 16; ++i) { acc0[i] = 0.f; acc1[i] = 0.f; }
    for (int k0 = 0; k0 < K; k0 += 16) {
        float av[2], bv[8];
#pragma unroll
        for (int i = 0; i < 2; ++i) { const int idx = F.tid + NTHREADS * i; av[i] = af(idx >> 4, k0 + (idx & 15)); }
#pragma unroll
        for (int i = 0; i < 8; ++i) { const int idx = F.tid + NTHREADS * i; bv[i] = bf(k0 + (idx >> 8), idx & 255); }
        __syncthreads();
#pragma unroll
        for (int i = 0; i < 2; ++i) { const int idx = F.tid + NTHREADS * i; As[(idx >> 4) * 17 + (idx & 15)] = av[i]; }
#pragma unroll
        for (int i = 0; i < 8; ++i) { const int idx = F.tid + NTHREADS * i; Bs[(idx >> 8) * 260 + (idx & 255)] = bv[i]; }
        __syncthreads();
#pragma unroll
        for (int kk = 0; kk < 16; kk += 2) {
            const float a = As[(wr * 32 + l31) * 17 + kk + hi];
            const float b0 = Bs[(kk + hi) * 260 + wc * 64 + l31], b1 = Bs[(kk + hi) * 260 + wc * 64 + 32 + l31];
            acc0 = __builtin_amdgcn_mfma_f32_32x32x2f32(a, b0, acc0, 0, 0, 0);
            acc1 = __builtin_amdgcn_mfma_f32_32x32x2f32(a, b1, acc1, 0, 0, 0);
        }
    }
#pragma unroll
    for (int r = 0; r < 16; ++r) sf(wr * 32 + (r & 3) + 8 * (r >> 2) + 4 * hi, wc * 64 + l31, acc0[r], acc1[r]);
    __syncthreads();
}

__device__ __forceinline__ void inproj_route(Frame& F, int row, int col, float v) {
    if (col >= INC) return;
    bf16_t* Q = (bf16_t*)(F.ws + WS_Q); bf16_t* Kb = (bf16_t*)(F.ws + WS_K); bf16_t* Vb = (bf16_t*)(F.ws + WS_V); bf16_t* Z = (bf16_t*)(F.ws + WS_Z);
    bf16_t* XBC = (bf16_t*)(F.ws + WS_XBC); float* FDT = (float*)(F.ws + WS_FDT);
    const bool real = row < M; int sr0, nb;
    if (real) { sr0 = (row >> 12) * LP + ROW_REAL + (row & 4095); nb = 1; } else { sr0 = ROW_META + (row - M); nb = NB; }
    if (col < C_K) { if (real) Q[(size_t)row * AW + col] = (bf16_t)f2bf(v * QSCALE); return; }
    if (col >= C_Z && col < C_X) { if (real) Z[(size_t)row * SW + (col - C_Z)] = (bf16_t)f2bf(v); return; }
    for (int b = 0; b < nb; ++b) { const size_t sr = (size_t)sr0 + (size_t)b * LP;
        if (col < C_V) Kb[sr * AW + (col - C_K)] = (bf16_t)f2bf(v);
        else if (col < C_F) Vb[sr * AW + (col - C_V)] = (bf16_t)f2bf(v);
        else if (col < C_Z) FDT[sr * 48 + (col - C_F)] = v;
        else if (col < C_DT) XBC[sr * CC + (col - C_X)] = (bf16_t)f2bf(v);
        else FDT[sr * 48 + 16 + (col - C_DT)] = v; }
}
__device__ __forceinline__ void ph1_inproj_oracle(Frame& F) {
    const bf16_t* XN = (const bf16_t*)(F.ws + WS_XN); const float* W = F.in[I_WIN];
    constexpr int MR = M + NMETA, TM = (MR + 63) / 64, TN = (INC + 255) / 256;
    for (int tile = blockIdx.x; tile < TM * TN; tile += gridDim.x) {
        const int tm = tile / TN, tn = tile % TN;
        gemm_tile_f32(F, DM,
            [&](int r, int k) -> float { const int row = tm * 64 + r; return row < MR ? bf2f(XN[(size_t)row * DM + k]) : 0.f; },
            [&](int k, int c) -> float { const int col = tn * 256 + c; return col < INC ? W[(size_t)k * INC + col] : 0.f; },
            [&](int r, int c, float v0, float v1) { const int row = tm * 64 + r, col = tn * 256 + c; if (row < MR) { inproj_route(F, row, col, v0); inproj_route(F, row, col + 32, v1); } });
    }
}

__device__ __forceinline__ void ph1b_conv_scan(Frame& F) {
    const bf16_t* XBC = (const bf16_t*)(F.ws + WS_XBC); bf16_t* XC = (bf16_t*)(F.ws + WS_XC);
    const float* FDT = (const float*)(F.ws + WS_FDT); float* DT = (float*)(F.ws + WS_DT); float* CF = (float*)(F.ws + WS_CF);
    const float* cw = F.in[I_CW]; const float* cb = F.in[I_CB];
    const int gt = blockIdx.x * NTHREADS + F.tid, GT = gridDim.x * NTHREADS;
    for (int i = gt; i < SR * (CC / 8); i += GT) {
        const int sr = i / (CC / 8), cv = i % (CC / 8), pos = sr % LP, c0 = cv * 8;
        u32x4 o = (u32x4){0u, 0u, 0u, 0u};
        if (pos >= ROW_META) {
            float acc[8];
#pragma unroll
            for (int j = 0; j < 8; ++j) acc[j] = cb[c0 + j];
#pragma unroll
            for (int k = 0; k < 4; ++k) { const u32x4 xv = *(const u32x4*)(XBC + (size_t)(sr - 3 + k) * CC + c0);
                const unsigned xw[4] = {xv.x, xv.y, xv.z, xv.w};
#pragma unroll
                for (int j = 0; j < 8; ++j) { const float xf = __uint_as_float((j & 1) ? (xw[j >> 1] & 0xffff0000u) : (xw[j >> 1] << 16)); acc[j] += cw[k * CC + c0 + j] * xf; } }
            o.x = pk2(siluf_(acc[0]), siluf_(acc[1])); o.y = pk2(siluf_(acc[2]), siluf_(acc[3])); o.z = pk2(siluf_(acc[4]), siluf_(acc[5])); o.w = pk2(siluf_(acc[6]), siluf_(acc[7]));
        }
        *(u32x4*)(XC + (size_t)sr * CC + c0) = o;
    }
    for (int i = gt; i < SR * SH; i += GT) { const int sr = i / SH, h = i % SH, pos = sr % LP;
        DT[i] = pos >= ROW_META ? softplusf_(FDT[(size_t)sr * 48 + 16 + h] + F.in[I_DTB][h]) : 0.f; }
    LAS float* red = (LAS float*)F.lds;
    for (int w = blockIdx.x; w < NB * AH; w += gridDim.x) {
        const int b = w / AH, h = w % AH; const float fb = F.in[I_FB][h];
        float v[9]; float run = 0.f;
#pragma unroll
        for (int j = 0; j < 9; ++j) { const int pos = F.tid * 9 + j; float lf = 0.f;
            if (pos >= ROW_META && pos < LP) lf = logsigmoidf_(FDT[(size_t)(b * LP + pos) * 48 + h] + fb);
            run += lf; v[j] = run; }
        __syncthreads();
        red[F.tid] = run;
        __syncthreads();
        if (F.tid == 0) { float s = 0.f; for (int i = 0; i < NTHREADS; ++i) { const float t = red[i]; red[i] = s; s += t; } }
        __syncthreads();
        const float off = red[F.tid];
#pragma unroll
        for (int j = 0; j < 9; ++j) { const int pos = F.tid * 9 + j; if (pos < LP) CF[(size_t)(b * LP + pos) * 16 + h] = v[j] + off; }
        __syncthreads();
    }
}

__device__ __forceinline__ void ph2_attn_oracle(Frame& F) {
    const bf16_t* Q = (const bf16_t*)(F.ws + WS_Q); const bf16_t* Kb = (const bf16_t*)(F.ws + WS_K); const bf16_t* Vb = (const bf16_t*)(F.ws + WS_V);
    const float* CF = (const float*)(F.ws + WS_CF); bf16_t* O = (bf16_t*)(F.ws + WS_O);
    for (int task = F.gw; task < NB * AH * 64; task += F.NGW) {
        const int tb = 63 - (task % 64), bh = task / 64, b = bh / AH, h = bh % AH;
        const int t = tb * 64 + F.lane, m = b * SEQ + t, srq = b * LP + ROW_REAL + t;
        float q[64], o[64];
#pragma unroll
        for (int d = 0; d < 64; d += 8) { const u32x4 w = *(const u32x4*)(Q + (size_t)m * AW + h * HD + d);
            q[d] = __uint_as_float(w.x << 16); q[d + 1] = __uint_as_float(w.x & 0xffff0000u); q[d + 2] = __uint_as_float(w.y << 16); q[d + 3] = __uint_as_float(w.y & 0xffff0000u);
            q[d + 4] = __uint_as_float(w.z << 16); q[d + 5] = __uint_as_float(w.z & 0xffff0000u); q[d + 6] = __uint_as_float(w.w << 16); q[d + 7] = __uint_as_float(w.w & 0xffff0000u); }
#pragma unroll
        for (int d = 0; d < 64; ++d) o[d] = 0.f;
        const float ct = CF[(size_t)srq * 16 + h] * LOG2E;
        float mrun = -INFINITY, l = 0.f;
        const int s_end = b * LP + ROW_REAL + tb * 64 + 63;
        for (int srk = b * LP + ROW_META; srk <= s_end; ++srk) {
            const unsigned* kp = (const unsigned*)(Kb + (size_t)srk * AW + h * HD);
            float dot = 0.f;
#pragma unroll
            for (int d = 0; d < 32; ++d) { const unsigned w = kp[d]; dot += q[2 * d] * __uint_as_float(w << 16); dot += q[2 * d + 1] * __uint_as_float(w & 0xffff0000u); }
            float s = dot + ct - CF[(size_t)srk * 16 + h] * LOG2E;
            if (srk > srq) s = -INFINITY;
            const float mnew = fmaxf(mrun, s);
            const float alpha = exp2f(mrun - mnew), p = exp2f(s - mnew);
            l = l * alpha + p; mrun = mnew;
            const unsigned* vp = (const unsigned*)(Vb + (size_t)srk * AW + h * HD);
#pragma unroll
            for (int d = 0; d < 32; ++d) { const unsigned w = vp[d]; o[2 * d] = o[2 * d] * alpha + p * __uint_as_float(w << 16); o[2 * d + 1] = o[2 * d + 1] * alpha + p * __uint_as_float(w & 0xffff0000u); }
        }
        const float rl = 1.f / l;
#pragma unroll
        for (int d = 0; d < 64; d += 8) { u32x4 w; w.x = pk2(o[d] * rl, o[d + 1] * rl); w.y = pk2(o[d + 2] * rl, o[d + 3] * rl); w.z = pk2(o[d + 4] * rl, o[d + 5] * rl); w.w = pk2(o[d + 6] * rl, o[d + 7] * rl);
            *(u32x4*)(O + (size_t)m * AW + h * HD + d) = w; }
    }
}

__device__ __forceinline__ void ph2_ssd_oracle(Frame& F) {
    const bf16_t* XC = (const bf16_t*)(F.ws + WS_XC); const float* DT = (const float*)(F.ws + WS_DT); bf16_t* YS = (bf16_t*)(F.ws + WS_YS);
    for (int task = F.NGW - 1 - F.gw; task < NB * SH; task += F.NGW) {
        const int b = task / SH, h = task % SH, g = h / (SH / SG);
        const float A = -expf(F.in[I_ALOG][h]), Dh = F.in[I_DSKIP][h];
        float hs[128];
#pragma unroll
        for (int n = 0; n < 128; ++n) hs[n] = 0.f;
        for (int pos = ROW_META; pos < LP; ++pos) {
            const size_t sr = (size_t)b * LP + pos;
            const float dt = DT[sr * SH + h], dec = expf(dt * A);
            const float x = bf2f(XC[sr * CC + h * SP + F.lane]), xdt = x * dt;
            const unsigned* bp = (const unsigned*)(XC + sr * CC + SW + g * SN); const unsigned* cp = (const unsigned*)(XC + sr * CC + SW + SG * SN + g * SN);
            float y = 0.f;
#pragma unroll
            for (int n = 0; n < 64; ++n) { const unsigned bw = bp[n], cw = cp[n];
                hs[2 * n] = dec * hs[2 * n] + __uint_as_float(bw << 16) * xdt; y += __uint_as_float(cw << 16) * hs[2 * n];
                hs[2 * n + 1] = dec * hs[2 * n + 1] + __uint_as_float(bw & 0xffff0000u) * xdt; y += __uint_as_float(cw & 0xffff0000u) * hs[2 * n + 1]; }
            y += Dh * x;
            if (pos >= ROW_REAL) YS[(size_t)(b * SEQ + pos - ROW_REAL) * SW + h * SP + F.lane] = (bf16_t)f2bf(y);
        }
    }
}

__device__ __forceinline__ void ph3_norms(Frame& F) {
    const bf16_t* O = (const bf16_t*)(F.ws + WS_O); const bf16_t* YS = (const bf16_t*)(F.ws + WS_YS); const bf16_t* Z = (const bf16_t*)(F.ws + WS_Z); bf16_t* A2 = (bf16_t*)(F.ws + WS_A2);
    const float* ga = F.in[I_GATT]; const float* gs = F.in[I_GSSM];
    for (int m = F.gw; m < M; m += F.NGW) {
        float a[16]; float ss = 0.f;
#pragma unroll
        for (int j = 0; j < 2; ++j) { const u32x4 w = *(const u32x4*)(O + (size_t)m * AW + 8 * F.lane + 512 * j); const unsigned ww[4] = {w.x, w.y, w.z, w.w};
#pragma unroll
            for (int i = 0; i < 4; ++i) { a[8 * j + 2 * i] = __uint_as_float(ww[i] << 16); a[8 * j + 2 * i + 1] = __uint_as_float(ww[i] & 0xffff0000u); } }
#pragma unroll
        for (int i = 0; i < 16; ++i) ss += a[i] * a[i];
        float rstd = rsqrtf(wave_sum(ss) * (1.f / AW) + EPS);
#pragma unroll
        for (int j = 0; j < 2; ++j) { const int c0 = 8 * F.lane + 512 * j; u32x4 w;
            w.x = pk2(a[8 * j] * rstd * ga[c0], a[8 * j + 1] * rstd * ga[c0 + 1]); w.y = pk2(a[8 * j + 2] * rstd * ga[c0 + 2], a[8 * j + 3] * rstd * ga[c0 + 3]);
            w.z = pk2(a[8 * j + 4] * rstd * ga[c0 + 4], a[8 * j + 5] * rstd * ga[c0 + 5]); w.w = pk2(a[8 * j + 6] * rstd * ga[c0 + 6], a[8 * j + 7] * rstd * ga[c0 + 7]);
            *(u32x4*)(A2 + (size_t)m * 3072 + c0) = w; }
        float y[32]; ss = 0.f;
#pragma unroll
        for (int j = 0; j < 4; ++j) { const u32x4 w = *(const u32x4*)(YS + (size_t)m * SW + 8 * F.lane + 512 * j); const u32x4 zz = *(const u32x4*)(Z + (size_t)m * SW + 8 * F.lane + 512 * j);
            const unsigned ww[4] = {w.x, w.y, w.z, w.w}, zw[4] = {zz.x, zz.y, zz.z, zz.w};
#pragma unroll
            for (int i = 0; i < 4; ++i) { y[8 * j + 2 * i] = __uint_as_float(ww[i] << 16) * siluf_(__uint_as_float(zw[i] << 16)); y[8 * j + 2 * i + 1] = __uint_as_float(ww[i] & 0xffff0000u) * siluf_(__uint_as_float(zw[i] & 0xffff0000u)); } }
#pragma unroll
        for (int i = 0; i < 32; ++i) ss += y[i] * y[i];
        rstd = rsqrtf(wave_sum(ss) * (1.f / SW) + EPS);
#pragma unroll
        for (int j = 0; j < 4; ++j) { const int c0 = 8 * F.lane + 512 * j; u32x4 w;
            w.x = pk2(y[8 * j] * rstd * gs[c0], y[8 * j + 1] * rstd * gs[c0 + 1]); w.y = pk2(y[8 * j + 2] * rstd * gs[c0 + 2], y[8 * j + 3] * rstd * gs[c0 + 3]);
            w.z = pk2(y[8 * j + 4] * rstd * gs[c0 + 4], y[8 * j + 5] * rstd * gs[c0 + 5]); w.w = pk2(y[8 * j + 6] * rstd * gs[c0 + 6], y[8 * j + 7] * rstd * gs[c0 + 7]);
            *(u32x4*)(A2 + (size_t)m * 3072 + AW + c0) = w; }
    }
}

__device__ __forceinline__ void ph4_outproj_oracle(Frame& F) {
    const bf16_t* A2 = (const bf16_t*)(F.ws + WS_A2); const float* W = F.in[I_WOUT]; const float* X = F.in[I_X]; float* H1 = F.out;
    constexpr int TM = M / 64, TN = DM / 256;
    for (int tile = blockIdx.x; tile < TM * TN; tile += gridDim.x) {
        const int tm = tile / TN, tn = tile % TN;
        gemm_tile_f32(F, 3072,
            [&](int r, int k) -> float { return bf2f(A2[(size_t)(tm * 64 + r) * 3072 + k]); },
            [&](int k, int c) -> float { return W[(size_t)k * DM + tn * 256 + c]; },
            [&](int r, int c, float v0, float v1) { const size_t o = (size_t)(tm * 64 + r) * DM + tn * 256 + c; H1[o] = X[o] + v0; H1[o + 32] = X[o + 32] + v1; });
    }
}

__device__ __forceinline__ void ph5_router(Frame& F) {
    const float* H1 = F.out; bf16_t* XN2 = (bf16_t*)(F.ws + WS_XN2); const float* g = F.in[I_GFFN]; const float* WR = F.in[I_WR]; const float* BR = F.in[I_BR];
    int* TOKE = (int*)(F.ws + WS_TOKE); int* TOKP = (int*)(F.ws + WS_TOKP); int* LIST = (int*)(F.ws + WS_LIST); float* LISTW = (float*)(F.ws + WS_LISTW);
    for (int m = F.gw; m < M; m += F.NGW) {
        f32x4 v[8]; float ss = 0.f;
#pragma unroll
        for (int j = 0; j < 8; ++j) { v[j] = *(const f32x4*)(H1 + (size_t)m * DM + 4 * F.lane + 256 * j); ss += (v[j].x * v[j].x + v[j].y * v[j].y) + (v[j].z * v[j].z + v[j].w * v[j].w); }
        const float rstd = rsqrtf(wave_sum(ss) * (1.f / DM) + EPS);
        float part[32];
#pragma unroll
        for (int e = 0; e < 32; ++e) part[e] = 0.f;
#pragma unroll
        for (int j = 0; j < 8; ++j) { const f32x4 gg = *(const f32x4*)(g + 4 * F.lane + 256 * j);
            v[j].x *= rstd * gg.x; v[j].y *= rstd * gg.y; v[j].z *= rstd * gg.z; v[j].w *= rstd * gg.w;
            u32x2 w; w.x = pk2(v[j].x, v[j].y); w.y = pk2(v[j].z, v[j].w);
            *(u32x2*)(XN2 + (size_t)m * DM + 4 * F.lane + 256 * j) = w;
#pragma unroll
            for (int i = 0; i < 4; ++i) { const float nv = v[j][i]; const float* wr = WR + (size_t)(4 * F.lane + 256 * j + i) * NE;
#pragma unroll
                for (int e4 = 0; e4 < 8; ++e4) { const f32x4 ww = *(const f32x4*)(wr + 4 * e4);
                    part[4 * e4] += nv * ww.x; part[4 * e4 + 1] += nv * ww.y; part[4 * e4 + 2] += nv * ww.z; part[4 * e4 + 3] += nv * ww.w; } } }
        float logit = 0.f;
#pragma unroll
        for (int e = 0; e < 32; ++e) { const float s = wave_sum(part[e]); if (F.lane == e) logit = s; }
        logit = (F.lane < 32) ? logit + BR[F.lane & 31] : -INFINITY;
        float tv[4]; int ti[4]; float cur = logit;
#pragma unroll
        for (int k = 0; k < 4; ++k) {
            float bv = cur; int bi = F.lane;
#pragma unroll
            for (int o = 1; o < 64; o <<= 1) { const float ov = __shfl_xor(bv, o); const int oi = __shfl_xor(bi, o); if (ov > bv || (ov == bv && oi < bi)) { bv = ov; bi = oi; } }
            tv[k] = bv; ti[k] = bi; if (F.lane == bi) cur = -INFINITY;
        }
        const float e0 = 1.f, e1 = __expf(tv[1] - tv[0]), e2 = __expf(tv[2] - tv[0]), e3 = __expf(tv[3] - tv[0]); const float rs = 1.f / (e0 + e1 + e2 + e3);
        if (F.lane < 4) {
            const int e = F.lane == 0 ? ti[0] : F.lane == 1 ? ti[1] : F.lane == 2 ? ti[2] : ti[3];
            const float w = (F.lane == 0 ? e0 : F.lane == 1 ? e1 : F.lane == 2 ? e2 : e3) * rs;
            const int pos = (int)__hip_atomic_fetch_add(F.ctl + CW_CNT + 64 * e, 1u, __ATOMIC_RELAXED, __HIP_MEMORY_SCOPE_AGENT);
            TOKE[m * 4 + F.lane] = e; TOKP[m * 4 + F.lane] = pos; LIST[(size_t)e * M + pos] = m; LISTW[(size_t)e * M + pos] = w;
        }
    }
}

__device__ __forceinline__ void load_expert_tables(Frame& F, LAS int* tab) {
    __syncthreads();
    if (F.tid == 0) { int rb = 0, tb = 0;
        for (int e = 0; e < NE; ++e) { const int c = (int)__hip_atomic_load(F.ctl + CW_CNT + 64 * e, __ATOMIC_RELAXED, __HIP_MEMORY_SCOPE_AGENT);
            tab[e] = c; tab[32 + e] = rb; tab[64 + e] = tb; rb += ((c + 255) / 256) * 256; tb += (c + 63) / 64; }
        tab[96] = tb; }
    __syncthreads();
}

__device__ __forceinline__ void ph6_gateup_oracle(Frame& F) {
    const bf16_t* XN2 = (const bf16_t*)(F.ws + WS_XN2); const int* LIST = (const int*)(F.ws + WS_LIST); bf16_t* H = (bf16_t*)(F.ws + WS_H);
    LAS int* tab = (LAS int*)(F.lds + 65536); LAS int* toks = tab + 128;
    load_expert_tables(F, tab);
    const int ntm = tab[96];
    for (int tile = blockIdx.x; tile < ntm * 16; tile += gridDim.x) {
        const int tmg = tile / 16, nt = tile % 16; int e = 0;
        for (int i = 1; i < NE; ++i) if (tab[64 + i] <= tmg) e = i;
        const int mt = tmg - tab[64 + e], cnt = tab[e], rb = tab[32 + e];
        __syncthreads();
        if (F.tid < 64) { const int pos = mt * 64 + F.tid; toks[F.tid] = pos < cnt ? LIST[(size_t)e * M + pos] : -1; }
        __syncthreads();
        const float* W = F.in[I_WGU] + (size_t)e * DM * 4096; const float* Bg = F.in[I_BGU] + (size_t)e * 4096;
        gemm_tile_f32(F, DM,
            [&](int r, int k) -> float { const int t = toks[r]; return t >= 0 ? bf2f(XN2[(size_t)t * DM + k]) : 0.f; },
            [&](int k, int c) -> float { const int vc = nt * 256 + c, blk = vc >> 6, i = vc & 63; const int col = (i < 32) ? blk * 32 + i : 2048 + blk * 32 + (i - 32); return W[(size_t)k * 4096 + col]; },
            [&](int r, int c, float v0, float v1) { const int pos = mt * 64 + r; if (pos < cnt) { const int vc = nt * 256 + c, j = (vc >> 6) * 32 + (vc & 31);
                float gv = fminf(v0 + Bg[j], 7.f), uv = fminf(fmaxf(v1 + Bg[2048 + j], -7.f), 7.f);
                H[(size_t)(rb + pos) * FF + j] = (bf16_t)f2bf(gv * sigmoidf_(1.702f * gv) * (uv + 1.f)); } });
    }
}
__device__ __forceinline__ void ph7_down_oracle(Frame& F) {
    const bf16_t* H = (const bf16_t*)(F.ws + WS_H); const float* LISTW = (const float*)(F.ws + WS_LISTW); bf16_t* Y = (bf16_t*)(F.ws + WS_Y);
    LAS int* tab = (LAS int*)(F.lds + 65536);
    load_expert_tables(F, tab);
    const int ntm = tab[96];
    for (int tile = blockIdx.x; tile < ntm * 8; tile += gridDim.x) {
        const int tmg = tile / 8, nt = tile % 8; int e = 0;
        for (int i = 1; i < NE; ++i) if (tab[64 + i] <= tmg) e = i;
        const int mt = tmg - tab[64 + e], cnt = tab[e], rb = tab[32 + e];
        const float* W = F.in[I_WD] + (size_t)e * FF * DM; const float* Bd = F.in[I_BD] + (size_t)e * DM;
        gemm_tile_f32(F, FF,
            [&](int r, int k) -> float { const int pos = mt * 64 + r; return pos < cnt ? bf2f(H[(size_t)(rb + pos) * FF + k]) : 0.f; },
            [&](int k, int c) -> float { return W[(size_t)k * DM + nt * 256 + c]; },
            [&](int r, int c, float v0, float v1) { const int pos = mt * 64 + r; if (pos < cnt) { const float w = LISTW[(size_t)e * M + pos]; const int col = nt * 256 + c;
                Y[(size_t)(rb + pos) * DM + col] = (bf16_t)f2bf(w * (v0 + Bd[col])); Y[(size_t)(rb + pos) * DM + col + 32] = (bf16_t)f2bf(w * (v1 + Bd[col + 32])); } });
    }
}

__device__ __forceinline__ void ph8_final(Frame& F) {
    float* H1 = F.out; const bf16_t* Y = (const bf16_t*)(F.ws + WS_Y); const int* TOKE = (const int*)(F.ws + WS_TOKE); const int* TOKP = (const int*)(F.ws + WS_TOKP); const float* g = F.in[I_GFIN];
    LAS int* tab = (LAS int*)(F.lds + 65536);
    load_expert_tables(F, tab);
    for (int m = F.gw; m < M; m += F.NGW) {
        size_t rows[4];
#pragma unroll
        for (int k = 0; k < 4; ++k) rows[k] = (size_t)(tab[32 + TOKE[m * 4 + k]] + TOKP[m * 4 + k]);
        f32x4 v[8]; float ss = 0.f;
#pragma unroll
        for (int j = 0; j < 8; ++j) { const int c = 4 * F.lane + 256 * j; v[j] = *(const f32x4*)(H1 + (size_t)m * DM + c);
#pragma unroll
            for (int k = 0; k < 4; ++k) { const u32x2 w = *(const u32x2*)(Y + rows[k] * DM + c);
                v[j].x += __uint_as_float(w.x << 16); v[j].y += __uint_as_float(w.x & 0xffff0000u); v[j].z += __uint_as_float(w.y << 16); v[j].w += __uint_as_float(w.y & 0xffff0000u); }
            ss += (v[j].x * v[j].x + v[j].y * v[j].y) + (v[j].z * v[j].z + v[j].w * v[j].w); }
        const float rstd = rsqrtf(wave_sum(ss) * (1.f / DM) + EPS);
#pragma unroll
        for (int j = 0; j < 8; ++j) { const int c = 4 * F.lane + 256 * j; const f32x4 gg = *(const f32x4*)(g + c);
            *(f32x4*)(H1 + (size_t)m * DM + c) = (f32x4){v[j].x * rstd * gg.x, v[j].y * rstd * gg.y, v[j].z * rstd * gg.z, v[j].w * rstd * gg.w}; }
    }
}

constexpr int NPHASES = 10;
__global__ void __launch_bounds__(NTHREADS, 2) fwd(Params p) {
    extern __shared__ __attribute__((aligned(16))) unsigned char lds_raw[];
    Frame F;
    F.lds = (LAS unsigned char*)lds_raw;
    F.tid = threadIdx.x; F.lane = F.tid & 63; F.wave = __builtin_amdgcn_readfirstlane(F.tid >> 6);
    F.gw = blockIdx.x * NWAVES + F.wave; F.NGW = gridDim.x * NWAVES;
    F.in = p.in; F.out = p.out; F.ws = p.ws; F.ctl = (unsigned*)(p.ws + WS_CTL);
    volatile LAS unsigned* MISC = (volatile LAS unsigned*)(F.lds + MISC_OFF);
    if (F.tid < 32) MISC[F.tid] = 0u;
    __syncthreads();
    const int lo = p.ph_lo, hi = p.ph_hi;
    XcdBarrier bar; bar.bar = F.ctl + CW_BAR; bar.x = 0; bar.st = nullptr;
    if (hi - lo > 1) bar = xcd_barrier_post(F.ctl + CW_BAR, MISC + 8);
#define IN(k) (lo <= (k) && (k) < hi)
#define SEAM(k) do { if (IN(k) && IN((k) + 1)) xcd_barrier(bar); } while (0)
    if (IN(0)) { ph0_prologue(F); } SEAM(0);
    if (IN(1)) { ph1_inproj_oracle(F); } SEAM(1);
    if (IN(2)) { ph1b_conv_scan(F); } SEAM(2);
    if (IN(3)) { ph2_attn_oracle(F); ph2_ssd_oracle(F); } SEAM(3);
    if (IN(4)) { ph3_norms(F); } SEAM(4);
    if (IN(5)) { ph4_outproj_oracle(F); } SEAM(5);
    if (IN(6)) { ph5_router(F); } SEAM(6);
    if (IN(7)) { ph6_gateup_oracle(F); } SEAM(7);
    if (IN(8)) { ph7_down_oracle(F); } SEAM(8);
    if (IN(9)) { ph8_final(F); }
#undef IN
#undef SEAM
}

extern "C" void kernel_launch(void* const* d_in, const int* in_sizes, int n_in, void* d_out, int out_size, void* d_ws, size_t ws_size, hipStream_t stream) {
    static int grid = 0;
    if (grid == 0) {
        if (n_in != 21 || out_size != M * DM || ws_size < WS_END) { fprintf(stderr, "kernel_launch: unexpected shapes (n_in %d, out %d, ws %zu < %zu)\n", n_in, out_size, ws_size, (size_t)WS_END); grid = -1; return; }
        int dev = 0, cus = 0, per_cu = 0;
        if (hipGetDevice(&dev) != hipSuccess || hipDeviceGetAttribute(&cus, hipDeviceAttributeMultiprocessorCount, dev) != hipSuccess) { grid = -1; return; }
        if (hipFuncSetAttribute((const void*)fwd, hipFuncAttributeMaxDynamicSharedMemorySize, LDS_BYTES) != hipSuccess) { fprintf(stderr, "kernel_launch: hipFuncSetAttribute failed\n"); grid = -1; return; }
        if (hipOccupancyMaxActiveBlocksPerMultiprocessor(&per_cu, (const void*)fwd, NTHREADS, LDS_BYTES) != hipSuccess || per_cu < 1) fprintf(stderr, "kernel_launch: occupancy query says %d\n", per_cu);
        (void)hipGetLastError();
        grid = cus;
    }
    if (grid < 0) return;
    (void)hipMemsetAsync((char*)d_ws + WS_CTL, 0, CTL_ZERO_BYTES, stream);
    Params p{};
    for (int i = 0; i < 21; ++i) p.in[i] = (const float*)d_in[i];
    p.out = (float*)d_out; p.ws = (unsigned char*)d_ws;
#if MK_ONE_LAUNCH
    p.ph_lo = 0; p.ph_hi = NPHASES;
    hipLaunchKernelGGL(fwd, dim3(grid), dim3(NTHREADS), LDS_BYTES, stream, p);
#else
    for (int k = 0; k < NPHASES; ++k) { p.ph_lo = k; p.ph_hi = k + 1; hipLaunchKernelGGL(fwd, dim3(grid), dim3(NTHREADS), LDS_BYTES, stream, p); }
#endif
}
```

```cpp
#include <hip/hip_runtime.h>
#include <cstdio>
#include <cstdint>

#ifndef MK_ONE_LAUNCH
#define MK_ONE_LAUNCH 1
#endif

#define GAS __attribute__((address_space(1)))
#define LAS __attribute__((address_space(3)))
typedef unsigned short bf16_t;
typedef float f32x4 __attribute__((ext_vector_type(4)));
typedef float f32x16 __attribute__((ext_vector_type(16)));
typedef unsigned u32x4 __attribute__((ext_vector_type(4)));
typedef unsigned u32x2 __attribute__((ext_vector_type(2)));

constexpr int NB = 4, SEQ = 4096, DM = 2048, NMETA = 16;
constexpr int M = NB * SEQ;
constexpr int LP = 4224;
constexpr int ROW_META = 112, ROW_REAL = 128;
constexpr int SR = NB * LP;
constexpr int AH = 16, HD = 64, AW = 1024;
constexpr int SH = 32, SP = 64, SW = 2048, SG = 4, SN = 128, CC = 3072;
constexpr int INC = 8240;
constexpr int C_Q = 0, C_K = 1024, C_V = 2048, C_F = 3072, C_Z = 3088, C_X = 5136, C_DT = 8208;
constexpr int NE = 32, TOPK = 4, FF = 2048;
constexpr float EPS = 1e-5f, LOG2E = 1.4426950408889634f, QSCALE = 0.125f * 1.4426950408889634f;
constexpr int NTHREADS = 512, NWAVES = 8;

constexpr size_t MiB = 1ull << 20;
constexpr size_t WS_CTL = 0, CTL_ZERO_BYTES = 1 * MiB;
constexpr size_t WS_XN   = 2 * MiB;
constexpr size_t WS_Q    = WS_XN   + (size_t)(M + 256) * DM * 2;
constexpr size_t WS_K    = WS_Q    + (size_t)M * AW * 2;
constexpr size_t WS_V    = WS_K    + (size_t)SR * AW * 2;
constexpr size_t WS_Z    = WS_V    + (size_t)SR * AW * 2;
constexpr size_t WS_XBC  = WS_Z    + (size_t)M * SW * 2;
constexpr size_t WS_XC   = WS_XBC  + (size_t)SR * CC * 2;
constexpr size_t WS_FDT  = WS_XC   + (size_t)SR * CC * 2;
constexpr size_t WS_DT   = WS_FDT  + (size_t)SR * 48 * 4;
constexpr size_t WS_CF   = WS_DT   + (size_t)SR * 32 * 4;
constexpr size_t WS_O    = WS_CF   + (size_t)SR * 16 * 4;
constexpr size_t WS_YS   = WS_O    + (size_t)M * AW * 2;
constexpr size_t WS_A2   = WS_YS   + (size_t)M * SW * 2;
constexpr size_t WS_XN2  = WS_A2   + (size_t)M * 3072 * 2;
constexpr size_t WS_TOKE = WS_XN2  + (size_t)M * DM * 2;
constexpr size_t WS_TOKP = WS_TOKE + (size_t)M * 4 * 4;
constexpr size_t WS_LIST = WS_TOKP + (size_t)M * 4 * 4;
constexpr size_t WS_LISTW= WS_LIST + (size_t)NE * M * 4;
constexpr int HROWS = 65536 + NE * 256;
constexpr size_t WS_H    = WS_LISTW+ (size_t)NE * M * 4;
constexpr size_t WS_Y    = WS_H    + (size_t)HROWS * FF * 2;
constexpr size_t WS_WIN  = WS_Y    + (size_t)HROWS * DM * 2;
constexpr size_t WS_WOUT = WS_WIN  + (size_t)8448 * DM * 2;
constexpr size_t WS_WGU  = WS_WOUT + (size_t)DM * 3072 * 2;
constexpr size_t WS_WD   = WS_WGU  + (size_t)NE * 4096 * DM * 2;
constexpr size_t WS_END  = WS_WD   + (size_t)NE * DM * FF * 2;
constexpr int CW_BAR = 4096;
constexpr int CW_CNT = 8192;

__device__ __forceinline__ float bf2f(bf16_t v) { return __uint_as_float((unsigned)v << 16); }
__device__ __forceinline__ unsigned f2bf(float f) { unsigned u = __float_as_uint(f); return (u + 0x7fffu + ((u >> 16) & 1u)) >> 16; }
__device__ __forceinline__ unsigned pk2(float lo, float hi) { return f2bf(lo) | (f2bf(hi) << 16); }
__device__ __forceinline__ float wave_sum(float v) {
#pragma unroll
    for (int o = 1; o < 64; o <<= 1) v += __shfl_xor(v, o);
    return v;
}
__device__ __forceinline__ float sigmoidf_(float x) { return 1.0f / (1.0f + __expf(-x)); }
__device__ __forceinline__ float siluf_(float x) { return x / (1.0f + __expf(-x)); }
__device__ __forceinline__ float softplusf_(float x) { return x > 20.f ? x : log1pf(expf(x)); }
__device__ __forceinline__ float logsigmoidf_(float x) { return x < 0.f ? x - log1pf(expf(x)) : -log1pf(expf(-x)); }

#define XB_TMO      128
#define XB_XCNT(j)  (256  + 64 * (j))
#define XB_XSUB(j)  (1280 + 64 * (j))
#define XB_XGEN(j)  (2304 + 64 * (j))
#define XB_TOP      3328
#define XB_TOPGEN   3392
#define XCD_BAR_WORDS 3456
#define XB_SPIN_CAP (1u << 23)
__device__ __forceinline__ unsigned xb_ld(unsigned* p)              { return __hip_atomic_load(p, __ATOMIC_RELAXED, __HIP_MEMORY_SCOPE_AGENT); }
__device__ __forceinline__ unsigned xb_add(unsigned* p, unsigned v) { return __hip_atomic_fetch_add(p, v, __ATOMIC_RELAXED, __HIP_MEMORY_SCOPE_AGENT); }
__device__ __forceinline__ unsigned xb_xcc_id() { return (unsigned)__builtin_amdgcn_s_getreg((3 << 11) | 20) & 0xFu; }
#define XB_SPIN(cond, bar) do { unsigned _sp = 0; while (cond) { __builtin_amdgcn_s_sleep(1); \
    if ((++_sp & 255u) == 0u) { if (xb_ld(&(bar)[XB_TMO])) break; if (_sp > XB_SPIN_CAP) { atomicAdd(&(bar)[XB_TMO], 1u); break; } } } } while (0)
struct XcdBarrier { unsigned* bar; unsigned x; volatile LAS unsigned* st; };
__device__ __forceinline__ XcdBarrier xcd_barrier_post(unsigned* bar, volatile LAS unsigned* st) {
    XcdBarrier b; b.bar = bar; b.x = xb_xcc_id(); b.st = st;
    if (threadIdx.x == 0) (void)xb_add(&bar[XB_XCNT(b.x)], 1u);
    return b;
}
__device__ __forceinline__ void xcd_barrier_complete(unsigned* bar, unsigned x, unsigned& nloc, unsigned& nx) {
    const unsigned G = gridDim.x * gridDim.y * gridDim.z;
    unsigned sum, cnt, mine, sp = 0u;
    for (;;) {
        sum = 0u; cnt = 0u; mine = 0u;
#pragma unroll
        for (unsigned j = 0; j < 16; ++j) { const unsigned c = xb_ld(&bar[XB_XCNT(j)]); sum += c; cnt += (c > 0u) ? 1u : 0u; mine = (j == x) ? c : mine; }
        if (sum == G) break;
        __builtin_amdgcn_s_sleep(1);
        if ((++sp & 255u) == 0u) { if (xb_ld(&bar[XB_TMO])) break; if (sp > XB_SPIN_CAP) { atomicAdd(&bar[XB_TMO], 1u); break; } }
    }
    nloc = mine > 0u ? mine : 1u; nx = cnt > 0u ? cnt : 1u;
}
__device__ __forceinline__ void xcd_barrier(const XcdBarrier& b) {
    asm volatile("s_waitcnt vmcnt(0)" ::: "memory");
    __syncthreads();
    if (threadIdx.x == 0) {
        unsigned* bar = b.bar;
        __builtin_amdgcn_s_waitcnt(0);
        unsigned nloc = b.st[0], nx = b.st[1];
        if (nloc == 0u) { xcd_barrier_complete(bar, b.x, nloc, nx); b.st[0] = nloc; b.st[1] = nx; }
        const unsigned old = xb_add(&bar[XB_XSUB(b.x)], 1u);
        const unsigned gen = old / nloc;
        if (old + 1u == (gen + 1u) * nloc) {
            __builtin_amdgcn_fence(__ATOMIC_RELEASE, "agent");
            asm volatile("s_waitcnt vmcnt(0)" ::: "memory");
            const unsigned og = xb_add(&bar[XB_TOP], 1u);
            const unsigned tg = og / nx;
            if (og + 1u == (tg + 1u) * nx) xb_add(&bar[XB_TOPGEN], 1u);
            else XB_SPIN(xb_ld(&bar[XB_TOPGEN]) == tg, bar);
            __builtin_amdgcn_fence(__ATOMIC_ACQUIRE, "agent");
            xb_add(&bar[XB_XGEN(b.x)], 1u);
            asm volatile("s_waitcnt vmcnt(0)" ::: "memory");
        } else {
            XB_SPIN(xb_ld(&bar[XB_XGEN(b.x)]) == gen, bar);
            __builtin_amdgcn_fence(__ATOMIC_ACQUIRE, "agent");
            asm volatile("s_waitcnt vmcnt(0)" ::: "memory");
        }
    }
    __syncthreads();
}

struct Params { const float* in[21]; float* out; unsigned char* ws; int ph_lo, ph_hi; };
enum { I_X = 0, I_META, I_GMIX, I_WIN, I_FB, I_GATT, I_CW, I_CB, I_DTB, I_ALOG, I_DSKIP, I_GSSM, I_WOUT, I_GFFN, I_WR, I_BR, I_WGU, I_BGU, I_WD, I_BD, I_GFIN };
struct Frame {
    LAS unsigned char* lds; int tid, lane, wave, gw, NGW;
    const float* const* in; float* out; unsigned char* ws; unsigned* ctl;
};
constexpr int LDS_BYTES = 147456;
constexpr int MISC_OFF = 131072;

__device__ __forceinline__ void rmsnorm_row_bf16(const float* src, const float* gain, bf16_t* dst, int lane) {
    f32x4 v[8]; float ss = 0.f;
#pragma unroll
    for (int j = 0; j < 8; ++j) { v[j] = *(const f32x4*)(src + 4 * lane + 256 * j); ss += (v[j].x * v[j].x + v[j].y * v[j].y) + (v[j].z * v[j].z + v[j].w * v[j].w); }
    const float rstd = rsqrtf(wave_sum(ss) * (1.f / DM) + EPS);
#pragma unroll
    for (int j = 0; j < 8; ++j) { const f32x4 g = *(const f32x4*)(gain + 4 * lane + 256 * j);
        u32x2 w; w.x = pk2(v[j].x * rstd * g.x, v[j].y * rstd * g.y); w.y = pk2(v[j].z * rstd * g.z, v[j].w * rstd * g.w);
        *(u32x2*)(dst + 4 * lane + 256 * j) = w; }
}
__device__ __forceinline__ void ph0_prologue(Frame& F) {
    bf16_t* XN = (bf16_t*)(F.ws + WS_XN);
    for (int row = F.gw; row < M + 256; row += F.NGW) {
        bf16_t* dst = XN + (size_t)row * DM;
        if (row < M) rmsnorm_row_bf16(F.in[I_X] + (size_t)row * DM, F.in[I_GMIX], dst, F.lane);
        else if (row < M + NMETA) rmsnorm_row_bf16(F.in[I_META] + (size_t)(row - M) * DM, F.in[I_GMIX], dst, F.lane);
        else {
#pragma unroll
            for (int j = 0; j < 8; ++j) *(u32x2*)(dst + 4 * F.lane + 256 * j) = (u32x2){0u, 0u};
        }
    }
    const int gt = blockIdx.x * NTHREADS + F.tid, GT = gridDim.x * NTHREADS;
    for (int i = gt; i < NB * ROW_META * (AW / 8); i += GT) { const int r = i / (AW / 8), c = i % (AW / 8); const int sr = (r / ROW_META) * LP + (r % ROW_META);
        *(u32x4*)((bf16_t*)(F.ws + WS_K) + (size_t)sr * AW + c * 8) = (u32x4){0u, 0u, 0u, 0u};
        *(u32x4*)((bf16_t*)(F.ws + WS_V) + (size_t)sr * AW + c * 8) = (u32x4){0u, 0u, 0u, 0u}; }
    for (int i = gt; i < NB * ROW_META * (CC / 8); i += GT) { const int r = i / (CC / 8), c = i % (CC / 8); const int sr = (r / ROW_META) * LP + (r % ROW_META);
        *(u32x4*)((bf16_t*)(F.ws + WS_XBC) + (size_t)sr * CC + c * 8) = (u32x4){0u, 0u, 0u, 0u}; }
    for (int i = gt; i < NB * ROW_META * 12; i += GT) { const int r = i / 12, c = i % 12; const int sr = (r / ROW_META) * LP + (r % ROW_META);
        *(f32x4*)((float*)(F.ws + WS_FDT) + (size_t)sr * 48 + c * 4) = (f32x4){0.f, 0.f, 0.f, 0.f}; }
}

template <class AF, class BF, class SF>
__device__ __forceinline__ void gemm_tile_f32(Frame& F, int K, AF af, BF bf, SF sf) {
    LAS float* As = (LAS float*)F.lds;
    LAS float* Bs = As + 64 * 17 + 16;
    const int wr = F.wave >> 2, wc = F.wave & 3, l31 = F.lane & 31, hi = F.lane >> 5;
    f32x16 acc0, acc1;
#pragma unroll
    for (int i = 0; i < 16; ++i) { acc0[i] = 0.f; acc1[i] = 0.f; }
    for (int k0 = 0; k0 < K; k0 += 16) {
        float av[2], bv[8];
#pragma unroll
        for (int i = 0; i < 2; ++i) { const int idx = F.tid + NTHREADS * i; av[i] = af(idx >> 4, k0 + (idx & 15)); }
#pragma unroll
        for (int i = 0; i < 8; ++i) { const int idx = F.tid + NTHREADS * i; bv[i] = bf(k0 + (idx >> 8), idx & 255); }
        __syncthreads();
#pragma unroll
        for (int i = 0; i < 2; ++i) { const int idx = F.tid + NTHREADS * i; As[(idx >> 4) * 17 + (idx & 15)] = av[i]; }
#pragma unroll
        for (int i = 0; i < 8; ++i) { const int idx = F.tid + NTHREADS * i; Bs[(idx >> 8) * 260 + (idx & 255)] = bv[i]; }
        __syncthreads();
#pragma unroll
        for (int kk = 0; kk < 16; kk += 2) {
            const float a = As[(wr * 32 + l31) * 17 + kk + hi];
            const float b0 = Bs[(kk + hi) * 260 + wc * 64 + l31], b1 = Bs[(kk + hi) * 260 + wc * 64 + 32 + l31];
            acc0 = __builtin_amdgcn_mfma_f32_32x32x2f32(a, b0, acc0, 0, 0, 0);
            acc1 = __builtin_amdgcn_mfma_f32_32x32x2f32(a, b1, acc1, 0, 0, 0);
        }
    }
#pragma unroll
    for (int r = 0; r < 16; ++r) sf(wr * 32 + (r & 3) + 8 * (r >> 2) + 4 * hi, wc * 64 + l31, acc0[r], acc1[r]);
    __syncthreads();
}

__device__ __forceinline__ void inproj_route(Frame& F, int row, int col, float v) {
    if (col >= INC) return;
    bf16_t* Q = (bf16_t*)(F.ws + WS_Q); bf16_t* Kb = (bf16_t*)(F.ws + WS_K); bf16_t* Vb = (bf16_t*)(F.ws + WS_V); bf16_t* Z = (bf16_t*)(F.ws + WS_Z);
    bf16_t* XBC = (bf16_t*)(F.ws + WS_XBC); float* FDT = (float*)(F.ws + WS_FDT);
    const bool real = row < M; int sr0, nb;
    if (real) { sr0 = (row >> 12) * LP + ROW_REAL + (row & 4095); nb = 1; } else { sr0 = ROW_META + (row - M); nb = NB; }
    if (col < C_K) { if (real) Q[(size_t)row * AW + col] = (bf16_t)f2bf(v * QSCALE); return; }
    if (col >= C_Z && col < C_X) { if (real) Z[(size_t)row * SW + (col - C_Z)] = (bf16_t)f2bf(v); return; }
    for (int b = 0; b < nb; ++b) { const size_t sr = (size_t)sr0 + (size_t)b * LP;
        if (col < C_V) Kb[sr * AW + (col - C_K)] = (bf16_t)f2bf(v);
        else if (col < C_F) Vb[sr * AW + (col - C_V)] = (bf16_t)f2bf(v);
        else if (col < C_Z) FDT[sr * 48 + (col - C_F)] = v;
        else if (col < C_DT) XBC[sr * CC + (col - C_X)] = (bf16_t)f2bf(v);
        else FDT[sr * 48 + 16 + (col - C_DT)] = v; }
}
__device__ __forceinline__ void ph1_inproj_oracle(Frame& F) {
    const bf16_t* XN = (const bf16_t*)(F.ws + WS_XN); const float* W = F.in[I_WIN];
    constexpr int MR = M + NMETA, TM = (MR + 63) / 64, TN = (INC + 255) / 256;
    for (int tile = blockIdx.x; tile < TM * TN; tile += gridDim.x) {
        const int tm = tile / TN, tn = tile % TN;
        gemm_tile_f32(F, DM,
            [&](int r, int k) -> float { const int row = tm * 64 + r; return row < MR ? bf2f(XN[(size_t)row * DM + k]) : 0.f; },
            [&](int k, int c) -> float { const int col = tn * 256 + c; return col < INC ? W[(size_t)k * INC + col] : 0.f; },
            [&](int r, int c, float v0, float v1) { const int row = tm * 64 + r, col = tn * 256 + c; if (row < MR) { inproj_route(F, row, col, v0); inproj_route(F, row, col + 32, v1); } });
    }
}


namespace pg8 {
typedef short bf16x8 __attribute__((ext_vector_type(8)));
constexpr int BM = 256, BK = 64, HALF = 128, HTB = HALF * BK * 2, STAGE_BYTES = 8 * HTB, NXCD = 8, WGM = 8;
__host__ __device__ __forceinline__ int lds_byte(int r, int c) { const int st = (r >> 4) * 2 + (c >> 5), rr = r & 15, cc = c & 31, ob = rr * 64 + cc * 2; return st * 1024 + (ob ^ (((ob >> 9) & 1) << 5)); }
__host__ __device__ __forceinline__ void stage_rc(int b, int& R, int& C) { const int st = b / 1024, sb = b % 1024, swz = sb ^ (((sb >> 9) & 1) << 5); R = (st >> 1) * 16 + swz / 64; C = (st & 1) * 32 + (swz % 64) / 2; }
__host__ __device__ __forceinline__ int perm32(int rho) { const int n = rho >> 4, i = rho & 15; return 8 * (i >> 2) + 4 * n + (i & 3); }
struct Unit { int pm, pn, e, x; };
struct StaticOrder {
    int nM, nN, nwg, G, c; const char* A; const char* Bt; size_t tstep;
    __device__ void init(const void* A_, const void* Bt_, int M_, int N_, int K_, int G_, int c_) { A = (const char*)A_; Bt = (const char*)Bt_; nM = M_ / BM; nN = N_ / BM; nwg = nM * nN; G = G_; c = c_; tstep = (size_t)BM * K_ * 2; }
    __device__ __forceinline__ bool next(int i, Unit& u) const {
        const long L = (long)i * G + c; if (L >= nwg) return false;
        int wgid = (int)L; { const int q = nwg / NXCD, r = nwg % NXCD, xcd = wgid % NXCD, off = wgid / NXCD; wgid = (xcd < r ? xcd * (q + 1) : r * (q + 1) + (xcd - r) * q) + off; }
        const int nig = WGM * nN, gid = wgid / nig, fm = gid * WGM, gsz = (nM - fm) < WGM ? (nM - fm) : WGM;
        u.pm = fm + ((wgid % nig) % gsz); u.pn = (wgid % nig) / gsz; u.e = 0; u.x = 0; return true;
    }
    __device__ __forceinline__ const char* a_base(const Unit& u) const { return A + (size_t)u.pm * tstep; }
    __device__ __forceinline__ const char* b_base(const Unit& u) const { return Bt + (size_t)u.pn * tstep; }
    __device__ __forceinline__ int a_row(const Unit&, int) const { return 0; }
};
__device__ __forceinline__ unsigned cvt_pk_bf16(float lo, float hi) { unsigned r; asm volatile("v_cvt_pk_bf16_f32 %0, %1, %2" : "=v"(r) : "v"(lo), "v"(hi)); return r; }

template <class Epi, class Sched, bool GATHER, bool ALIGN_EPI>
__device__ __forceinline__ void gemm_phase(LAS unsigned char* lds, const int K, const Sched& S, const Epi& E) {
    const int tid = threadIdx.x, wid = __builtin_amdgcn_readfirstlane(tid >> 6), lane = tid & 63, wr = wid >> 2, wc = wid & 3, fr = lane & 15, fq = lane >> 4;
    const int nt = K / BK;
    unsigned voffB[2], offC[2][2], offN[2][2]; int Rr[2], Cc[2];
#pragma unroll
    for (int i = 0; i < 2; ++i) { int R, C; stage_rc(tid * 16 + i * 8192, R, C); const int Rb = Epi::PERM ? ((R & ~31) + perm32(R & 31)) : R;
        voffB[i] = (unsigned)(Rb * K + C) * 2u; Rr[i] = R; Cc[i] = C;
        offC[0][i] = (unsigned)(R * K + C) * 2u; offC[1][i] = (unsigned)((HALF + R) * K + C) * 2u; offN[0][i] = offC[0][i]; offN[1][i] = offC[1][i]; }
    const size_t kstep = (size_t)(BK * 2);
    const size_t hstep = (size_t)HALF * K * 2;
    const unsigned ldsw = (unsigned)wid * 1024u;
    const int aoff = lds_byte(wr * 64 + fr, fq * 8), boff = lds_byte(wc * 32 + fr, fq * 8);
#define PG8_SA(b, h) (((b) * 2 + (h)) * HTB)
#define PG8_SB(b, h) ((4 + (b) * 2 + (h)) * HTB)
#define PG8_GLDS(gp, bufoff, i) __builtin_amdgcn_global_load_lds((const unsigned*)(gp), (LAS unsigned*)(lds + (bufoff) + ldsw + (i) * 8192), 16, 0, 0)
#define PG8_STG_B(bufoff, ptr) do { PG8_GLDS((ptr) + voffB[0], bufoff, 0); PG8_GLDS((ptr) + voffB[1], bufoff, 1); } while (0)
#define PG8_STG_A(bufoff, ptr, o0, o1) do { PG8_GLDS((ptr) + (o0), bufoff, 0); PG8_GLDS((ptr) + (o1), bufoff, 1); } while (0)
#define PG8_LDA(dst, b, h) do { _Pragma("unroll") for (int m = 0; m < 4; ++m) _Pragma("unroll") for (int k = 0; k < 2; ++k) dst[m][k] = *(const LAS bf16x8*)(lds + PG8_SA(b, h) + aoff + m * 2048 + k * 1024); } while (0)
#define PG8_LDB(dst, b, h) do { _Pragma("unroll") for (int n = 0; n < 2; ++n) _Pragma("unroll") for (int k = 0; k < 2; ++k) dst[n][k] = *(const LAS bf16x8*)(lds + PG8_SB(b, h) + boff + n * 2048 + k * 1024); } while (0)
#define PG8_MMA(ai, bj, At, Bt) do { __builtin_amdgcn_s_setprio(1); _Pragma("unroll") for (int m = 0; m < 4; ++m) _Pragma("unroll") for (int n = 0; n < 2; ++n) _Pragma("unroll") for (int k = 0; k < 2; ++k) \
        acc[ai][bj][m][n] = __builtin_amdgcn_mfma_f32_16x16x32_bf16(Bt[n][k], At[m][k], acc[ai][bj][m][n], 0, 0, 0); __builtin_amdgcn_s_setprio(0); } while (0)
#define PG8_WAIT_V(n) asm volatile("s_waitcnt vmcnt(" #n ")" ::: "memory")
#define PG8_WAIT_L(n) asm volatile("s_waitcnt lgkmcnt(" #n ")" ::: "memory")
#define PG8_BAR __builtin_amdgcn_s_barrier()
#define PG8_SCHED __builtin_amdgcn_sched_barrier(0)
    Unit cur, nxt; int ui = 0;
    if (!S.next(0, cur)) return;
    bool has_next = S.next(1, nxt);
    if constexpr (GATHER) {
#pragma unroll
        for (int h = 0; h < 2; ++h)
#pragma unroll
            for (int i = 0; i < 2; ++i) { offC[h][i] = (unsigned)S.a_row(cur, h * HALF + Rr[i]) * (unsigned)(K * 2) + (unsigned)(Cc[i] * 2);
                offN[h][i] = (unsigned)S.a_row(has_next ? nxt : cur, h * HALF + Rr[i]) * (unsigned)(K * 2) + (unsigned)(Cc[i] * 2); }
        asm volatile("s_waitcnt vmcnt(0)" : "+v"(offC[0][0]), "+v"(offC[0][1]), "+v"(offC[1][0]), "+v"(offC[1][1]), "+v"(offN[0][0]), "+v"(offN[0][1]), "+v"(offN[1][0]), "+v"(offN[1][1]) :: "memory");
    }
    f32x4 acc[2][2][4][2];
#pragma unroll
    for (int a = 0; a < 2; ++a)
#pragma unroll
        for (int b = 0; b < 2; ++b)
#pragma unroll
            for (int m = 0; m < 4; ++m)
#pragma unroll
                for (int n = 0; n < 2; ++n) acc[a][b][m][n] = (f32x4){0.f, 0.f, 0.f, 0.f};
    bf16x8 At[4][2], B0[2][2], B1[2][2];
    const char* cA = S.a_base(cur); const char* cB = S.b_base(cur);
    PG8_STG_B(PG8_SB(0, 0), cB); PG8_STG_B(PG8_SB(0, 1), cB + hstep); PG8_STG_A(PG8_SA(0, 0), cA, offC[0][0], offC[0][1]); PG8_STG_A(PG8_SA(0, 1), cA, offC[1][0], offC[1][1]);
    if (wr == 1) PG8_BAR;
    PG8_WAIT_V(2); PG8_BAR;
    PG8_STG_B(PG8_SB(1, 0), cB + kstep); PG8_STG_A(PG8_SA(1, 0), cA + kstep, offC[0][0], offC[0][1]); PG8_STG_B(PG8_SB(1, 1), cB + hstep + kstep);
    PG8_WAIT_V(6); PG8_BAR;
    for (;;) {
        const char* nA = has_next ? S.a_base(nxt) : cA; const char* nB = has_next ? S.b_base(nxt) : cB;
        for (int t = 0; t < nt; t += 2) {
            const bool last = (t == nt - 2);
            const char* a1 = cA + (size_t)(t + 1) * kstep;
            const char* a2 = last ? nA : cA + (size_t)(t + 2) * kstep; const char* b2 = last ? nB : cB + (size_t)(t + 2) * kstep;
            const char* a3 = a2 + kstep; const char* b3 = b2 + kstep;
            unsigned o00 = offC[0][0], o01 = offC[0][1], o10 = offC[1][0], o11 = offC[1][1];
            if constexpr (GATHER) { if (last) { o00 = offN[0][0]; o01 = offN[0][1]; o10 = offN[1][0]; o11 = offN[1][1]; } }
            PG8_LDB(B0, 0, 0); PG8_LDB(B1, 0, 1); PG8_SCHED; PG8_LDA(At, 0, 0); PG8_STG_A(PG8_SA(1, 1), a1, offC[1][0], offC[1][1]);
            PG8_WAIT_V(8); PG8_WAIT_L(0); PG8_BAR; PG8_MMA(0, 0, At, B0); PG8_MMA(0, 1, At, B1); PG8_BAR; PG8_SCHED;
            PG8_LDA(At, 0, 1); PG8_STG_B(PG8_SB(0, 0), b2); PG8_STG_B(PG8_SB(0, 1), b2 + hstep); PG8_STG_A(PG8_SA(0, 0), a2, o00, o01);
            PG8_WAIT_V(8); PG8_WAIT_L(0); PG8_BAR; PG8_MMA(1, 0, At, B0); PG8_MMA(1, 1, At, B1); PG8_BAR; PG8_SCHED;
            PG8_LDB(B0, 1, 0); PG8_LDB(B1, 1, 1); PG8_SCHED; PG8_LDA(At, 1, 0); PG8_STG_A(PG8_SA(0, 1), a2, o10, o11);
            PG8_WAIT_V(8); PG8_WAIT_L(0); PG8_BAR; PG8_MMA(0, 0, At, B0); PG8_MMA(0, 1, At, B1); PG8_BAR; PG8_SCHED;
            PG8_LDA(At, 1, 1); PG8_STG_B(PG8_SB(1, 0), b3); PG8_STG_B(PG8_SB(1, 1), b3 + hstep); PG8_STG_A(PG8_SA(1, 0), a3, o00, o01);
            PG8_WAIT_V(8); PG8_WAIT_L(0); PG8_BAR; PG8_MMA(1, 0, At, B0); PG8_MMA(1, 1, At, B1); PG8_BAR; PG8_SCHED;
        }
        if constexpr (ALIGN_EPI) { if (wr == 0) PG8_BAR; }
        E(acc, cur, wr, wc, fr, fq);
        if (!has_next) break;
#pragma unroll
        for (int a = 0; a < 2; ++a)
#pragma unroll
            for (int b = 0; b < 2; ++b)
#pragma unroll
                for (int m = 0; m < 4; ++m)
#pragma unroll
                    for (int n = 0; n < 2; ++n) acc[a][b][m][n] = (f32x4){0.f, 0.f, 0.f, 0.f};
        cur = nxt; cA = nA; cB = nB; ++ui;
        has_next = S.next(ui + 1, nxt);
        if constexpr (GATHER) {
            int t2 = tid; asm volatile("" : "+v"(t2));
#pragma unroll
            for (int i = 0; i < 2; ++i) { int R, C; stage_rc(t2 * 16 + i * 8192, R, C);
#pragma unroll
                for (int h = 0; h < 2; ++h) { offC[h][i] = offN[h][i];
                    offN[h][i] = (unsigned)S.a_row(has_next ? nxt : cur, h * HALF + R) * (unsigned)(K * 2) + (unsigned)(C * 2); } }
            asm volatile("s_waitcnt vmcnt(0)" : "+v"(offN[0][0]), "+v"(offN[0][1]), "+v"(offN[1][0]), "+v"(offN[1][1]) :: "memory");
        }
        if constexpr (ALIGN_EPI) { if (wr == 1) PG8_BAR; }
    }
    PG8_WAIT_V(0);
    if constexpr (!ALIGN_EPI) { if (wr == 0) PG8_BAR; }
    PG8_BAR;
#undef PG8_SA
#undef PG8_SB
#undef PG8_GLDS
#undef PG8_STG_A
#undef PG8_STG_B
#undef PG8_LDA
#undef PG8_LDB
#undef PG8_MMA
#undef PG8_WAIT_V
#undef PG8_WAIT_L
#undef PG8_BAR
#undef PG8_SCHED
}
}

template <class RM>
__device__ __forceinline__ void transpose_item(const float* W, int K, int N, bf16_t* WT, LAS float* scr, int item, int lane, RM rm) {
    const int nblk = (N + 31) / 32, kb = item / nblk, nb = item % nblk, k0 = 64 * kb, n0 = 32 * nb;
    const bool nok = n0 + (lane & 31) < N;
#pragma unroll 8
    for (int i = 0; i < 32; ++i) { const int kk = 2 * i + (lane >> 5); scr[kk * 33 + (lane & 31)] = nok ? W[(size_t)(k0 + kk) * N + n0 + (lane & 31)] : 0.f; }
    asm volatile("s_waitcnt lgkmcnt(0)" ::: "memory");
    const int c = lane & 7;
#pragma unroll
    for (int j = 0; j < 4; ++j) { const int n = (lane >> 3) + 8 * j; const LAS float* s = scr + (8 * c) * 33 + n;
        u32x4 o; o.x = pk2(s[0 * 33], s[1 * 33]); o.y = pk2(s[2 * 33], s[3 * 33]); o.z = pk2(s[4 * 33], s[5 * 33]); o.w = pk2(s[6 * 33], s[7 * 33]);
        if (n0 + n < N) *(u32x4*)(WT + (size_t)rm(n0 + n) * K + k0 + 8 * c) = o; }
    asm volatile("s_waitcnt lgkmcnt(0)" ::: "memory");
}
constexpr int INC_P = 8448;
__device__ __forceinline__ int win_remap(int c) { return c < C_F ? c : c < C_Z ? 8192 + (c - C_F) : c < C_X ? 3072 + (c - C_Z) : c < C_DT ? 5120 + (c - C_X) : 8208 + (c - C_DT); }
__device__ __forceinline__ void ph0_weights(Frame& F, bool moe) {
    LAS float* scr = (LAS float*)(F.lds + F.wave * 16384);
    bf16_t* WinT = (bf16_t*)(F.ws + WS_WIN); bf16_t* WoutT = (bf16_t*)(F.ws + WS_WOUT); bf16_t* WguT = (bf16_t*)(F.ws + WS_WGU); bf16_t* WdT = (bf16_t*)(F.ws + WS_WD);
    constexpr int I_IN = (DM / 64) * ((INC + 31) / 32), I_OUT = (3072 / 64) * (DM / 32), I_GU = (DM / 64) * (4096 / 32), I_D = (FF / 64) * (DM / 32);
    const int total = I_IN + I_OUT + (moe ? NE * (I_GU + I_D) : 0);
    for (int it = F.gw; it < total; it += F.NGW) {
        int r = it;
        if (r < I_IN) { transpose_item(F.in[I_WIN], DM, INC, WinT, scr, r, F.lane, [](int n) { return win_remap(n); }); continue; } r -= I_IN;
        if (r < I_OUT) { transpose_item(F.in[I_WOUT], 3072, DM, WoutT, scr, r, F.lane, [](int n) { return n; }); continue; } r -= I_OUT;
        if (r < NE * I_GU) { const int e = r / I_GU; transpose_item(F.in[I_WGU] + (size_t)e * DM * 4096, DM, 4096, WguT + (size_t)e * 4096 * DM, scr, r % I_GU, F.lane,
            [](int n) { const int j = n & 2047; return (j >> 7) * 256 + (n >> 11) * 128 + (j & 127); }); continue; } r -= NE * I_GU;
        { const int e = r / I_D; transpose_item(F.in[I_WD] + (size_t)e * FF * DM, FF, DM, WdT + (size_t)e * DM * FF, scr, r % I_D, F.lane, [](int n) { return n; }); }
    }
    const int gt = blockIdx.x * NTHREADS + F.tid, GT = gridDim.x * NTHREADS;
    for (int i = gt; i < (INC_P - INC) * (DM / 8); i += GT) *(u32x4*)(WinT + (size_t)INC * DM + (size_t)i * 8) = (u32x4){0u, 0u, 0u, 0u};
}

struct EpiInproj {
    static constexpr bool PERM = true;
    unsigned char* ws;
    __device__ __forceinline__ void operator()(const f32x4 (&acc)[2][2][4][2], const pg8::Unit& u, int wr, int wc, int fr, int fq) const {
        asm volatile("" : "+v"(fr), "+v"(fq));
        const int pn = u.pn, pm = u.pm; const bool meta = pm >= M / 256;
        if (pn < 32) {
            bf16_t* base; int ld, colt; bool seq; float sc = 1.f;
            if (pn < 4) { base = (bf16_t*)(ws + WS_Q); ld = AW; colt = pn * 256; seq = false; sc = QSCALE; }
            else if (pn < 8) { base = (bf16_t*)(ws + WS_K); ld = AW; colt = (pn - 4) * 256; seq = true; }
            else if (pn < 12) { base = (bf16_t*)(ws + WS_V); ld = AW; colt = (pn - 8) * 256; seq = true; }
            else if (pn < 20) { base = (bf16_t*)(ws + WS_Z); ld = SW; colt = (pn - 12) * 256; seq = false; }
            else { base = (bf16_t*)(ws + WS_XBC); ld = CC; colt = (pn - 20) * 256; seq = true; }
            if (meta && !seq) return;
            const int col0 = colt + wc * 32 + 8 * fq;
#pragma unroll
            for (int ai = 0; ai < 2; ++ai)
#pragma unroll
                for (int m = 0; m < 4; ++m) { const int r = ai * 128 + wr * 64 + m * 16 + fr;
                    u32x4 w[2];
#pragma unroll
                    for (int bj = 0; bj < 2; ++bj) { const f32x4 v0 = acc[ai][bj][m][0] * sc, v1 = acc[ai][bj][m][1] * sc;
                        w[bj].x = pg8::cvt_pk_bf16(v0[0], v0[1]); w[bj].y = pg8::cvt_pk_bf16(v0[2], v0[3]); w[bj].z = pg8::cvt_pk_bf16(v1[0], v1[1]); w[bj].w = pg8::cvt_pk_bf16(v1[2], v1[3]); }
                    if (!meta) { const int mrow = pm * 256 + r; const size_t drow = seq ? (size_t)(mrow + ROW_REAL * ((mrow >> 12) + 1)) : (size_t)mrow;
                        bf16_t* rowp = base + drow * ld + col0; *(u32x4*)rowp = w[0]; *(u32x4*)(rowp + 128) = w[1]; }
                    else if (r < NMETA) {
#pragma unroll
                        for (int b = 0; b < NB; ++b) { bf16_t* rowp = base + (size_t)(b * LP + ROW_META + r) * ld + col0; *(u32x4*)rowp = w[0]; *(u32x4*)(rowp + 128) = w[1]; } }
                }
        } else {
            float* FDT = (float*)(ws + WS_FDT);
            const int col0 = wc * 32 + 8 * fq;
            if (col0 >= 48) return;
#pragma unroll
            for (int ai = 0; ai < 2; ++ai)
#pragma unroll
                for (int m = 0; m < 4; ++m) { const int r = ai * 128 + wr * 64 + m * 16 + fr;
                    if (!meta) { const int mrow = pm * 256 + r; float* rowp = FDT + (size_t)(mrow + ROW_REAL * ((mrow >> 12) + 1)) * 48 + col0;
                        *(f32x4*)rowp = acc[ai][0][m][0]; *(f32x4*)(rowp + 4) = acc[ai][0][m][1]; }
                    else if (r < NMETA) {
#pragma unroll
                        for (int b = 0; b < NB; ++b) { float* rowp = FDT + (size_t)(b * LP + ROW_META + r) * 48 + col0; *(f32x4*)rowp = acc[ai][0][m][0]; *(f32x4*)(rowp + 4) = acc[ai][0][m][1]; } }
                }
        }
    }
};
__device__ __forceinline__ void ph1_inproj(Frame& F) {
    pg8::StaticOrder S; S.init(F.ws + WS_XN, F.ws + WS_WIN, M + 256, INC_P, DM, gridDim.x, blockIdx.x);
    EpiInproj E{F.ws};
    pg8::gemm_phase<EpiInproj, pg8::StaticOrder, false, true>(F.lds, DM, S, E);
}
struct EpiOutproj {
    static constexpr bool PERM = false;
    const float* x; float* out;
    __device__ __forceinline__ void operator()(const f32x4 (&acc)[2][2][4][2], const pg8::Unit& u, int wr, int wc, int fr, int fq) const {
        asm volatile("" : "+v"(fr), "+v"(fq));
        const int col0 = u.pn * 256 + wc * 32 + 4 * fq;
#pragma unroll
        for (int ai = 0; ai < 2; ++ai)
#pragma unroll
            for (int m = 0; m < 4; ++m) { const size_t off = (size_t)(u.pm * 256 + ai * 128 + wr * 64 + m * 16 + fr) * DM + col0;
#pragma unroll
                for (int bj = 0; bj < 2; ++bj)
#pragma unroll
                    for (int n = 0; n < 2; ++n) { const f32x4 xv = *(const f32x4*)(x + off + bj * 128 + n * 16); *(f32x4*)(out + off + bj * 128 + n * 16) = xv + acc[ai][bj][m][n]; } }
    }
};
__device__ __forceinline__ void ph4_outproj(Frame& F) {
    pg8::StaticOrder S; S.init(F.ws + WS_A2, F.ws + WS_WOUT, M, DM, 3072, gridDim.x, blockIdx.x);
    EpiOutproj E{F.in[I_X], F.out};
    pg8::gemm_phase<EpiOutproj, pg8::StaticOrder, false, true>(F.lds, 3072, S, E);
}

__device__ __forceinline__ void ph1b_conv_scan(Frame& F) {
    const bf16_t* XBC = (const bf16_t*)(F.ws + WS_XBC); bf16_t* XC = (bf16_t*)(F.ws + WS_XC);
    const float* FDT = (const float*)(F.ws + WS_FDT); float* DT = (float*)(F.ws + WS_DT); float* CF = (float*)(F.ws + WS_CF);
    const float* cw = F.in[I_CW]; const float* cb = F.in[I_CB];
    const int gt = blockIdx.x * NTHREADS + F.tid, GT = gridDim.x * NTHREADS;
    for (int i = gt; i < SR * (CC / 8); i += GT) {
        const int sr = i / (CC / 8), cv = i % (CC / 8), pos = sr % LP, c0 = cv * 8;
        u32x4 o = (u32x4){0u, 0u, 0u, 0u};
        if (pos >= ROW_META) {
            float acc[8];
#pragma unroll
            for (int j = 0; j < 8; ++j) acc[j] = cb[c0 + j];
#pragma unroll
            for (int k = 0; k < 4; ++k) { const u32x4 xv = *(const u32x4*)(XBC + (size_t)(sr - 3 + k) * CC + c0);
                const unsigned xw[4] = {xv.x, xv.y, xv.z, xv.w};
#pragma unroll
                for (int j = 0; j < 8; ++j) { const float xf = __uint_as_float((j & 1) ? (xw[j >> 1] & 0xffff0000u) : (xw[j >> 1] << 16)); acc[j] += cw[k * CC + c0 + j] * xf; } }
            o.x = pk2(siluf_(acc[0]), siluf_(acc[1])); o.y = pk2(siluf_(acc[2]), siluf_(acc[3])); o.z = pk2(siluf_(acc[4]), siluf_(acc[5])); o.w = pk2(siluf_(acc[6]), siluf_(acc[7]));
        }
        *(u32x4*)(XC + (size_t)sr * CC + c0) = o;
    }
    for (int i = gt; i < SR * SH; i += GT) { const int sr = i / SH, h = i % SH, pos = sr % LP;
        DT[i] = pos >= ROW_META ? softplusf_(FDT[(size_t)sr * 48 + 16 + h] + F.in[I_DTB][h]) : 0.f; }
    LAS float* red = (LAS float*)F.lds;
    for (int w = blockIdx.x; w < NB * AH; w += gridDim.x) {
        const int b = w / AH, h = w % AH; const float fb = F.in[I_FB][h];
        float v[9]; float run = 0.f;
#pragma unroll
        for (int j = 0; j < 9; ++j) { const int pos = F.tid * 9 + j; float lf = 0.f;
            if (pos >= ROW_META && pos < LP) lf = logsigmoidf_(FDT[(size_t)(b * LP + pos) * 48 + h] + fb);
            run += lf; v[j] = run; }
        __syncthreads();
        red[F.tid] = run;
        __syncthreads();
        if (F.tid == 0) { float s = 0.f; for (int i = 0; i < NTHREADS; ++i) { const float t = red[i]; red[i] = s; s += t; } }
        __syncthreads();
        const float off = red[F.tid];
#pragma unroll
        for (int j = 0; j < 9; ++j) { const int pos = F.tid * 9 + j; if (pos < LP) CF[(size_t)(b * LP + pos) * 16 + h] = v[j] + off; }
        __syncthreads();
    }
}

__device__ __forceinline__ void ph2_attn_oracle(Frame& F) {
    const bf16_t* Q = (const bf16_t*)(F.ws + WS_Q); const bf16_t* Kb = (const bf16_t*)(F.ws + WS_K); const bf16_t* Vb = (const bf16_t*)(F.ws + WS_V);
    const float* CF = (const float*)(F.ws + WS_CF); bf16_t* O = (bf16_t*)(F.ws + WS_O);
    for (int task = F.gw; task < NB * AH * 64; task += F.NGW) {
        const int tb = 63 - (task % 64), bh = task / 64, b = bh / AH, h = bh % AH;
        const int t = tb * 64 + F.lane, m = b * SEQ + t, srq = b * LP + ROW_REAL + t;
        float q[64], o[64];
#pragma unroll
        for (int d = 0; d < 64; d += 8) { const u32x4 w = *(const u32x4*)(Q + (size_t)m * AW + h * HD + d);
            q[d] = __uint_as_float(w.x << 16); q[d + 1] = __uint_as_float(w.x & 0xffff0000u); q[d + 2] = __uint_as_float(w.y << 16); q[d + 3] = __uint_as_float(w.y & 0xffff0000u);
            q[d + 4] = __uint_as_float(w.z << 16); q[d + 5] = __uint_as_float(w.z & 0xffff0000u); q[d + 6] = __uint_as_float(w.w << 16); q[d + 7] = __uint_as_float(w.w & 0xffff0000u); }
#pragma unroll
        for (int d = 0; d < 64; ++d) o[d] = 0.f;
        const float ct = CF[(size_t)srq * 16 + h] * LOG2E;
        float mrun = -INFINITY, l = 0.f;
        const int s_end = b * LP + ROW_REAL + tb * 64 + 63;
        for (int srk = b * LP + ROW_META; srk <= s_end; ++srk) {
            const unsigned* kp = (const unsigned*)(Kb + (size_t)srk * AW + h * HD);
            float dot = 0.f;
#pragma unroll
            for (int d = 0; d < 32; ++d) { const unsigned w = kp[d]; dot += q[2 * d] * __uint_as_float(w << 16); dot += q[2 * d + 1] * __uint_as_float(w & 0xffff0000u); }
            float s = dot + ct - CF[(size_t)srk * 16 + h] * LOG2E;
            if (srk > srq) s = -INFINITY;
            const float mnew = fmaxf(mrun, s);
            const float alpha = exp2f(mrun - mnew), p = exp2f(s - mnew);
            l = l * alpha + p; mrun = mnew;
            const unsigned* vp = (const unsigned*)(Vb + (size_t)srk * AW + h * HD);
#pragma unroll
            for (int d = 0; d < 32; ++d) { const unsigned w = vp[d]; o[2 * d] = o[2 * d] * alpha + p * __uint_as_float(w << 16); o[2 * d + 1] = o[2 * d + 1] * alpha + p * __uint_as_float(w & 0xffff0000u); }
        }
        const float rl = 1.f / l;
#pragma unroll
        for (int d = 0; d < 64; d += 8) { u32x4 w; w.x = pk2(o[d] * rl, o[d + 1] * rl); w.y = pk2(o[d + 2] * rl, o[d + 3] * rl); w.z = pk2(o[d + 4] * rl, o[d + 5] * rl); w.w = pk2(o[d + 6] * rl, o[d + 7] * rl);
            *(u32x4*)(O + (size_t)m * AW + h * HD + d) = w; }
    }
}

__device__ __forceinline__ void ph2_ssd_oracle(Frame& F) {
    const bf16_t* XC = (const bf16_t*)(F.ws + WS_XC); const float* DT = (const float*)(F.ws + WS_DT); bf16_t* YS = (bf16_t*)(F.ws + WS_YS);
    for (int task = F.NGW - 1 - F.gw; task < NB * SH; task += F.NGW) {
        const int b = task / SH, h = task % SH, g = h / (SH / SG);
        const float A = -expf(F.in[I_ALOG][h]), Dh = F.in[I_DSKIP][h];
        float hs[128];
#pragma unroll
        for (int n = 0; n < 128; ++n) hs[n] = 0.f;
        for (int pos = ROW_META; pos < LP; ++pos) {
            const size_t sr = (size_t)b * LP + pos;
            const float dt = DT[sr * SH + h], dec = expf(dt * A);
            const float x = bf2f(XC[sr * CC + h * SP + F.lane]), xdt = x * dt;
            const unsigned* bp = (const unsigned*)(XC + sr * CC + SW + g * SN); const unsigned* cp = (const unsigned*)(XC + sr * CC + SW + SG * SN + g * SN);
            float y = 0.f;
#pragma unroll
            for (int n = 0; n < 64; ++n) { const unsigned bw = bp[n], cw = cp[n];
                hs[2 * n] = dec * hs[2 * n] + __uint_as_float(bw << 16) * xdt; y += __uint_as_float(cw << 16) * hs[2 * n];
                hs[2 * n + 1] = dec * hs[2 * n + 1] + __uint_as_float(bw & 0xffff0000u) * xdt; y += __uint_as_float(cw & 0xffff0000u) * hs[2 * n + 1]; }
            y += Dh * x;
            if (pos >= ROW_REAL) YS[(size_t)(b * SEQ + pos - ROW_REAL) * SW + h * SP + F.lane] = (bf16_t)f2bf(y);
        }
    }
}

__device__ __forceinline__ void ph3_norms(Frame& F) {
    const bf16_t* O = (const bf16_t*)(F.ws + WS_O); const bf16_t* YS = (const bf16_t*)(F.ws + WS_YS); const bf16_t* Z = (const bf16_t*)(F.ws + WS_Z); bf16_t* A2 = (bf16_t*)(F.ws + WS_A2);
    const float* ga = F.in[I_GATT]; const float* gs = F.in[I_GSSM];
    for (int m = F.gw; m < M; m += F.NGW) {
        float a[16]; float ss = 0.f;
#pragma unroll
        for (int j = 0; j < 2; ++j) { const u32x4 w = *(const u32x4*)(O + (size_t)m * AW + 8 * F.lane + 512 * j); const unsigned ww[4] = {w.x, w.y, w.z, w.w};
#pragma unroll
            for (int i = 0; i < 4; ++i) { a[8 * j + 2 * i] = __uint_as_float(ww[i] << 16); a[8 * j + 2 * i + 1] = __uint_as_float(ww[i] & 0xffff0000u); } }
#pragma unroll
        for (int i = 0; i < 16; ++i) ss += a[i] * a[i];
        float rstd = rsqrtf(wave_sum(ss) * (1.f / AW) + EPS);
#pragma unroll
        for (int j = 0; j < 2; ++j) { const int c0 = 8 * F.lane + 512 * j; u32x4 w;
            w.x = pk2(a[8 * j] * rstd * ga[c0], a[8 * j + 1] * rstd * ga[c0 + 1]); w.y = pk2(a[8 * j + 2] * rstd * ga[c0 + 2], a[8 * j + 3] * rstd * ga[c0 + 3]);
            w.z = pk2(a[8 * j + 4] * rstd * ga[c0 + 4], a[8 * j + 5] * rstd * ga[c0 + 5]); w.w = pk2(a[8 * j + 6] * rstd * ga[c0 + 6], a[8 * j + 7] * rstd * ga[c0 + 7]);
            *(u32x4*)(A2 + (size_t)m * 3072 + c0) = w; }
        float y[32]; ss = 0.f;
#pragma unroll
        for (int j = 0; j < 4; ++j) { const u32x4 w = *(const u32x4*)(YS + (size_t)m * SW + 8 * F.lane + 512 * j); const u32x4 zz = *(const u32x4*)(Z + (size_t)m * SW + 8 * F.lane + 512 * j);
            const unsigned ww[4] = {w.x, w.y, w.z, w.w}, zw[4] = {zz.x, zz.y, zz.z, zz.w};
#pragma unroll
            for (int i = 0; i < 4; ++i) { y[8 * j + 2 * i] = __uint_as_float(ww[i] << 16) * siluf_(__uint_as_float(zw[i] << 16)); y[8 * j + 2 * i + 1] = __uint_as_float(ww[i] & 0xffff0000u) * siluf_(__uint_as_float(zw[i] & 0xffff0000u)); } }
#pragma unroll
        for (int i = 0; i < 32; ++i) ss += y[i] * y[i];
        rstd = rsqrtf(wave_sum(ss) * (1.f / SW) + EPS);
#pragma unroll
        for (int j = 0; j < 4; ++j) { const int c0 = 8 * F.lane + 512 * j; u32x4 w;
            w.x = pk2(y[8 * j] * rstd * gs[c0], y[8 * j + 1] * rstd * gs[c0 + 1]); w.y = pk2(y[8 * j + 2] * rstd * gs[c0 + 2], y[8 * j + 3] * rstd * gs[c0 + 3]);
            w.z = pk2(y[8 * j + 4] * rstd * gs[c0 + 4], y[8 * j + 5] * rstd * gs[c0 + 5]); w.w = pk2(y[8 * j + 6] * rstd * gs[c0 + 6], y[8 * j + 7] * rstd * gs[c0 + 7]);
            *(u32x4*)(A2 + (size_t)m * 3072 + AW + c0) = w; }
    }
}

__device__ __forceinline__ void ph4_outproj_oracle(Frame& F) {
    const bf16_t* A2 = (const bf16_t*)(F.ws + WS_A2); const float* W = F.in[I_WOUT]; const float* X = F.in[I_X]; float* H1 = F.out;
    constexpr int TM = M / 64, TN = DM / 256;
    for (int tile = blockIdx.x; tile < TM * TN; tile += gridDim.x) {
        const int tm = tile / TN, tn = tile % TN;
        gemm_tile_f32(F, 3072,
            [&](int r, int k) -> float { return bf2f(A2[(size_t)(tm * 64 + r) * 3072 + k]); },
            [&](int k, int c) -> float { return W[(size_t)k * DM + tn * 256 + c]; },
            [&](int r, int c, float v0, float v1) { const size_t o = (size_t)(tm * 64 + r) * DM + tn * 256 + c; H1[o] = X[o] + v0; H1[o + 32] = X[o + 32] + v1; });
    }
}

__device__ __forceinline__ void ph5_router(Frame& F) {
    const float* H1 = F.out; bf16_t* XN2 = (bf16_t*)(F.ws + WS_XN2); const float* g = F.in[I_GFFN]; const float* WR = F.in[I_WR]; const float* BR = F.in[I_BR];
    int* TOKE = (int*)(F.ws + WS_TOKE); int* TOKP = (int*)(F.ws + WS_TOKP); int* LIST = (int*)(F.ws + WS_LIST); float* LISTW = (float*)(F.ws + WS_LISTW);
    for (int m = F.gw; m < M; m += F.NGW) {
        f32x4 v[8]; float ss = 0.f;
#pragma unroll
        for (int j = 0; j < 8; ++j) { v[j] = *(const f32x4*)(H1 + (size_t)m * DM + 4 * F.lane + 256 * j); ss += (v[j].x * v[j].x + v[j].y * v[j].y) + (v[j].z * v[j].z + v[j].w * v[j].w); }
        const float rstd = rsqrtf(wave_sum(ss) * (1.f / DM) + EPS);
        float part[32];
#pragma unroll
        for (int e = 0; e < 32; ++e) part[e] = 0.f;
#pragma unroll
        for (int j = 0; j < 8; ++j) { const f32x4 gg = *(const f32x4*)(g + 4 * F.lane + 256 * j);
            v[j].x *= rstd * gg.x; v[j].y *= rstd * gg.y; v[j].z *= rstd * gg.z; v[j].w *= rstd * gg.w;
            u32x2 w; w.x = pk2(v[j].x, v[j].y); w.y = pk2(v[j].z, v[j].w);
            *(u32x2*)(XN2 + (size_t)m * DM + 4 * F.lane + 256 * j) = w;
#pragma unroll
            for (int i = 0; i < 4; ++i) { const float nv = v[j][i]; const float* wr = WR + (size_t)(4 * F.lane + 256 * j + i) * NE;
#pragma unroll
                for (int e4 = 0; e4 < 8; ++e4) { const f32x4 ww = *(const f32x4*)(wr + 4 * e4);
                    part[4 * e4] += nv * ww.x; part[4 * e4 + 1] += nv * ww.y; part[4 * e4 + 2] += nv * ww.z; part[4 * e4 + 3] += nv * ww.w; } } }
        float logit = 0.f;
#pragma unroll
        for (int e = 0; e < 32; ++e) { const float s = wave_sum(part[e]); if (F.lane == e) logit = s; }
        logit = (F.lane < 32) ? logit + BR[F.lane & 31] : -INFINITY;
        float tv[4]; int ti[4]; float cur = logit;
#pragma unroll
        for (int k = 0; k < 4; ++k) {
            float bv = cur; int bi = F.lane;
#pragma unroll
            for (int o = 1; o < 64; o <<= 1) { const float ov = __shfl_xor(bv, o); const int oi = __shfl_xor(bi, o); if (ov > bv || (ov == bv && oi < bi)) { bv = ov; bi = oi; } }
            tv[k] = bv; ti[k] = bi; if (F.lane == bi) cur = -INFINITY;
        }
        const float e0 = 1.f, e1 = __expf(tv[1] - tv[0]), e2 = __expf(tv[2] - tv[0]), e3 = __expf(tv[3] - tv[0]); const float rs = 1.f / (e0 + e1 + e2 + e3);
        if (F.lane < 4) {
            const int e = F.lane == 0 ? ti[0] : F.lane == 1 ? ti[1] : F.lane == 2 ? ti[2] : ti[3];
            const float w = (F.lane == 0 ? e0 : F.lane == 1 ? e1 : F.lane == 2 ? e2 : e3) * rs;
            const int pos = (int)__hip_atomic_fetch_add(F.ctl + CW_CNT + 64 * e, 1u, __ATOMIC_RELAXED, __HIP_MEMORY_SCOPE_AGENT);
            TOKE[m * 4 + F.lane] = e; TOKP[m * 4 + F.lane] = pos; LIST[(size_t)e * M + pos] = m; LISTW[(size_t)e * M + pos] = w;
        }
    }
}

constexpr int TAB_OFF = MISC_OFF + 256;
__device__ __forceinline__ void load_expert_tables(Frame& F, LAS int* tab) {
    __syncthreads();
    if (F.tid == 0) { int rb = 0, tb = 0, t2 = 0;
        for (int e = 0; e < NE; ++e) { const int c = (int)__hip_atomic_load(F.ctl + CW_CNT + 64 * e, __ATOMIC_RELAXED, __HIP_MEMORY_SCOPE_AGENT);
            tab[e] = c; tab[32 + e] = rb; tab[64 + e] = tb; tab[128 + e] = t2; rb += ((c + 255) / 256) * 256; tb += (c + 63) / 64; t2 += (c + 255) / 256; }
        tab[96] = tb; tab[160] = t2; }
    __syncthreads();
}
struct GroupedOrder {
    const LAS int* tab; int NT, G, c, nwg; const char* A; const char* W; size_t wstride, tstep; const int* LIST; bool gather;
    __device__ __forceinline__ bool next(int i, pg8::Unit& u) const {
        const int L = i * G + c; if (L >= nwg) return false;
        int wgid = L; { const int q = nwg / 8, r = nwg % 8, xcd = wgid % 8, off = wgid / 8; wgid = (xcd < r ? xcd * (q + 1) : r * (q + 1) + (xcd - r) * q) + off; }
        int e = 0;
        for (int k = 1; k < NE; ++k) if (tab[128 + k] * NT <= wgid) e = k;
        e = __builtin_amdgcn_readfirstlane(e);
        const int t0 = __builtin_amdgcn_readfirstlane(tab[128 + e]), t1 = __builtin_amdgcn_readfirstlane(tab[128 + e + 1]);
        const int idx = wgid - t0 * NT, tiles = t1 - t0;
        u.x = idx % tiles; u.pn = idx / tiles; u.e = e; u.pm = t0 + u.x; return true;
    }
    __device__ __forceinline__ const char* a_base(const pg8::Unit& u) const { return gather ? A : A + (size_t)u.pm * tstep; }
    __device__ __forceinline__ const char* b_base(const pg8::Unit& u) const { return W + (size_t)u.e * wstride + (size_t)u.pn * tstep; }
    __device__ __forceinline__ int a_row(const pg8::Unit& u, int R) const { const int cnt = __builtin_amdgcn_readfirstlane(tab[u.e]); int pos = u.x * 256 + R; pos = pos < cnt ? pos : cnt - 1; return LIST[(size_t)u.e * M + pos]; }
};
struct EpiGateUp {
    static constexpr bool PERM = true;
    bf16_t* H; const float* Bgu;
    __device__ __forceinline__ void operator()(const f32x4 (&acc)[2][2][4][2], const pg8::Unit& u, int wr, int wc, int fr, int fq) const {
        asm volatile("" : "+v"(fr), "+v"(fq));
        const int j0 = u.pn * 128 + wc * 32 + 8 * fq; const float* bg = Bgu + (size_t)u.e * 4096 + j0;
        const f32x4 bg0 = *(const f32x4*)bg, bg1 = *(const f32x4*)(bg + 4), bu0 = *(const f32x4*)(bg + 2048), bu1 = *(const f32x4*)(bg + 2052);
#pragma unroll
        for (int ai = 0; ai < 2; ++ai)
#pragma unroll
            for (int m = 0; m < 4; ++m) { const int r = ai * 128 + wr * 64 + m * 16 + fr; float h[8];
#pragma unroll
                for (int n = 0; n < 2; ++n) { const f32x4 gv = acc[ai][0][m][n] + (n ? bg1 : bg0), uv = acc[ai][1][m][n] + (n ? bu1 : bu0);
#pragma unroll
                    for (int i = 0; i < 4; ++i) { const float g = fminf(gv[i], 7.f), uu = fminf(fmaxf(uv[i], -7.f), 7.f);
                        h[4 * n + i] = g * __builtin_amdgcn_rcpf(1.f + __expf(-1.702f * g)) * (uu + 1.f); } }
                u32x4 w; w.x = pg8::cvt_pk_bf16(h[0], h[1]); w.y = pg8::cvt_pk_bf16(h[2], h[3]); w.z = pg8::cvt_pk_bf16(h[4], h[5]); w.w = pg8::cvt_pk_bf16(h[6], h[7]);
                *(u32x4*)(H + (size_t)(u.pm * 256 + r) * FF + j0) = w; }
    }
};
__device__ __forceinline__ void ph6_gateup(Frame& F) {
    LAS int* tab = (LAS int*)(F.lds + TAB_OFF);
    load_expert_tables(F, tab);
    GroupedOrder S{tab, 16, (int)gridDim.x, (int)blockIdx.x, __builtin_amdgcn_readfirstlane(tab[160]) * 16, (const char*)(F.ws + WS_XN2), (const char*)(F.ws + WS_WGU), (size_t)4096 * DM * 2, (size_t)256 * DM * 2, (const int*)(F.ws + WS_LIST), true};
    EpiGateUp E{(bf16_t*)(F.ws + WS_H), F.in[I_BGU]};
    pg8::gemm_phase<EpiGateUp, GroupedOrder, true, true>(F.lds, DM, S, E);
}
struct EpiDown {
    static constexpr bool PERM = true;
    bf16_t* Y; const float* Bd; const float* LISTW;
    __device__ __forceinline__ void operator()(const f32x4 (&acc)[2][2][4][2], const pg8::Unit& u, int wr, int wc, int fr, int fq) const {
        asm volatile("" : "+v"(fr), "+v"(fq));
        const int col0 = u.pn * 256 + wc * 32 + 8 * fq; const float* bd = Bd + (size_t)u.e * DM + col0;
        f32x4 bv[2][2];
#pragma unroll
        for (int bj = 0; bj < 2; ++bj)
#pragma unroll
            for (int n = 0; n < 2; ++n) bv[bj][n] = *(const f32x4*)(bd + bj * 128 + 4 * n);
#pragma unroll
        for (int ai = 0; ai < 2; ++ai)
#pragma unroll
            for (int m = 0; m < 4; ++m) { const int r = ai * 128 + wr * 64 + m * 16 + fr; const float gw = LISTW[(size_t)u.e * M + u.x * 256 + r];
                bf16_t* rowp = Y + (size_t)(u.pm * 256 + r) * DM + col0;
#pragma unroll
                for (int bj = 0; bj < 2; ++bj) { const f32x4 v0 = (acc[ai][bj][m][0] + bv[bj][0]) * gw, v1 = (acc[ai][bj][m][1] + bv[bj][1]) * gw;
                    u32x4 w; w.x = pg8::cvt_pk_bf16(v0[0], v0[1]); w.y = pg8::cvt_pk_bf16(v0[2], v0[3]); w.z = pg8::cvt_pk_bf16(v1[0], v1[1]); w.w = pg8::cvt_pk_bf16(v1[2], v1[3]);
                    *(u32x4*)(rowp + bj * 128) = w; } }
    }
};
__device__ __forceinline__ void ph7_down(Frame& F) {
    LAS int* tab = (LAS int*)(F.lds + TAB_OFF);
    load_expert_tables(F, tab);
    GroupedOrder S{tab, 8, (int)gridDim.x, (int)blockIdx.x, __builtin_amdgcn_readfirstlane(tab[160]) * 8, (const char*)(F.ws + WS_H), (const char*)(F.ws + WS_WD), (size_t)DM * FF * 2, (size_t)256 * FF * 2, nullptr, false};
    EpiDown E{(bf16_t*)(F.ws + WS_Y), F.in[I_BD], (const float*)(F.ws + WS_LISTW)};
    pg8::gemm_phase<EpiDown, GroupedOrder, false, true>(F.lds, FF, S, E);
}

__device__ __forceinline__ void ph6_gateup_oracle(Frame& F) {
    const bf16_t* XN2 = (const bf16_t*)(F.ws + WS_XN2); const int* LIST = (const int*)(F.ws + WS_LIST); bf16_t* H = (bf16_t*)(F.ws + WS_H);
    LAS int* tab = (LAS int*)(F.lds + TAB_OFF); LAS int* toks = tab + 192;
    load_expert_tables(F, tab);
    const int ntm = tab[96];
    for (int tile = blockIdx.x; tile < ntm * 16; tile += gridDim.x) {
        const int tmg = tile / 16, nt = tile % 16; int e = 0;
        for (int i = 1; i < NE; ++i) if (tab[64 + i] <= tmg) e = i;
        const int mt = tmg - tab[64 + e], cnt = tab[e], rb = tab[32 + e];
        __syncthreads();
        if (F.tid < 64) { const int pos = mt * 64 + F.tid; toks[F.tid] = pos < cnt ? LIST[(size_t)e * M + pos] : -1; }
        __syncthreads();
        const float* W = F.in[I_WGU] + (size_t)e * DM * 4096; const float* Bg = F.in[I_BGU] + (size_t)e * 4096;
        gemm_tile_f32(F, DM,
            [&](int r, int k) -> float { const int t = toks[r]; return t >= 0 ? bf2f(XN2[(size_t)t * DM + k]) : 0.f; },
            [&](int k, int c) -> float { const int vc = nt * 256 + c, blk = vc >> 6, i = vc & 63; const int col = (i < 32) ? blk * 32 + i : 2048 + blk * 32 + (i - 32); return W[(size_t)k * 4096 + col]; },
            [&](int r, int c, float v0, float v1) { const int pos = mt * 64 + r; if (pos < cnt) { const int vc = nt * 256 + c, j = (vc >> 6) * 32 + (vc & 31);
                float gv = fminf(v0 + Bg[j], 7.f), uv = fminf(fmaxf(v1 + Bg[2048 + j], -7.f), 7.f);
                H[(size_t)(rb + pos) * FF + j] = (bf16_t)f2bf(gv * sigmoidf_(1.702f * gv) * (uv + 1.f)); } });
    }
}
__device__ __forceinline__ void ph7_down_oracle(Frame& F) {
    const bf16_t* H = (const bf16_t*)(F.ws + WS_H); const float* LISTW = (const float*)(F.ws + WS_LISTW); bf16_t* Y = (bf16_t*)(F.ws + WS_Y);
    LAS int* tab = (LAS int*)(F.lds + TAB_OFF);
    load_expert_tables(F, tab);
    const int ntm = tab[96];
    for (int tile = blockIdx.x; tile < ntm * 8; tile += gridDim.x) {
        const int tmg = tile / 8, nt = tile % 8; int e = 0;
        for (int i = 1; i < NE; ++i) if (tab[64 + i] <= tmg) e = i;
        const int mt = tmg - tab[64 + e], cnt = tab[e], rb = tab[32 + e];
        const float* W = F.in[I_WD] + (size_t)e * FF * DM; const float* Bd = F.in[I_BD] + (size_t)e * DM;
        gemm_tile_f32(F, FF,
            [&](int r, int k) -> float { const int pos = mt * 64 + r; return pos < cnt ? bf2f(H[(size_t)(rb + pos) * FF + k]) : 0.f; },
            [&](int k, int c) -> float { return W[(size_t)k * DM + nt * 256 + c]; },
            [&](int r, int c, float v0, float v1) { const int pos = mt * 64 + r; if (pos < cnt) { const float w = LISTW[(size_t)e * M + pos]; const int col = nt * 256 + c;
                Y[(size_t)(rb + pos) * DM + col] = (bf16_t)f2bf(w * (v0 + Bd[col])); Y[(size_t)(rb + pos) * DM + col + 32] = (bf16_t)f2bf(w * (v1 + Bd[col + 32])); } });
    }
}

__device__ __forceinline__ void ph8_final(Frame& F) {
    float* H1 = F.out; const bf16_t* Y = (const bf16_t*)(F.ws + WS_Y); const int* TOKE = (const int*)(F.ws + WS_TOKE); const int* TOKP = (const int*)(F.ws + WS_TOKP); const float* g = F.in[I_GFIN];
    LAS int* tab = (LAS int*)(F.lds + TAB_OFF);
    load_expert_tables(F, tab);
    for (int m = F.gw; m < M; m += F.NGW) {
        size_t rows[4];
#pragma unroll
        for (int k = 0; k < 4; ++k) rows[k] = (size_t)(tab[32 + TOKE[m * 4 + k]] + TOKP[m * 4 + k]);
        f32x4 v[8]; float ss = 0.f;
#pragma unroll
        for (int j = 0; j < 8; ++j) { const int c = 4 * F.lane + 256 * j; v[j] = *(const f32x4*)(H1 + (size_t)m * DM + c);
#pragma unroll
            for (int k = 0; k < 4; ++k) { const u32x2 w = *(const u32x2*)(Y + rows[k] * DM + c);
                v[j].x += __uint_as_float(w.x << 16); v[j].y += __uint_as_float(w.x & 0xffff0000u); v[j].z += __uint_as_float(w.y << 16); v[j].w += __uint_as_float(w.y & 0xffff0000u); }
            ss += (v[j].x * v[j].x + v[j].y * v[j].y) + (v[j].z * v[j].z + v[j].w * v[j].w); }
        const float rstd = rsqrtf(wave_sum(ss) * (1.f / DM) + EPS);
#pragma unroll
        for (int j = 0; j < 8; ++j) { const int c = 4 * F.lane + 256 * j; const f32x4 gg = *(const f32x4*)(g + c);
            *(f32x4*)(H1 + (size_t)m * DM + c) = (f32x4){v[j].x * rstd * gg.x, v[j].y * rstd * gg.y, v[j].z * rstd * gg.z, v[j].w * rstd * gg.w}; }
    }
}

constexpr int NPHASES = 10;
__global__ void __launch_bounds__(NTHREADS, 2) fwd(Params p) {
    extern __shared__ __attribute__((aligned(16))) unsigned char lds_raw[];
    Frame F;
    F.lds = (LAS unsigned char*)lds_raw;
    F.tid = threadIdx.x; F.lane = F.tid & 63; F.wave = __builtin_amdgcn_readfirstlane(F.tid >> 6);
    F.gw = blockIdx.x * NWAVES + F.wave; F.NGW = gridDim.x * NWAVES;
    F.in = p.in; F.out = p.out; F.ws = p.ws; F.ctl = (unsigned*)(p.ws + WS_CTL);
    volatile LAS unsigned* MISC = (volatile LAS unsigned*)(F.lds + MISC_OFF);
    if (F.tid < 32) MISC[F.tid] = 0u;
    __syncthreads();
    const int lo = p.ph_lo, hi = p.ph_hi;
    XcdBarrier bar; bar.bar = F.ctl + CW_BAR; bar.x = 0; bar.st = nullptr;
    if (hi - lo > 1) bar = xcd_barrier_post(F.ctl + CW_BAR, MISC + 8);
#define IN(k) (lo <= (k) && (k) < hi)
#define SEAM(k) do { if (IN(k) && IN((k) + 1)) xcd_barrier(bar); } while (0)
    if (IN(0)) { ph0_prologue(F); ph0_weights(F, true); } SEAM(0);
    if (IN(1)) { ph1_inproj(F); } SEAM(1);
    if (IN(2)) { ph1b_conv_scan(F); } SEAM(2);
    if (IN(3)) { ph2_attn_oracle(F); ph2_ssd_oracle(F); } SEAM(3);
    if (IN(4)) { ph3_norms(F); } SEAM(4);
    if (IN(5)) { ph4_outproj(F); } SEAM(5);
    if (IN(6)) { ph5_router(F); } SEAM(6);
    if (IN(7)) { ph6_gateup(F); } SEAM(7);
    if (IN(8)) { ph7_down(F); } SEAM(8);
    if (IN(9)) { ph8_final(F); }
#undef IN
#undef SEAM
}

extern "C" void kernel_launch(void* const* d_in, const int* in_sizes, int n_in, void* d_out, int out_size, void* d_ws, size_t ws_size, hipStream_t stream) {
    static int grid = 0;
    if (grid == 0) {
        if (n_in != 21 || out_size != M * DM || ws_size < WS_END) { fprintf(stderr, "kernel_launch: unexpected shapes (n_in %d, out %d, ws %zu < %zu)\n", n_in, out_size, ws_size, (size_t)WS_END); grid = -1; return; }
        int dev = 0, cus = 0, per_cu = 0;
        if (hipGetDevice(&dev) != hipSuccess || hipDeviceGetAttribute(&cus, hipDeviceAttributeMultiprocessorCount, dev) != hipSuccess) { grid = -1; return; }
        if (hipFuncSetAttribute((const void*)fwd, hipFuncAttributeMaxDynamicSharedMemorySize, LDS_BYTES) != hipSuccess) { fprintf(stderr, "kernel_launch: hipFuncSetAttribute failed\n"); grid = -1; return; }
        if (hipOccupancyMaxActiveBlocksPerMultiprocessor(&per_cu, (const void*)fwd, NTHREADS, LDS_BYTES) != hipSuccess || per_cu < 1) fprintf(stderr, "kernel_launch: occupancy query says %d\n", per_cu);
        (void)hipGetLastError();
        grid = cus;
    }
    if (grid < 0) return;
    (void)hipMemsetAsync((char*)d_ws + WS_CTL, 0, CTL_ZERO_BYTES, stream);
    Params p{};
    for (int i = 0; i < 21; ++i) p.in[i] = (const float*)d_in[i];
    p.out = (float*)d_out; p.ws = (unsigned char*)d_ws;
#if MK_ONE_LAUNCH
    p.ph_lo = 0; p.ph_hi = NPHASES;
    hipLaunchKernelGGL(fwd, dim3(grid), dim3(NTHREADS), LDS_BYTES, stream, p);
#else
    for (int k = 0; k < NPHASES; ++k) { p.ph_lo = k; p.ph_hi = k + 1; hipLaunchKernelGGL(fwd, dim3(grid), dim3(NTHREADS), LDS_BYTES, stream, p); }
#endif
}
```

```cpp
#include <hip/hip_runtime.h>
#include <cstdio>
#include <cstdint>

#ifndef MK_ONE_LAUNCH
#define MK_ONE_LAUNCH 1
#endif

#define GAS __attribute__((address_space(1)))
#define LAS __attribute__((address_space(3)))
typedef unsigned short bf16_t;
typedef float f32x4 __attribute__((ext_vector_type(4)));
typedef float f32x16 __attribute__((ext_vector_type(16)));
typedef unsigned u32x4 __attribute__((ext_vector_type(4)));
typedef unsigned u32x2 __attribute__((ext_vector_type(2)));

constexpr int NB = 4, SEQ = 4096, DM = 2048, NMETA = 16;
constexpr int M = NB * SEQ;
constexpr int LP = 4224;
constexpr int ROW_META = 112, ROW_REAL = 128;
constexpr int SR = NB * LP;
constexpr int AH = 16, HD = 64, AW = 1024;
constexpr int SH = 32, SP = 64, SW = 2048, SG = 4, SN = 128, CC = 3072;
constexpr int INC = 8240;
constexpr int C_Q = 0, C_K = 1024, C_V = 2048, C_F = 3072, C_Z = 3088, C_X = 5136, C_DT = 8208;
constexpr int NE = 32, TOPK = 4, FF = 2048;
constexpr float EPS = 1e-5f, LOG2E = 1.4426950408889634f, QSCALE = 0.125f * 1.4426950408889634f;
constexpr int NTHREADS = 512, NWAVES = 8;

constexpr size_t MiB = 1ull << 20;
constexpr size_t WS_CTL = 0, CTL_ZERO_BYTES = 1 * MiB;
constexpr size_t WS_XN   = 2 * MiB;
constexpr size_t WS_Q    = WS_XN   + (size_t)(M + 256) * DM * 2;
constexpr size_t WS_K    = WS_Q    + (size_t)M * AW * 2;
constexpr size_t WS_V    = WS_K    + (size_t)(SR + 64) * AW * 2;
constexpr size_t WS_Z    = WS_V    + (size_t)(SR + 64) * AW * 2;
constexpr size_t WS_XBC  = WS_Z    + (size_t)M * SW * 2;
constexpr size_t WS_XC   = WS_XBC  + (size_t)SR * CC * 2;
constexpr size_t WS_FDT  = WS_XC   + (size_t)SR * CC * 2;
constexpr size_t WS_DT   = WS_FDT  + (size_t)SR * 48 * 4;
constexpr size_t WS_CF   = WS_DT   + (size_t)SR * 32 * 4;
constexpr size_t WS_O    = WS_CF   + (size_t)SR * 16 * 4;
constexpr size_t WS_YS   = WS_O    + (size_t)M * AW * 2;
constexpr size_t WS_A2   = WS_YS   + (size_t)M * SW * 2;
constexpr size_t WS_XN2  = WS_A2   + (size_t)M * 3072 * 2;
constexpr size_t WS_TOKE = WS_XN2  + (size_t)M * DM * 2;
constexpr size_t WS_TOKP = WS_TOKE + (size_t)M * 4 * 4;
constexpr size_t WS_LIST = WS_TOKP + (size_t)M * 4 * 4;
constexpr size_t WS_LISTW= WS_LIST + (size_t)NE * M * 4;
constexpr int HROWS = 65536 + NE * 256;
constexpr size_t WS_H    = WS_LISTW+ (size_t)NE * M * 4;
constexpr size_t WS_Y    = WS_H    + (size_t)HROWS * FF * 2;
constexpr size_t WS_WIN  = WS_Y    + (size_t)HROWS * DM * 2;
constexpr size_t WS_WOUT = WS_WIN  + (size_t)8448 * DM * 2;
constexpr size_t WS_WGU  = WS_WOUT + (size_t)DM * 3072 * 2;
constexpr size_t WS_WD   = WS_WGU  + (size_t)NE * 4096 * DM * 2;
constexpr int CFT_LD = 4352;
constexpr size_t WS_CFT  = WS_WD   + (size_t)NE * DM * FF * 2;
constexpr size_t WS_END  = WS_CFT  + (size_t)NB * AH * CFT_LD * 4;
constexpr int CW_BAR = 4096;
constexpr int CW_CNT = 8192;

__device__ __forceinline__ float bf2f(bf16_t v) { return __uint_as_float((unsigned)v << 16); }
__device__ __forceinline__ unsigned f2bf(float f) { unsigned u = __float_as_uint(f); return (u + 0x7fffu + ((u >> 16) & 1u)) >> 16; }
__device__ __forceinline__ unsigned pk2(float lo, float hi) { return f2bf(lo) | (f2bf(hi) << 16); }
__device__ __forceinline__ float wave_sum(float v) {
#pragma unroll
    for (int o = 1; o < 64; o <<= 1) v += __shfl_xor(v, o);
    return v;
}
__device__ __forceinline__ float sigmoidf_(float x) { return 1.0f / (1.0f + __expf(-x)); }
__device__ __forceinline__ float siluf_(float x) { return x / (1.0f + __expf(-x)); }
__device__ __forceinline__ float softplusf_(float x) { return x > 20.f ? x : log1pf(expf(x)); }
__device__ __forceinline__ float logsigmoidf_(float x) { return x < 0.f ? x - log1pf(expf(x)) : -log1pf(expf(-x)); }

#define XB_TMO      128
#define XB_XCNT(j)  (256  + 64 * (j))
#define XB_XSUB(j)  (1280 + 64 * (j))
#define XB_XGEN(j)  (2304 + 64 * (j))
#define XB_TOP      3328
#define XB_TOPGEN   3392
#define XCD_BAR_WORDS 3456
#define XB_SPIN_CAP (1u << 23)
__device__ __forceinline__ unsigned xb_ld(unsigned* p)              { return __hip_atomic_load(p, __ATOMIC_RELAXED, __HIP_MEMORY_SCOPE_AGENT); }
__device__ __forceinline__ unsigned xb_add(unsigned* p, unsigned v) { return __hip_atomic_fetch_add(p, v, __ATOMIC_RELAXED, __HIP_MEMORY_SCOPE_AGENT); }
__device__ __forceinline__ unsigned xb_xcc_id() { return (unsigned)__builtin_amdgcn_s_getreg((3 << 11) | 20) & 0xFu; }
#define XB_SPIN(cond, bar) do { unsigned _sp = 0; while (cond) { __builtin_amdgcn_s_sleep(1); \
    if ((++_sp & 255u) == 0u) { if (xb_ld(&(bar)[XB_TMO])) break; if (_sp > XB_SPIN_CAP) { atomicAdd(&(bar)[XB_TMO], 1u); break; } } } } while (0)
struct XcdBarrier { unsigned* bar; unsigned x; volatile LAS unsigned* st; };
__device__ __forceinline__ XcdBarrier xcd_barrier_post(unsigned* bar, volatile LAS unsigned* st) {
    XcdBarrier b; b.bar = bar; b.x = xb_xcc_id(); b.st = st;
    if (threadIdx.x == 0) (void)xb_add(&bar[XB_XCNT(b.x)], 1u);
    return b;
}
__device__ __forceinline__ void xcd_barrier_complete(unsigned* bar, unsigned x, unsigned& nloc, unsigned& nx) {
    const unsigned G = gridDim.x * gridDim.y * gridDim.z;
    unsigned sum, cnt, mine, sp = 0u;
    for (;;) {
        sum = 0u; cnt = 0u; mine = 0u;
#pragma unroll
        for (unsigned j = 0; j < 16; ++j) { const unsigned c = xb_ld(&bar[XB_XCNT(j)]); sum += c; cnt += (c > 0u) ? 1u : 0u; mine = (j == x) ? c : mine; }
        if (sum == G) break;
        __builtin_amdgcn_s_sleep(1);
        if ((++sp & 255u) == 0u) { if (xb_ld(&bar[XB_TMO])) break; if (sp > XB_SPIN_CAP) { atomicAdd(&bar[XB_TMO], 1u); break; } }
    }
    nloc = mine > 0u ? mine : 1u; nx = cnt > 0u ? cnt : 1u;
}
__device__ __forceinline__ void xcd_barrier(const XcdBarrier& b) {
    asm volatile("s_waitcnt vmcnt(0)" ::: "memory");
    __syncthreads();
    if (threadIdx.x == 0) {
        unsigned* bar = b.bar;
        __builtin_amdgcn_s_waitcnt(0);
        unsigned nloc = b.st[0], nx = b.st[1];
        if (nloc == 0u) { xcd_barrier_complete(bar, b.x, nloc, nx); b.st[0] = nloc; b.st[1] = nx; }
        const unsigned old = xb_add(&bar[XB_XSUB(b.x)], 1u);
        const unsigned gen = old / nloc;
        if (old + 1u == (gen + 1u) * nloc) {
            __builtin_amdgcn_fence(__ATOMIC_RELEASE, "agent");
            asm volatile("s_waitcnt vmcnt(0)" ::: "memory");
            const unsigned og = xb_add(&bar[XB_TOP], 1u);
            const unsigned tg = og / nx;
            if (og + 1u == (tg + 1u) * nx) xb_add(&bar[XB_TOPGEN], 1u);
            else XB_SPIN(xb_ld(&bar[XB_TOPGEN]) == tg, bar);
            __builtin_amdgcn_fence(__ATOMIC_ACQUIRE, "agent");
            xb_add(&bar[XB_XGEN(b.x)], 1u);
            asm volatile("s_waitcnt vmcnt(0)" ::: "memory");
        } else {
            XB_SPIN(xb_ld(&bar[XB_XGEN(b.x)]) == gen, bar);
            __builtin_amdgcn_fence(__ATOMIC_ACQUIRE, "agent");
            asm volatile("s_waitcnt vmcnt(0)" ::: "memory");
        }
    }
    __syncthreads();
}

struct Params { const float* in[21]; float* out; unsigned char* ws; int ph_lo, ph_hi; };
enum { I_X = 0, I_META, I_GMIX, I_WIN, I_FB, I_GATT, I_CW, I_CB, I_DTB, I_ALOG, I_DSKIP, I_GSSM, I_WOUT, I_GFFN, I_WR, I_BR, I_WGU, I_BGU, I_WD, I_BD, I_GFIN };
struct Frame {
    LAS unsigned char* lds; int tid, lane, wave, gw, NGW;
    const float* const* in; float* out; unsigned char* ws; unsigned* ctl;
};
constexpr int LDS_BYTES = 147456;
constexpr int MISC_OFF = 131072;

__device__ __forceinline__ void rmsnorm_row_bf16(const float* src, const float* gain, bf16_t* dst, int lane) {
    f32x4 v[8]; float ss = 0.f;
#pragma unroll
    for (int j = 0; j < 8; ++j) { v[j] = *(const f32x4*)(src + 4 * lane + 256 * j); ss += (v[j].x * v[j].x + v[j].y * v[j].y) + (v[j].z * v[j].z + v[j].w * v[j].w); }
    const float rstd = rsqrtf(wave_sum(ss) * (1.f / DM) + EPS);
#pragma unroll
    for (int j = 0; j < 8; ++j) { const f32x4 g = *(const f32x4*)(gain + 4 * lane + 256 * j);
        u32x2 w; w.x = pk2(v[j].x * rstd * g.x, v[j].y * rstd * g.y); w.y = pk2(v[j].z * rstd * g.z, v[j].w * rstd * g.w);
        *(u32x2*)(dst + 4 * lane + 256 * j) = w; }
}
__device__ __forceinline__ void ph0_prologue(Frame& F) {
    bf16_t* XN = (bf16_t*)(F.ws + WS_XN);
    for (int row = F.gw; row < M + 256; row += F.NGW) {
        bf16_t* dst = XN + (size_t)row * DM;
        if (row < M) rmsnorm_row_bf16(F.in[I_X] + (size_t)row * DM, F.in[I_GMIX], dst, F.lane);
        else if (row < M + NMETA) rmsnorm_row_bf16(F.in[I_META] + (size_t)(row - M) * DM, F.in[I_GMIX], dst, F.lane);
        else {
#pragma unroll
            for (int j = 0; j < 8; ++j) *(u32x2*)(dst + 4 * F.lane + 256 * j) = (u32x2){0u, 0u};
        }
    }
    const int gt = blockIdx.x * NTHREADS + F.tid, GT = gridDim.x * NTHREADS;
    for (int i = gt; i < NB * ROW_META * (AW / 8); i += GT) { const int r = i / (AW / 8), c = i % (AW / 8); const int sr = (r / ROW_META) * LP + (r % ROW_META);
        *(u32x4*)((bf16_t*)(F.ws + WS_K) + (size_t)sr * AW + c * 8) = (u32x4){0u, 0u, 0u, 0u};
        *(u32x4*)((bf16_t*)(F.ws + WS_V) + (size_t)sr * AW + c * 8) = (u32x4){0u, 0u, 0u, 0u}; }
    for (int i = gt; i < 64 * (AW / 8); i += GT) { *(u32x4*)((bf16_t*)(F.ws + WS_K) + (size_t)SR * AW + (size_t)i * 8) = (u32x4){0u, 0u, 0u, 0u}; *(u32x4*)((bf16_t*)(F.ws + WS_V) + (size_t)SR * AW + (size_t)i * 8) = (u32x4){0u, 0u, 0u, 0u}; }
    for (int i = gt; i < NB * ROW_META * (CC / 8); i += GT) { const int r = i / (CC / 8), c = i % (CC / 8); const int sr = (r / ROW_META) * LP + (r % ROW_META);
        *(u32x4*)((bf16_t*)(F.ws + WS_XBC) + (size_t)sr * CC + c * 8) = (u32x4){0u, 0u, 0u, 0u}; }
    for (int i = gt; i < NB * ROW_META * 12; i += GT) { const int r = i / 12, c = i % 12; const int sr = (r / ROW_META) * LP + (r % ROW_META);
        *(f32x4*)((float*)(F.ws + WS_FDT) + (size_t)sr * 48 + c * 4) = (f32x4){0.f, 0.f, 0.f, 0.f}; }
}

template <class AF, class BF, class SF>
__device__ __forceinline__ void gemm_tile_f32(Frame& F, int K, AF af, BF bf, SF sf) {
    LAS float* As = (LAS float*)F.lds;
    LAS float* Bs = As + 64 * 17 + 16;
    const int wr = F.wave >> 2, wc = F.wave & 3, l31 = F.lane & 31, hi = F.lane >> 5;
    f32x16 acc0, acc1;
#pragma unroll
    for (int i = 0; i < 16; ++i) { acc0[i] = 0.f; acc1[i] = 0.f; }
    for (int k0 = 0; k0 < K; k0 += 16) {
        float av[2], bv[8];
#pragma unroll
        for (int i = 0; i < 2; ++i) { const int idx = F.tid + NTHREADS * i; av[i] = af(idx >> 4, k0 + (idx & 15)); }
#pragma unroll
        for (int i = 0; i < 8; ++i) { const int idx = F.tid + NTHREADS * i; bv[i] = bf(k0 + (idx >> 8), idx & 255); }
        __syncthreads();
#pragma unroll
        for (int i = 0; i < 2; ++i) { const int idx = F.tid + NTHREADS * i; As[(idx >> 4) * 17 + (idx & 15)] = av[i]; }
#pragma unroll
        for (int i = 0; i < 8; ++i) { const int idx = F.tid + NTHREADS * i; Bs[(idx >> 8) * 260 + (idx & 255)] = bv[i]; }
        __syncthreads();
#pragma unroll
        for (int kk = 0; kk < 16; kk += 2) {
            const float a = As[(wr * 32 + l31) * 17 + kk + hi];
            const float b0 = Bs[(kk + hi) * 260 + wc * 64 + l31], b1 = Bs[(kk + hi) * 260 + wc * 64 + 32 + l31];
            acc0 = __builtin_amdgcn_mfma_f32_32x32x2f32(a, b0, acc0, 0, 0, 0);
            acc1 = __builtin_amdgcn_mfma_f32_32x32x2f32(a, b1, acc1, 0, 0, 0);
        }
    }
#pragma unroll
    for (int r = 0; r < 16; ++r) sf(wr * 32 + (r & 3) + 8 * (r >> 2) + 4 * hi, wc * 64 + l31, acc0[r], acc1[r]);
    __syncthreads();
}

__device__ __forceinline__ void inproj_route(Frame& F, int row, int col, float v) {
    if (col >= INC) return;
    bf16_t* Q = (bf16_t*)(F.ws + WS_Q); bf16_t* Kb = (bf16_t*)(F.ws + WS_K); bf16_t* Vb = (bf16_t*)(F.ws + WS_V); bf16_t* Z = (bf16_t*)(F.ws + WS_Z);
    bf16_t* XBC = (bf16_t*)(F.ws + WS_XBC); float* FDT = (float*)(F.ws + WS_FDT);
    const bool real = row < M; int sr0, nb;
    if (real) { sr0 = (row >> 12) * LP + ROW_REAL + (row & 4095); nb = 1; } else { sr0 = ROW_META + (row - M); nb = NB; }
    if (col < C_K) { if (real) Q[(size_t)row * AW + col] = (bf16_t)f2bf(v * QSCALE); return; }
    if (col >= C_Z && col < C_X) { if (real) Z[(size_t)row * SW + (col - C_Z)] = (bf16_t)f2bf(v); return; }
    for (int b = 0; b < nb; ++b) { const size_t sr = (size_t)sr0 + (size_t)b * LP;
        if (col < C_V) Kb[sr * AW + (col - C_K)] = (bf16_t)f2bf(v);
        else if (col < C_F) Vb[sr * AW + (col - C_V)] = (bf16_t)f2bf(v);
        else if (col < C_Z) FDT[sr * 48 + (col - C_F)] = v;
        else if (col < C_DT) XBC[sr * CC + (col - C_X)] = (bf16_t)f2bf(v);
        else FDT[sr * 48 + 16 + (col - C_DT)] = v; }
}
__device__ __forceinline__ void ph1_inproj_oracle(Frame& F) {
    const bf16_t* XN = (const bf16_t*)(F.ws + WS_XN); const float* W = F.in[I_WIN];
    constexpr int MR = M + NMETA, TM = (MR + 63) / 64, TN = (INC + 255) / 256;
    for (int tile = blockIdx.x; tile < TM * TN; tile += gridDim.x) {
        const int tm = tile / TN, tn = tile % TN;
        gemm_tile_f32(F, DM,
            [&](int r, int k) -> float { const int row = tm * 64 + r; return row < MR ? bf2f(XN[(size_t)row * DM + k]) : 0.f; },
            [&](int k, int c) -> float { const int col = tn * 256 + c; return col < INC ? W[(size_t)k * INC + col] : 0.f; },
            [&](int r, int c, float v0, float v1) { const int row = tm * 64 + r, col = tn * 256 + c; if (row < MR) { inproj_route(F, row, col, v0); inproj_route(F, row, col + 32, v1); } });
    }
}


namespace pg8 {
typedef short bf16x8 __attribute__((ext_vector_type(8)));
constexpr int BM = 256, BK = 64, HALF = 128, HTB = HALF * BK * 2, STAGE_BYTES = 8 * HTB, NXCD = 8, WGM = 8;
__host__ __device__ __forceinline__ int lds_byte(int r, int c) { const int st = (r >> 4) * 2 + (c >> 5), rr = r & 15, cc = c & 31, ob = rr * 64 + cc * 2; return st * 1024 + (ob ^ (((ob >> 9) & 1) << 5)); }
__host__ __device__ __forceinline__ void stage_rc(int b, int& R, int& C) { const int st = b / 1024, sb = b % 1024, swz = sb ^ (((sb >> 9) & 1) << 5); R = (st >> 1) * 16 + swz / 64; C = (st & 1) * 32 + (swz % 64) / 2; }
__host__ __device__ __forceinline__ int perm32(int rho) { const int n = rho >> 4, i = rho & 15; return 8 * (i >> 2) + 4 * n + (i & 3); }
struct Unit { int pm, pn, e, x; };
struct StaticOrder {
    int nM, nN, nwg, G, c; const char* A; const char* Bt; size_t tstep;
    __device__ void init(const void* A_, const void* Bt_, int M_, int N_, int K_, int G_, int c_) { A = (const char*)A_; Bt = (const char*)Bt_; nM = M_ / BM; nN = N_ / BM; nwg = nM * nN; G = G_; c = c_; tstep = (size_t)BM * K_ * 2; }
    __device__ __forceinline__ bool next(int i, Unit& u) const {
        const long L = (long)i * G + c; if (L >= nwg) return false;
        int wgid = (int)L; { const int q = nwg / NXCD, r = nwg % NXCD, xcd = wgid % NXCD, off = wgid / NXCD; wgid = (xcd < r ? xcd * (q + 1) : r * (q + 1) + (xcd - r) * q) + off; }
        const int nig = WGM * nN, gid = wgid / nig, fm = gid * WGM, gsz = (nM - fm) < WGM ? (nM - fm) : WGM;
        u.pm = fm + ((wgid % nig) % gsz); u.pn = (wgid % nig) / gsz; u.e = 0; u.x = 0; return true;
    }
    __device__ __forceinline__ const char* a_base(const Unit& u) const { return A + (size_t)u.pm * tstep; }
    __device__ __forceinline__ const char* b_base(const Unit& u) const { return Bt + (size_t)u.pn * tstep; }
    __device__ __forceinline__ int a_row(const Unit&, int) const { return 0; }
};
__device__ __forceinline__ unsigned cvt_pk_bf16(float lo, float hi) { unsigned r; asm volatile("v_cvt_pk_bf16_f32 %0, %1, %2" : "=v"(r) : "v"(lo), "v"(hi)); return r; }

template <class Epi, class Sched, bool GATHER, bool ALIGN_EPI>
__device__ __forceinline__ void gemm_phase(LAS unsigned char* lds, const int K, const Sched& S, const Epi& E) {
    const int tid = threadIdx.x, wid = __builtin_amdgcn_readfirstlane(tid >> 6), lane = tid & 63, wr = wid >> 2, wc = wid & 3, fr = lane & 15, fq = lane >> 4;
    const int nt = K / BK;
    unsigned voffB[2], offC[2][2], offN[2][2]; int Rr[2], Cc[2];
#pragma unroll
    for (int i = 0; i < 2; ++i) { int R, C; stage_rc(tid * 16 + i * 8192, R, C); const int Rb = Epi::PERM ? ((R & ~31) + perm32(R & 31)) : R;
        voffB[i] = (unsigned)(Rb * K + C) * 2u; Rr[i] = R; Cc[i] = C;
        offC[0][i] = (unsigned)(R * K + C) * 2u; offC[1][i] = (unsigned)((HALF + R) * K + C) * 2u; offN[0][i] = offC[0][i]; offN[1][i] = offC[1][i]; }
    const size_t kstep = (size_t)(BK * 2);
    const size_t hstep = (size_t)HALF * K * 2;
    const unsigned ldsw = (unsigned)wid * 1024u;
    const int aoff = lds_byte(wr * 64 + fr, fq * 8), boff = lds_byte(wc * 32 + fr, fq * 8);
#define PG8_SA(b, h) (((b) * 2 + (h)) * HTB)
#define PG8_SB(b, h) ((4 + (b) * 2 + (h)) * HTB)
#define PG8_GLDS(gp, bufoff, i) __builtin_amdgcn_global_load_lds((const unsigned*)(gp), (LAS unsigned*)(lds + (bufoff) + ldsw + (i) * 8192), 16, 0, 0)
#define PG8_STG_B(bufoff, ptr) do { PG8_GLDS((ptr) + voffB[0], bufoff, 0); PG8_GLDS((ptr) + voffB[1], bufoff, 1); } while (0)
#define PG8_STG_A(bufoff, ptr, o0, o1) do { PG8_GLDS((ptr) + (o0), bufoff, 0); PG8_GLDS((ptr) + (o1), bufoff, 1); } while (0)
#define PG8_LDA(dst, b, h) do { _Pragma("unroll") for (int m = 0; m < 4; ++m) _Pragma("unroll") for (int k = 0; k < 2; ++k) dst[m][k] = *(const LAS bf16x8*)(lds + PG8_SA(b, h) + aoff + m * 2048 + k * 1024); } while (0)
#define PG8_LDB(dst, b, h) do { _Pragma("unroll") for (int n = 0; n < 2; ++n) _Pragma("unroll") for (int k = 0; k < 2; ++k) dst[n][k] = *(const LAS bf16x8*)(lds + PG8_SB(b, h) + boff + n * 2048 + k * 1024); } while (0)
#define PG8_MMA(ai, bj, At, Bt) do { __builtin_amdgcn_s_setprio(1); _Pragma("unroll") for (int m = 0; m < 4; ++m) _Pragma("unroll") for (int n = 0; n < 2; ++n) _Pragma("unroll") for (int k = 0; k < 2; ++k) \
        acc[ai][bj][m][n] = __builtin_amdgcn_mfma_f32_16x16x32_bf16(Bt[n][k], At[m][k], acc[ai][bj][m][n], 0, 0, 0); __builtin_amdgcn_s_setprio(0); } while (0)
#define PG8_WAIT_V(n) asm volatile("s_waitcnt vmcnt(" #n ")" ::: "memory")
#define PG8_WAIT_L(n) asm volatile("s_waitcnt lgkmcnt(" #n ")" ::: "memory")
#define PG8_BAR __builtin_amdgcn_s_barrier()
#define PG8_SCHED __builtin_amdgcn_sched_barrier(0)
    Unit cur, nxt; int ui = 0;
    if (!S.next(0, cur)) return;
    bool has_next = S.next(1, nxt);
    if constexpr (GATHER) {
#pragma unroll
        for (int h = 0; h < 2; ++h)
#pragma unroll
            for (int i = 0; i < 2; ++i) { offC[h][i] = (unsigned)S.a_row(cur, h * HALF + Rr[i]) * (unsigned)(K * 2) + (unsigned)(Cc[i] * 2);
                offN[h][i] = (unsigned)S.a_row(has_next ? nxt : cur, h * HALF + Rr[i]) * (unsigned)(K * 2) + (unsigned)(Cc[i] * 2); }
        asm volatile("s_waitcnt vmcnt(0)" : "+v"(offC[0][0]), "+v"(offC[0][1]), "+v"(offC[1][0]), "+v"(offC[1][1]), "+v"(offN[0][0]), "+v"(offN[0][1]), "+v"(offN[1][0]), "+v"(offN[1][1]) :: "memory");
    }
    f32x4 acc[2][2][4][2];
#pragma unroll
    for (int a = 0; a < 2; ++a)
#pragma unroll
        for (int b = 0; b < 2; ++b)
#pragma unroll
            for (int m = 0; m < 4; ++m)
#pragma unroll
                for (int n = 0; n < 2; ++n) acc[a][b][m][n] = (f32x4){0.f, 0.f, 0.f, 0.f};
    bf16x8 At[4][2], B0[2][2], B1[2][2];
    const char* cA = S.a_base(cur); const char* cB = S.b_base(cur);
    PG8_STG_B(PG8_SB(0, 0), cB); PG8_STG_B(PG8_SB(0, 1), cB + hstep); PG8_STG_A(PG8_SA(0, 0), cA, offC[0][0], offC[0][1]); PG8_STG_A(PG8_SA(0, 1), cA, offC[1][0], offC[1][1]);
    if (wr == 1) PG8_BAR;
    PG8_WAIT_V(2); PG8_BAR;
    PG8_STG_B(PG8_SB(1, 0), cB + kstep); PG8_STG_A(PG8_SA(1, 0), cA + kstep, offC[0][0], offC[0][1]); PG8_STG_B(PG8_SB(1, 1), cB + hstep + kstep);
    PG8_WAIT_V(6); PG8_BAR;
    for (;;) {
        const char* nA = has_next ? S.a_base(nxt) : cA; const char* nB = has_next ? S.b_base(nxt) : cB;
        for (int t = 0; t < nt; t += 2) {
            const bool last = (t == nt - 2);
            const char* a1 = cA + (size_t)(t + 1) * kstep;
            const char* a2 = last ? nA : cA + (size_t)(t + 2) * kstep; const char* b2 = last ? nB : cB + (size_t)(t + 2) * kstep;
            const char* a3 = a2 + kstep; const char* b3 = b2 + kstep;
            unsigned o00 = offC[0][0], o01 = offC[0][1], o10 = offC[1][0], o11 = offC[1][1];
            if constexpr (GATHER) { if (last) { o00 = offN[0][0]; o01 = offN[0][1]; o10 = offN[1][0]; o11 = offN[1][1]; } }
            PG8_LDB(B0, 0, 0); PG8_LDB(B1, 0, 1); PG8_SCHED; PG8_LDA(At, 0, 0); PG8_STG_A(PG8_SA(1, 1), a1, offC[1][0], offC[1][1]);
            PG8_WAIT_V(8); PG8_WAIT_L(0); PG8_BAR; PG8_MMA(0, 0, At, B0); PG8_MMA(0, 1, At, B1); PG8_BAR; PG8_SCHED;
            PG8_LDA(At, 0, 1); PG8_STG_B(PG8_SB(0, 0), b2); PG8_STG_B(PG8_SB(0, 1), b2 + hstep); PG8_STG_A(PG8_SA(0, 0), a2, o00, o01);
            PG8_WAIT_V(8); PG8_WAIT_L(0); PG8_BAR; PG8_MMA(1, 0, At, B0); PG8_MMA(1, 1, At, B1); PG8_BAR; PG8_SCHED;
            PG8_LDB(B0, 1, 0); PG8_LDB(B1, 1, 1); PG8_SCHED; PG8_LDA(At, 1, 0); PG8_STG_A(PG8_SA(0, 1), a2, o10, o11);
            PG8_WAIT_V(8); PG8_WAIT_L(0); PG8_BAR; PG8_MMA(0, 0, At, B0); PG8_MMA(0, 1, At, B1); PG8_BAR; PG8_SCHED;
            PG8_LDA(At, 1, 1); PG8_STG_B(PG8_SB(1, 0), b3); PG8_STG_B(PG8_SB(1, 1), b3 + hstep); PG8_STG_A(PG8_SA(1, 0), a3, o00, o01);
            PG8_WAIT_V(8); PG8_WAIT_L(0); PG8_BAR; PG8_MMA(1, 0, At, B0); PG8_MMA(1, 1, At, B1); PG8_BAR; PG8_SCHED;
        }
        if constexpr (ALIGN_EPI) { if (wr == 0) PG8_BAR; }
        E(acc, cur, wr, wc, fr, fq);
        if (!has_next) break;
#pragma unroll
        for (int a = 0; a < 2; ++a)
#pragma unroll
            for (int b = 0; b < 2; ++b)
#pragma unroll
                for (int m = 0; m < 4; ++m)
#pragma unroll
                    for (int n = 0; n < 2; ++n) acc[a][b][m][n] = (f32x4){0.f, 0.f, 0.f, 0.f};
        cur = nxt; cA = nA; cB = nB; ++ui;
        has_next = S.next(ui + 1, nxt);
        if constexpr (GATHER) {
            int t2 = tid; asm volatile("" : "+v"(t2));
#pragma unroll
            for (int i = 0; i < 2; ++i) { int R, C; stage_rc(t2 * 16 + i * 8192, R, C);
#pragma unroll
                for (int h = 0; h < 2; ++h) { offC[h][i] = offN[h][i];
                    offN[h][i] = (unsigned)S.a_row(has_next ? nxt : cur, h * HALF + R) * (unsigned)(K * 2) + (unsigned)(C * 2); } }
            asm volatile("s_waitcnt vmcnt(0)" : "+v"(offN[0][0]), "+v"(offN[0][1]), "+v"(offN[1][0]), "+v"(offN[1][1]) :: "memory");
        }
        if constexpr (ALIGN_EPI) { if (wr == 1) PG8_BAR; }
    }
    PG8_WAIT_V(0);
    if constexpr (!ALIGN_EPI) { if (wr == 0) PG8_BAR; }
    PG8_BAR;
#undef PG8_SA
#undef PG8_SB
#undef PG8_GLDS
#undef PG8_STG_A
#undef PG8_STG_B
#undef PG8_LDA
#undef PG8_LDB
#undef PG8_MMA
#undef PG8_WAIT_V
#undef PG8_WAIT_L
#undef PG8_BAR
#undef PG8_SCHED
}
}

template <class RM>
__device__ __forceinline__ void transpose_item(const float* W, int K, int N, bf16_t* WT, LAS float* scr, int item, int lane, RM rm) {
    const int nblk = (N + 31) / 32, kb = item / nblk, nb = item % nblk, k0 = 64 * kb, n0 = 32 * nb;
    const bool nok = n0 + (lane & 31) < N;
#pragma unroll 8
    for (int i = 0; i < 32; ++i) { const int kk = 2 * i + (lane >> 5); scr[kk * 33 + (lane & 31)] = nok ? W[(size_t)(k0 + kk) * N + n0 + (lane & 31)] : 0.f; }
    asm volatile("s_waitcnt lgkmcnt(0)" ::: "memory");
    const int c = lane & 7;
#pragma unroll
    for (int j = 0; j < 4; ++j) { const int n = (lane >> 3) + 8 * j; const LAS float* s = scr + (8 * c) * 33 + n;
        u32x4 o; o.x = pk2(s[0 * 33], s[1 * 33]); o.y = pk2(s[2 * 33], s[3 * 33]); o.z = pk2(s[4 * 33], s[5 * 33]); o.w = pk2(s[6 * 33], s[7 * 33]);
        if (n0 + n < N) *(u32x4*)(WT + (size_t)rm(n0 + n) * K + k0 + 8 * c) = o; }
    asm volatile("s_waitcnt lgkmcnt(0)" ::: "memory");
}
constexpr int INC_P = 8448;
__device__ __forceinline__ int win_remap(int c) { return c < C_F ? c : c < C_Z ? 8192 + (c - C_F) : c < C_X ? 3072 + (c - C_Z) : c < C_DT ? 5120 + (c - C_X) : 8208 + (c - C_DT); }
__device__ __forceinline__ void ph0_weights(Frame& F, bool moe) {
    LAS float* scr = (LAS float*)(F.lds + F.wave * 16384);
    bf16_t* WinT = (bf16_t*)(F.ws + WS_WIN); bf16_t* WoutT = (bf16_t*)(F.ws + WS_WOUT); bf16_t* WguT = (bf16_t*)(F.ws + WS_WGU); bf16_t* WdT = (bf16_t*)(F.ws + WS_WD);
    constexpr int I_IN = (DM / 64) * ((INC + 31) / 32), I_OUT = (3072 / 64) * (DM / 32), I_GU = (DM / 64) * (4096 / 32), I_D = (FF / 64) * (DM / 32);
    const int total = I_IN + I_OUT + (moe ? NE * (I_GU + I_D) : 0);
    for (int it = F.gw; it < total; it += F.NGW) {
        int r = it;
        if (r < I_IN) { transpose_item(F.in[I_WIN], DM, INC, WinT, scr, r, F.lane, [](int n) { return win_remap(n); }); continue; } r -= I_IN;
        if (r < I_OUT) { transpose_item(F.in[I_WOUT], 3072, DM, WoutT, scr, r, F.lane, [](int n) { return n; }); continue; } r -= I_OUT;
        if (r < NE * I_GU) { const int e = r / I_GU; transpose_item(F.in[I_WGU] + (size_t)e * DM * 4096, DM, 4096, WguT + (size_t)e * 4096 * DM, scr, r % I_GU, F.lane,
            [](int n) { const int j = n & 2047; return (j >> 7) * 256 + (n >> 11) * 128 + (j & 127); }); continue; } r -= NE * I_GU;
        { const int e = r / I_D; transpose_item(F.in[I_WD] + (size_t)e * FF * DM, FF, DM, WdT + (size_t)e * DM * FF, scr, r % I_D, F.lane, [](int n) { return n; }); }
    }
    const int gt = blockIdx.x * NTHREADS + F.tid, GT = gridDim.x * NTHREADS;
    for (int i = gt; i < (INC_P - INC) * (DM / 8); i += GT) *(u32x4*)(WinT + (size_t)INC * DM + (size_t)i * 8) = (u32x4){0u, 0u, 0u, 0u};
}

struct EpiInproj {
    static constexpr bool PERM = true;
    unsigned char* ws;
    __device__ __forceinline__ void operator()(const f32x4 (&acc)[2][2][4][2], const pg8::Unit& u, int wr, int wc, int fr, int fq) const {
        asm volatile("" : "+v"(fr), "+v"(fq));
        const int pn = u.pn, pm = u.pm; const bool meta = pm >= M / 256;
        if (pn < 32) {
            bf16_t* base; int ld, colt; bool seq; float sc = 1.f;
            if (pn < 4) { base = (bf16_t*)(ws + WS_Q); ld = AW; colt = pn * 256; seq = false; sc = QSCALE; }
            else if (pn < 8) { base = (bf16_t*)(ws + WS_K); ld = AW; colt = (pn - 4) * 256; seq = true; }
            else if (pn < 12) { base = (bf16_t*)(ws + WS_V); ld = AW; colt = (pn - 8) * 256; seq = true; }
            else if (pn < 20) { base = (bf16_t*)(ws + WS_Z); ld = SW; colt = (pn - 12) * 256; seq = false; }
            else { base = (bf16_t*)(ws + WS_XBC); ld = CC; colt = (pn - 20) * 256; seq = true; }
            if (meta && !seq) return;
            const int col0 = colt + wc * 32 + 8 * fq;
#pragma unroll
            for (int ai = 0; ai < 2; ++ai)
#pragma unroll
                for (int m = 0; m < 4; ++m) { const int r = ai * 128 + wr * 64 + m * 16 + fr;
                    u32x4 w[2];
#pragma unroll
                    for (int bj = 0; bj < 2; ++bj) { const f32x4 v0 = acc[ai][bj][m][0] * sc, v1 = acc[ai][bj][m][1] * sc;
                        w[bj].x = pg8::cvt_pk_bf16(v0[0], v0[1]); w[bj].y = pg8::cvt_pk_bf16(v0[2], v0[3]); w[bj].z = pg8::cvt_pk_bf16(v1[0], v1[1]); w[bj].w = pg8::cvt_pk_bf16(v1[2], v1[3]); }
                    if (!meta) { const int mrow = pm * 256 + r; const size_t drow = seq ? (size_t)(mrow + ROW_REAL * ((mrow >> 12) + 1)) : (size_t)mrow;
                        bf16_t* rowp = base + drow * ld + col0; *(u32x4*)rowp = w[0]; *(u32x4*)(rowp + 128) = w[1]; }
                    else if (r < NMETA) {
#pragma unroll
                        for (int b = 0; b < NB; ++b) { bf16_t* rowp = base + (size_t)(b * LP + ROW_META + r) * ld + col0; *(u32x4*)rowp = w[0]; *(u32x4*)(rowp + 128) = w[1]; } }
                }
        } else {
            float* FDT = (float*)(ws + WS_FDT);
            const int col0 = wc * 32 + 8 * fq;
            if (col0 >= 48) return;
#pragma unroll
            for (int ai = 0; ai < 2; ++ai)
#pragma unroll
                for (int m = 0; m < 4; ++m) { const int r = ai * 128 + wr * 64 + m * 16 + fr;
                    if (!meta) { const int mrow = pm * 256 + r; float* rowp = FDT + (size_t)(mrow + ROW_REAL * ((mrow >> 12) + 1)) * 48 + col0;
                        *(f32x4*)rowp = acc[ai][0][m][0]; *(f32x4*)(rowp + 4) = acc[ai][0][m][1]; }
                    else if (r < NMETA) {
#pragma unroll
                        for (int b = 0; b < NB; ++b) { float* rowp = FDT + (size_t)(b * LP + ROW_META + r) * 48 + col0; *(f32x4*)rowp = acc[ai][0][m][0]; *(f32x4*)(rowp + 4) = acc[ai][0][m][1]; } }
                }
        }
    }
};
__device__ __forceinline__ void ph1_inproj(Frame& F) {
    pg8::StaticOrder S; S.init(F.ws + WS_XN, F.ws + WS_WIN, M + 256, INC_P, DM, gridDim.x, blockIdx.x);
    EpiInproj E{F.ws};
    pg8::gemm_phase<EpiInproj, pg8::StaticOrder, false, true>(F.lds, DM, S, E);
}
struct EpiOutproj {
    static constexpr bool PERM = false;
    const float* x; float* out;
    __device__ __forceinline__ void operator()(const f32x4 (&acc)[2][2][4][2], const pg8::Unit& u, int wr, int wc, int fr, int fq) const {
        asm volatile("" : "+v"(fr), "+v"(fq));
        const int col0 = u.pn * 256 + wc * 32 + 4 * fq;
#pragma unroll
        for (int ai = 0; ai < 2; ++ai)
#pragma unroll
            for (int m = 0; m < 4; ++m) { const size_t off = (size_t)(u.pm * 256 + ai * 128 + wr * 64 + m * 16 + fr) * DM + col0;
#pragma unroll
                for (int bj = 0; bj < 2; ++bj)
#pragma unroll
                    for (int n = 0; n < 2; ++n) { const f32x4 xv = *(const f32x4*)(x + off + bj * 128 + n * 16); *(f32x4*)(out + off + bj * 128 + n * 16) = xv + acc[ai][bj][m][n]; } }
    }
};
__device__ __forceinline__ void ph4_outproj(Frame& F) {
    pg8::StaticOrder S; S.init(F.ws + WS_A2, F.ws + WS_WOUT, M, DM, 3072, gridDim.x, blockIdx.x);
    EpiOutproj E{F.in[I_X], F.out};
    pg8::gemm_phase<EpiOutproj, pg8::StaticOrder, false, true>(F.lds, 3072, S, E);
}

__device__ __forceinline__ void ph1b_conv_scan(Frame& F) {
    const bf16_t* XBC = (const bf16_t*)(F.ws + WS_XBC); bf16_t* XC = (bf16_t*)(F.ws + WS_XC);
    const float* FDT = (const float*)(F.ws + WS_FDT); float* DT = (float*)(F.ws + WS_DT); float* CF = (float*)(F.ws + WS_CF); float* CFT = (float*)(F.ws + WS_CFT);
    const float* cw = F.in[I_CW]; const float* cb = F.in[I_CB];
    const int gt = blockIdx.x * NTHREADS + F.tid, GT = gridDim.x * NTHREADS;
    for (int i = gt; i < SR * (CC / 8); i += GT) {
        const int sr = i / (CC / 8), cv = i % (CC / 8), pos = sr % LP, c0 = cv * 8;
        u32x4 o = (u32x4){0u, 0u, 0u, 0u};
        if (pos >= ROW_META) {
            float acc[8];
#pragma unroll
            for (int j = 0; j < 8; ++j) acc[j] = cb[c0 + j];
#pragma unroll
            for (int k = 0; k < 4; ++k) { const u32x4 xv = *(const u32x4*)(XBC + (size_t)(sr - 3 + k) * CC + c0);
                const unsigned xw[4] = {xv.x, xv.y, xv.z, xv.w};
#pragma unroll
                for (int j = 0; j < 8; ++j) { const float xf = __uint_as_float((j & 1) ? (xw[j >> 1] & 0xffff0000u) : (xw[j >> 1] << 16)); acc[j] += cw[k * CC + c0 + j] * xf; } }
            o.x = pk2(siluf_(acc[0]), siluf_(acc[1])); o.y = pk2(siluf_(acc[2]), siluf_(acc[3])); o.z = pk2(siluf_(acc[4]), siluf_(acc[5])); o.w = pk2(siluf_(acc[6]), siluf_(acc[7]));
        }
        *(u32x4*)(XC + (size_t)sr * CC + c0) = o;
    }
    for (int i = gt; i < SR * SH; i += GT) { const int sr = i / SH, h = i % SH, pos = sr % LP;
        DT[i] = pos >= ROW_META ? softplusf_(FDT[(size_t)sr * 48 + 16 + h] + F.in[I_DTB][h]) : 0.f; }
    LAS float* red = (LAS float*)F.lds;
    for (int w = blockIdx.x; w < NB * AH; w += gridDim.x) {
        const int b = w / AH, h = w % AH; const float fb = F.in[I_FB][h];
        float v[9]; float run = 0.f;
#pragma unroll
        for (int j = 0; j < 9; ++j) { const int pos = F.tid * 9 + j; float lf = 0.f;
            if (pos >= ROW_META && pos < LP) lf = logsigmoidf_(FDT[(size_t)(b * LP + pos) * 48 + h] + fb);
            run += lf; v[j] = run; }
        __syncthreads();
        red[F.tid] = run;
        __syncthreads();
        if (F.tid == 0) { float s = 0.f; for (int i = 0; i < NTHREADS; ++i) { const float t = red[i]; red[i] = s; s += t; } }
        __syncthreads();
        const float off = red[F.tid];
#pragma unroll
        for (int j = 0; j < 9; ++j) { const int pos = F.tid * 9 + j; if (pos < LP) CF[(size_t)(b * LP + pos) * 16 + h] = v[j] + off;
            if (pos < CFT_LD) CFT[(size_t)w * CFT_LD + pos] = pos < LP ? (v[j] + off) * LOG2E : 0.f; }
        __syncthreads();
    }
}

namespace attn_body {
using bf16=unsigned short;
using bf16x8=__attribute__((ext_vector_type(8)))short;
using s16x4=__attribute__((ext_vector_type(4)))short;
using f32x16=__attribute__((ext_vector_type(16)))float;
using u32x4=__attribute__((ext_vector_type(4)))unsigned;
using f32x4v=__attribute__((ext_vector_type(4)))float;
constexpr int BATCH=4,NHEAD=16,SEQ=4096,D=64,DM=NHEAD*D;
constexpr int NW=8,QBLK=32,QB=QBLK*NW,KVBLK=64,NQB=SEQ/QB;
constexpr int ATTN_PITCH=DM, ATTN_UNIT_ROWS=QB;
__device__ __forceinline__ int crow(int r,int hi){return (r&3)+8*(r>>2)+4*hi;}
#define SBAR() __builtin_amdgcn_sched_barrier(0)
__device__ __forceinline__ void cmask(f32x16&p0,f32x16&p1,int jb,int qrel,int hi){
  const float NEG=-INFINITY; int kb=64*jb+4*hi;
  #pragma unroll
  for(int r=0;r<16;++r){int kv=kb+(r&3)+8*(r>>2); if(kv>qrel)p0[r]=NEG; if(kv+32>qrel)p1[r]=NEG;}
}

constexpr int NSLOT=3, SLOTB=8192;
constexpr int LDS_K=0, LDS_V=NSLOT*SLOTB, LDS_WS=2*NSLOT*SLOTB, LDS_OST=LDS_WS+NW*64*4, LDS_C2=LDS_OST+NW*4096, C2_LEN=4352, LDS_BYTES=LDS_C2+C2_LEN*4;
constexpr float C2=0.125f*1.4426950408889634f;
__device__ __forceinline__ void glds16(const void*gsrc,unsigned lds_dst){unsigned keep;
  asm volatile("s_mov_b32 %0, m0\n\ts_mov_b32 m0, %2\n\ts_nop 0\n\tglobal_load_lds_dwordx4 %1, off\n\ts_mov_b32 m0, %0":"=&s"(keep):"v"(gsrc),"s"(lds_dst):"memory");}
__device__ __forceinline__ float max3f(float a,float b,float c){float r;asm("v_max3_f32 %0, %1, %2, %3":"=v"(r):"v"(a),"v"(b),"v"(c));return r;}
__device__ __forceinline__ float max2f(float a,float b){float r;asm("v_max_f32_e32 %0, %1, %2":"=v"(r):"v"(a),"v"(b));return r;}
__device__ __forceinline__ float fadd_s(float a,float b){float r;asm("v_add_f32_e32 %0, %1, %2":"=v"(r):"v"(a),"v"(b));return r;}
__device__ __forceinline__ float fsub_s(float a,float b){float r;asm("v_sub_f32_e32 %0, %1, %2":"=v"(r):"v"(a),"v"(b));return r;}
typedef float f32x2_t __attribute__((ext_vector_type(2))); typedef __bf16 bf16x2_t __attribute__((ext_vector_type(2)));
__device__ __forceinline__ unsigned cvtpk_s(float lo,float hi){f32x2_t v={lo,hi};bf16x2_t b=__builtin_convertvector(v,bf16x2_t);return __builtin_bit_cast(unsigned,b);}
#define WAIT_BAR(N) asm volatile("s_waitcnt vmcnt(" #N ") lgkmcnt(0)\n\ts_barrier":::"memory")

__device__ __forceinline__ void qkt(f32x16&p0,f32x16&p1,const char*Kslot,const bf16x8*qr,int r32,int hi){
  const char*kb=Kslot+hi*1024+r32*16;
  #pragma unroll
  for(int d0=0;d0<4;++d0){
    const bf16x8 b0=*reinterpret_cast<const bf16x8*>(kb+d0*2048);
    const bf16x8 b1=*reinterpret_cast<const bf16x8*>(kb+d0*2048+512);
    p0=__builtin_amdgcn_mfma_f32_32x32x16_bf16(b0,qr[d0],p0,0,0,0);p1=__builtin_amdgcn_mfma_f32_32x32x16_bf16(b1,qr[d0],p1,0,0,0);}
}
typedef __attribute__((address_space(3))) const char* lds_cptr;
typedef short v4i16_t __attribute__((ext_vector_type(4)));
__device__ __forceinline__ void kload8(bf16x8*kf,lds_cptr kp){
  kf[0]=*(const __attribute__((address_space(3))) bf16x8*)(kp);      kf[1]=*(const __attribute__((address_space(3))) bf16x8*)(kp+512);
  kf[2]=*(const __attribute__((address_space(3))) bf16x8*)(kp+2048); kf[3]=*(const __attribute__((address_space(3))) bf16x8*)(kp+2560);
  kf[4]=*(const __attribute__((address_space(3))) bf16x8*)(kp+4096); kf[5]=*(const __attribute__((address_space(3))) bf16x8*)(kp+4608);
  kf[6]=*(const __attribute__((address_space(3))) bf16x8*)(kp+6144); kf[7]=*(const __attribute__((address_space(3))) bf16x8*)(kp+6656);
}
__device__ __forceinline__ void kload2(bf16x8*kf,lds_cptr kp,int j){ kf[2*j]=*(const __attribute__((address_space(3))) bf16x8*)(kp+j*2048); kf[2*j+1]=*(const __attribute__((address_space(3))) bf16x8*)(kp+j*2048+512); }
__device__ __forceinline__ s16x4 vtr(lds_cptr p){ return __builtin_bit_cast(s16x4,__builtin_amdgcn_ds_read_tr16_b64_v4i16((__attribute__((address_space(3))) v4i16_t*)p)); }
__device__ __forceinline__ float rowmax(const f32x16&p0,const f32x16&p1){
  float a=max3f(p0[0],p0[1],p1[0]),b=max3f(p0[2],p0[3],p1[1]);a=max3f(a,p1[2],p1[3]);
  #pragma unroll
  for(int r=4;r<16;r+=4){a=max3f(a,p0[r],p0[r+1]);b=max3f(b,p0[r+2],p0[r+3]);a=max3f(a,p1[r],p1[r+1]);b=max3f(b,p1[r+2],p1[r+3]);}
  const float m=max2f(a,b);
  auto rr=__builtin_amdgcn_permlane32_swap(__float_as_uint(m),__float_as_uint(m),false,false);
  return max2f(__uint_as_float(rr[0]),__uint_as_float(rr[1]));
}
__device__ __forceinline__ void pv(f32x16*o,int vb,bf16x8 pa0,bf16x8 pa1,bf16x8 pa2,bf16x8 pa3){
  #pragma unroll
  for(int d0=0;d0<2;++d0){s16x4 lo[4],hi[4];
    #pragma unroll
    for(int ks=0;ks<4;++ks){
      asm volatile("ds_read_b64_tr_b16 %0,%1 offset:%c2":"=&v"(lo[ks]):"v"(vb),"i"(d0*4096+ks*1024):"memory");
      asm volatile("ds_read_b64_tr_b16 %0,%1 offset:%c2":"=&v"(hi[ks]):"v"(vb),"i"(d0*4096+ks*1024+512):"memory");}
    asm volatile("s_waitcnt lgkmcnt(0)":::"memory");SBAR();
    #define PK(k) (bf16x8){lo[k][0],lo[k][1],lo[k][2],lo[k][3],hi[k][0],hi[k][1],hi[k][2],hi[k][3]}
    o[d0]=__builtin_amdgcn_mfma_f32_32x32x16_bf16(pa0,PK(0),o[d0],0,0,0);
    o[d0]=__builtin_amdgcn_mfma_f32_32x32x16_bf16(pa1,PK(1),o[d0],0,0,0);
    o[d0]=__builtin_amdgcn_mfma_f32_32x32x16_bf16(pa2,PK(2),o[d0],0,0,0);
    o[d0]=__builtin_amdgcn_mfma_f32_32x32x16_bf16(pa3,PK(3),o[d0],0,0,0);
    #undef PK
  }
}

#ifndef ATTN_STORE16
#define ATTN_STORE16(p,v) (*(u32x4*)(p)=(v))
#endif
template<int THRL> __device__ __forceinline__ void attn_unit(int b,int h,int qb,const bf16*Q,const bf16*__restrict__ K,const bf16*__restrict__ V,bf16*O,const float*__restrict__ CFT,char*shm){
  const int tid=threadIdx.x,lane=tid&63,r32=lane&31,hi=lane>>5; const int wid=__builtin_amdgcn_readfirstlane(tid>>6);
  const long rowbase=(long)b*SEQ; const long rowbase_k=(long)b*LP+64; const int q0=qb*QB;
  const bf16*Qw=Q+(rowbase+q0+wid*QBLK)*DM+h*D;
  const bf16*Kh=K+rowbase_k*DM+h*D,*Vh=V+rowbase_k*DM+h*D;
  const unsigned lds0=(unsigned)(uintptr_t)shm;
  float*wsf=(float*)(shm+LDS_WS)+wid*64;
  const bf16*ksrc=Kh+(long)lane*DM+wid*8;
  const bf16*vsrc=Vh+(long)(16*(wid&3)+(lane>>2))*DM+(wid>>2)*32+(lane&3)*8;
  const unsigned kdst=lds0+LDS_K+wid*1024, vdst=lds0+LDS_V+wid*1024;
  #define DMA_K(t,slot) glds16(ksrc+(long)(t)*KVBLK*DM,(unsigned)__builtin_amdgcn_readfirstlane(kdst+(slot)))
  #define DMA_V(t,slot) glds16(vsrc+(long)(t)*KVBLK*DM,(unsigned)__builtin_amdgcn_readfirstlane(vdst+(slot)))
  const int vb0=(int)(lds0+LDS_V)+((lane>>4)&1)*32+(lane&3)*8+(4*hi+((lane&15)>>2))*64;
  const char*Kbase=shm+LDS_K; bf16x8 kf[8];
  const lds_cptr shm3=(lds_cptr)shm; const lds_cptr kp0=shm3+LDS_K+hi*1024+r32*16; const lds_cptr vp0=shm3+LDS_V+((lane>>4)&1)*32+(lane&3)*8+(4*hi+((lane&15)>>2))*64;
  const int NT=(q0+QB)/KVBLK+2;
  const float*cft=CFT+(long)(b*NHEAD+h)*C2_LEN+64;
  { float*c2w=(float*)(shm+LDS_C2); for(int i=tid;i<KVBLK*NT;i+=NW*64)c2w[i]=cft[i]; }
  const float cq2=cft[64+q0+wid*QBLK+r32];
  const __attribute__((address_space(3))) f32x4v*c2p=(const __attribute__((address_space(3))) f32x4v*)(shm3+LDS_C2)+hi;
  DMA_K(0,0);DMA_V(0,0);DMA_K(1,SLOTB);
  bf16x8 qr[4];
  #pragma unroll
  for(int d0=0;d0<4;++d0)qr[d0]=*reinterpret_cast<const bf16x8*>(&Qw[(long)r32*DM+d0*16+hi*8]);
  float mhat=0.f,l_reg=0.f;f32x16 o[2];o[0]=f32x16{};o[1]=f32x16{};float cqm=cq2;
  const int qrel=wid*QBLK+r32;
  #define CMASK(P0,P1,t) do{int jb_=(t)-(NT-5); if(jb_>=0)cmask(P0,P1,jb_,qrel,hi);}while(0)
  bool resc=false;
  #define START(P0,P1) do{ const float rm=rowmax(P0,P1); resc=false; \
    { const float dl=rm; mhat=fadd_s(mhat,dl); \
      _Pragma("unroll") for(int r=0;r<16;++r){P0[r]=fsub_s(P0[r],dl);P1[r]=fsub_s(P1[r],dl);} \
      cqm=cq2-mhat; } \
    _Pragma("unroll") for(int r=0;r<16;++r)P0[r]=__builtin_amdgcn_exp2f(P0[r]); }while(0)
  #define RESC() do{ if(resc){ asm volatile("s_waitcnt lgkmcnt(0)":::"memory"); \
      _Pragma("unroll") for(int d_=0;d_<2;++d_) _Pragma("unroll") for(int r=0;r<16;++r)o[d_][r]*=wsf[crow(r,hi)]; } }while(0)
  f32x16 pA0,pA1,pB0,pB1;
  int sl_prev=0,sl_cur=0,sl_next=SLOTB;
  #define ROT() do{sl_prev=sl_cur;sl_cur=sl_next;sl_next=(sl_next==(NSLOT-1)*SLOTB)?0:sl_next+SLOTB;}while(0)
  DMA_K(2,2*SLOTB);
  WAIT_BAR(3);
  #define CINIT(P0,P1,t) do{ const __attribute__((address_space(3))) f32x4v*cp_=c2p+16*(t); \
    _Pragma("unroll") for(int g_=0;g_<4;++g_){ const f32x4v a_=cp_[2*g_], b_=cp_[2*g_+8]; \
      P0[4*g_]=cqm-a_[0];P0[4*g_+1]=cqm-a_[1];P0[4*g_+2]=cqm-a_[2];P0[4*g_+3]=cqm-a_[3]; P1[4*g_]=cqm-b_[0];P1[4*g_+1]=cqm-b_[1];P1[4*g_+2]=cqm-b_[2];P1[4*g_+3]=cqm-b_[3]; } }while(0)
  CINIT(pA0,pA1,0); qkt(pA0,pA1,Kbase,qr,r32,hi);asm volatile("s_nop 15\n\ts_nop 7":"+v"(pA0),"+v"(pA1));
  { const float NEG_=-INFINITY;
    _Pragma("unroll") for(int r=0;r<16;++r)pA0[r]=NEG_;
    _Pragma("unroll") for(int r=0;r<8;++r)pA1[r]=NEG_; }
  START(pA0,pA1);
  _Pragma("unroll") for(int r=0;r<16;++r)pA1[r]=__builtin_amdgcn_exp2f(pA1[r]);
  WAIT_BAR(0);
  DMA_K(3,0);DMA_V(1,SLOTB);
  ROT();
  kload8(kf,kp0+sl_cur);
  WAIT_BAR(2);
  s16x4 vlo[8],vhi[8]; u32x4 pw0,pw1,pw2,pw3;
  #define PKW(P,B) cvtpk_s(P[B],P[B+1])
  #define PAF(k) __builtin_bit_cast(bf16x8,pw##k)
  #define VFR(i) (bf16x8){vlo[i][0],vlo[i][1],vlo[i][2],vlo[i][3],vhi[i][0],vhi[i][1],vhi[i][2],vhi[i][3]}
  #define PIN(x) asm volatile("":"+v"(x))
  #define MX3(a,b,c) __builtin_fmaxf(__builtin_fmaxf((a),(b)),(c))
  #define GAPA(MF,A0,A1,A2,A3,W0,W1,PW) do{ MF; sacc+=A0; sacc+=A1; sacc+=A2; sacc+=A3; PIN(sacc); W0; W1; PIN(PW); SBAR(); }while(0)
  #define EX(v) __builtin_amdgcn_exp2f(v)
  #define GAPB(MF,X,B) do{ MF; X[B]=EX(X[B]); X[B+1]=EX(X[B+1]); X[B+2]=EX(X[B+2]); X[B+3]=EX(X[B+3]); PIN(X); SBAR(); }while(0)
  #define VRD(i) do{ vlo[i]=vtr(vp_+(((i)>>2)*4096+((i)&3)*1024)); vhi[i]=vtr(vp_+(((i)>>2)*4096+((i)&3)*1024+512)); }while(0)
  #define KRD(G,j) do{ if(G){ kload2(kf,kp0+sl_next,j); SBAR(); } }while(0)
  #define STEP(C0,C1,P0,P1,t,GK,GV,GL) do{ SBAR(); \
    const lds_cptr vp_=vp0+sl_prev; CINIT(C0,C1,t); SBAR(); \
    VRD(0); SBAR(); float sacc=(P0[0]+P0[1]); \
    GAPA(C0=__builtin_amdgcn_mfma_f32_32x32x16_bf16(kf[0],qr[0],C0,0,0,0), P0[2],P0[3],P0[4],P0[5],     pw0[0]=PKW(P0,0), pw0[1]=PKW(P0,2), pw0); \
    VRD(4); SBAR(); GAPA(C1=__builtin_amdgcn_mfma_f32_32x32x16_bf16(kf[1],qr[0],C1,0,0,0), P0[6],P0[7],P0[8],P0[9],     pw0[2]=PKW(P0,4), pw0[3]=PKW(P0,6), pw0); \
    VRD(1); SBAR(); GAPA(C0=__builtin_amdgcn_mfma_f32_32x32x16_bf16(kf[2],qr[1],C0,0,0,0),   P0[10],P0[11],P0[12],P0[13], pw1[0]=PKW(P0,8), pw1[1]=PKW(P0,10), pw1); \
    VRD(5); SBAR(); GAPA(C1=__builtin_amdgcn_mfma_f32_32x32x16_bf16(kf[3],qr[1],C1,0,0,0),   P0[14],P0[15],P1[0],P1[1],   pw1[2]=PKW(P0,12),pw1[3]=PKW(P0,14), pw1); \
    VRD(2); SBAR(); GAPA(C0=__builtin_amdgcn_mfma_f32_32x32x16_bf16(kf[4],qr[2],C0,0,0,0),   P1[2],P1[3],P1[4],P1[5],     pw2[0]=PKW(P1,0), pw2[1]=PKW(P1,2), pw2); \
    VRD(6); SBAR(); GAPA(C1=__builtin_amdgcn_mfma_f32_32x32x16_bf16(kf[5],qr[2],C1,0,0,0),   P1[6],P1[7],P1[8],P1[9],     pw2[2]=PKW(P1,4), pw2[3]=PKW(P1,6), pw2); \
    VRD(3); SBAR(); GAPA(C0=__builtin_amdgcn_mfma_f32_32x32x16_bf16(kf[6],qr[3],C0,0,0,0),   P1[10],P1[11],P1[12],P1[13], pw3[0]=PKW(P1,8), pw3[1]=PKW(P1,10), pw3); \
    VRD(7); SBAR(); GAPA(C1=__builtin_amdgcn_mfma_f32_32x32x16_bf16(kf[7],qr[3],C1,0,0,0),   P1[14],P1[15],0.f,0.f,       pw3[2]=PKW(P1,12),pw3[3]=PKW(P1,14), pw3); \
    l_reg+=sacc; \
    if(GK){DMA_K((t)+3,sl_cur);} if(GV){DMA_V((t)+1,sl_next);} \
    CMASK(C0,C1,t); \
    { float a=MX3(C0[0],C0[1],C1[0]),b=MX3(C0[2],C0[3],C1[1]); a=MX3(a,C1[2],C1[3]); \
      _Pragma("unroll") for(int r=4;r<16;r+=4){a=MX3(a,C0[r],C0[r+1]);b=MX3(b,C0[r+2],C0[r+3]);a=MX3(a,C1[r],C1[r+1]);b=MX3(b,C1[r+2],C1[r+3]);} \
      float rm=__builtin_fmaxf(a,b); { auto rr=__builtin_amdgcn_permlane32_swap(__float_as_uint(rm),__float_as_uint(rm),false,false); rm=__builtin_fmaxf(__uint_as_float(rr[0]),__uint_as_float(rr[1])); } \
      resc=false; \
      if(__builtin_expect(__any(rm>(float)THRL),0)){ const float dl=__builtin_fmaxf(rm,0.f); mhat+=dl; \
        _Pragma("unroll") for(int r=0;r<16;++r){C0[r]-=dl;C1[r]-=dl;} \
        cqm=cq2-mhat; \
        const float f=__builtin_amdgcn_exp2f(-dl); l_reg*=f; if(hi==0)wsf[r32]=f; resc=true; } } \
    SBAR(); \
    GAPB(o[0]=__builtin_amdgcn_mfma_f32_32x32x16_bf16(PAF(0),VFR(0),o[0],0,0,0), C0,0); \
    GAPB(o[1]=__builtin_amdgcn_mfma_f32_32x32x16_bf16(PAF(0),VFR(4),o[1],0,0,0), C0,4); \
    KRD(GL,0); GAPB(o[0]=__builtin_amdgcn_mfma_f32_32x32x16_bf16(PAF(1),VFR(1),o[0],0,0,0), C0,8); \
    KRD(GL,1); GAPB(o[1]=__builtin_amdgcn_mfma_f32_32x32x16_bf16(PAF(1),VFR(5),o[1],0,0,0), C0,12); \
    KRD(GL,2); GAPB(o[0]=__builtin_amdgcn_mfma_f32_32x32x16_bf16(PAF(2),VFR(2),o[0],0,0,0), C1,0); \
    KRD(GL,3); GAPB(o[1]=__builtin_amdgcn_mfma_f32_32x32x16_bf16(PAF(2),VFR(6),o[1],0,0,0), C1,4); \
    GAPB(o[0]=__builtin_amdgcn_mfma_f32_32x32x16_bf16(PAF(3),VFR(3),o[0],0,0,0), C1,8); \
    GAPB(o[1]=__builtin_amdgcn_mfma_f32_32x32x16_bf16(PAF(3),VFR(7),o[1],0,0,0), C1,12); \
    }while(0)
  int t=1;
  #undef CMASK
  #define CMASK(P0,P1,t) do{}while(0)
  for(;t+5<NT;t+=2){
    STEP(pB0,pB1,pA0,pA1,t,true,true,true);     WAIT_BAR(2); RESC(); ROT();
    STEP(pA0,pA1,pB0,pB1,t+1,true,true,true);   WAIT_BAR(2); RESC(); ROT();
  }
  #undef CMASK
  #define CMASK(P0,P1,t) do{int jb_=(t)-(NT-5); if(jb_>=0)cmask(P0,P1,jb_,qrel,hi);}while(0)
  #define ENDW(tt) do{ if((tt)+3<NT){WAIT_BAR(2);} else if((tt)+2<NT){WAIT_BAR(1);} else {WAIT_BAR(0);} }while(0)
  for(;t+1<NT;t+=2){
    STEP(pB0,pB1,pA0,pA1,t,(t+3<NT),(t+1<NT),(t+1<NT));       ENDW(t);   RESC(); ROT();
    STEP(pA0,pA1,pB0,pB1,t+1,(t+4<NT),(t+2<NT),(t+2<NT));     ENDW(t+1); RESC(); ROT();
  }
  STEP(pB0,pB1,pA0,pA1,NT-1,false,false,false); RESC();
  { float sacc=pB0[0]+pB0[1]; _Pragma("unroll") for(int r=2;r<16;++r)sacc+=pB0[r]; _Pragma("unroll") for(int r=0;r<16;++r)sacc+=pB1[r]; l_reg+=sacc;
    pw0=(u32x4){PKW(pB0,0),PKW(pB0,2),PKW(pB0,4),PKW(pB0,6)};pw1=(u32x4){PKW(pB0,8),PKW(pB0,10),PKW(pB0,12),PKW(pB0,14)};pw2=(u32x4){PKW(pB1,0),PKW(pB1,2),PKW(pB1,4),PKW(pB1,6)};pw3=(u32x4){PKW(pB1,8),PKW(pB1,10),PKW(pB1,12),PKW(pB1,14)};
    SBAR(); pv(o,vb0+sl_cur,PAF(0),PAF(1),PAF(2),PAF(3)); }
  #undef PKW
  #undef PAF
  #undef VFR
  #undef PIN
  #undef MX3
  #undef GAPA
  #undef GAPB
  #undef EX
  #undef VRD
  #undef KRD
  #undef STEP
  #undef ENDW
  {auto rr=__builtin_amdgcn_permlane32_swap(__float_as_uint(l_reg),__float_as_uint(l_reg),false,false);l_reg=__uint_as_float(rr[0])+__uint_as_float(rr[1]);}
  if(hi==0)wsf[32+r32]=l_reg;asm volatile("s_waitcnt lgkmcnt(0)":::"memory");
  int lane_e=lane; asm volatile("":"+v"(lane_e));
  const int r32e=lane_e&31, hie=lane_e>>5;
  float rli[16];
  #pragma unroll
  for(int r=0;r<16;++r)rli[r]=__builtin_amdgcn_rcpf(wsf[32+crow(r,hie)]);
  bf16*Ow=O+(rowbase+q0+wid*QBLK)*DM+h*D;
  { bf16*stg=(bf16*)(shm+LDS_OST)+wid*2048;
    #pragma unroll
    for(int r=0;r<16;++r){const int orow=crow(r,hie);
      #pragma unroll
      for(int d0=0;d0<2;++d0)stg[orow*64+d0*32+r32e]=(bf16)f2bf(o[d0][r]*rli[r]);}
    asm volatile("s_waitcnt lgkmcnt(0)":::"memory");
    #pragma unroll
    for(int i=0;i<4;++i){const int row=i*8+(lane_e>>3),ch=lane_e&7; const u32x4 v=*(const u32x4*)(stg+row*64+ch*8); ATTN_STORE16(Ow+(long)row*DM+ch*8,v);} }
  asm volatile("s_waitcnt lgkmcnt(0)\n\ts_barrier":::"memory");
  #undef DMA_K
  #undef CINIT
  #undef DMA_V
  #undef CMASK
  #undef START
  #undef RESC
  #undef ROT
}
constexpr int ATTN_LDS_BYTES=LDS_BYTES;
struct AttnTensors { const bf16* Q; const bf16* K; const bf16* V; bf16* O; const float* CFT; };
struct AttnUnit { int bh; int qb; };
struct StaticOrder {
  int vcu;
  __device__ __forceinline__ explicit StaticOrder(int grid,int block):vcu((block%8)*(grid/8)+block/8){}
  __device__ __forceinline__ bool next(int i,AttnUnit&u)const{ if(i>=4||vcu>=256)return false; const int s=vcu&3; u.bh=vcu>>2; u.qb=(i==0)?15-s:(i==1)?8+s:(i==2)?7-s:s; return true; }
  __device__ __forceinline__ void a_ready(const AttnUnit&)const{}
  __device__ __forceinline__ void done(const AttnUnit&)const{}
};
template<class Sched,int THRL=8> __device__ __forceinline__ void attn_phase(char*lds,const AttnTensors&T,const Sched&S){
  AttnUnit u;
  for(int i=0;S.next(i,u);++i){ S.a_ready(u); attn_unit<THRL>(u.bh/NHEAD,u.bh%NHEAD,u.qb,T.Q,T.K,T.V,T.O,T.CFT,lds); S.done(u); }
}
#undef SBAR
#undef WAIT_BAR
}

__device__ __forceinline__ void ph2_attn(Frame& F) {
    const attn_body::AttnTensors AT{(const bf16_t*)(F.ws + WS_Q), (const bf16_t*)(F.ws + WS_K), (const bf16_t*)(F.ws + WS_V), (bf16_t*)(F.ws + WS_O), (const float*)(F.ws + WS_CFT)};
    const attn_body::StaticOrder S((int)gridDim.x, (int)blockIdx.x);
    attn_body::attn_phase<attn_body::StaticOrder>((char*)F.lds, AT, S);
}

__device__ __forceinline__ void ph2_attn_oracle(Frame& F) {
    const bf16_t* Q = (const bf16_t*)(F.ws + WS_Q); const bf16_t* Kb = (const bf16_t*)(F.ws + WS_K); const bf16_t* Vb = (const bf16_t*)(F.ws + WS_V);
    const float* CF = (const float*)(F.ws + WS_CF); bf16_t* O = (bf16_t*)(F.ws + WS_O);
    for (int task = F.gw; task < NB * AH * 64; task += F.NGW) {
        const int tb = 63 - (task % 64), bh = task / 64, b = bh / AH, h = bh % AH;
        const int t = tb * 64 + F.lane, m = b * SEQ + t, srq = b * LP + ROW_REAL + t;
        float q[64], o[64];
#pragma unroll
        for (int d = 0; d < 64; d += 8) { const u32x4 w = *(const u32x4*)(Q + (size_t)m * AW + h * HD + d);
            q[d] = __uint_as_float(w.x << 16); q[d + 1] = __uint_as_float(w.x & 0xffff0000u); q[d + 2] = __uint_as_float(w.y << 16); q[d + 3] = __uint_as_float(w.y & 0xffff0000u);
            q[d + 4] = __uint_as_float(w.z << 16); q[d + 5] = __uint_as_float(w.z & 0xffff0000u); q[d + 6] = __uint_as_float(w.w << 16); q[d + 7] = __uint_as_float(w.w & 0xffff0000u); }
#pragma unroll
        for (int d = 0; d < 64; ++d) o[d] = 0.f;
        const float ct = CF[(size_t)srq * 16 + h] * LOG2E;
        float mrun = -INFINITY, l = 0.f;
        const int s_end = b * LP + ROW_REAL + tb * 64 + 63;
        for (int srk = b * LP + ROW_META; srk <= s_end; ++srk) {
            const unsigned* kp = (const unsigned*)(Kb + (size_t)srk * AW + h * HD);
            float dot = 0.f;
#pragma unroll
            for (int d = 0; d < 32; ++d) { const unsigned w = kp[d]; dot += q[2 * d] * __uint_as_float(w << 16); dot += q[2 * d + 1] * __uint_as_float(w & 0xffff0000u); }
            float s = dot + ct - CF[(size_t)srk * 16 + h] * LOG2E;
            if (srk > srq) s = -INFINITY;
            const float mnew = fmaxf(mrun, s);
            const float alpha = exp2f(mrun - mnew), p = exp2f(s - mnew);
            l = l * alpha + p; mrun = mnew;
            const unsigned* vp = (const unsigned*)(Vb + (size_t)srk * AW + h * HD);
#pragma unroll
            for (int d = 0; d < 32; ++d) { const unsigned w = vp[d]; o[2 * d] = o[2 * d] * alpha + p * __uint_as_float(w << 16); o[2 * d + 1] = o[2 * d + 1] * alpha + p * __uint_as_float(w & 0xffff0000u); }
        }
        const float rl = 1.f / l;
#pragma unroll
        for (int d = 0; d < 64; d += 8) { u32x4 w; w.x = pk2(o[d] * rl, o[d + 1] * rl); w.y = pk2(o[d + 2] * rl, o[d + 3] * rl); w.z = pk2(o[d + 4] * rl, o[d + 5] * rl); w.w = pk2(o[d + 6] * rl, o[d + 7] * rl);
            *(u32x4*)(O + (size_t)m * AW + h * HD + d) = w; }
    }
}

__device__ __forceinline__ void ph2_ssd_oracle(Frame& F) {
    const bf16_t* XC = (const bf16_t*)(F.ws + WS_XC); const float* DT = (const float*)(F.ws + WS_DT); bf16_t* YS = (bf16_t*)(F.ws + WS_YS);
    for (int task = F.NGW - 1 - F.gw; task < NB * SH; task += F.NGW) {
        const int b = task / SH, h = task % SH, g = h / (SH / SG);
        const float A = -expf(F.in[I_ALOG][h]), Dh = F.in[I_DSKIP][h];
        float hs[128];
#pragma unroll
        for (int n = 0; n < 128; ++n) hs[n] = 0.f;
        for (int pos = ROW_META; pos < LP; ++pos) {
            const size_t sr = (size_t)b * LP + pos;
            const float dt = DT[sr * SH + h], dec = expf(dt * A);
            const float x = bf2f(XC[sr * CC + h * SP + F.lane]), xdt = x * dt;
            const unsigned* bp = (const unsigned*)(XC + sr * CC + SW + g * SN); const unsigned* cp = (const unsigned*)(XC + sr * CC + SW + SG * SN + g * SN);
            float y = 0.f;
#pragma unroll
            for (int n = 0; n < 64; ++n) { const unsigned bw = bp[n], cw = cp[n];
                hs[2 * n] = dec * hs[2 * n] + __uint_as_float(bw << 16) * xdt; y += __uint_as_float(cw << 16) * hs[2 * n];
                hs[2 * n + 1] = dec * hs[2 * n + 1] + __uint_as_float(bw & 0xffff0000u) * xdt; y += __uint_as_float(cw & 0xffff0000u) * hs[2 * n + 1]; }
            y += Dh * x;
            if (pos >= ROW_REAL) YS[(size_t)(b * SEQ + pos - ROW_REAL) * SW + h * SP + F.lane] = (bf16_t)f2bf(y);
        }
    }
}

namespace ssd {
typedef short bf16x8 __attribute__((ext_vector_type(8)));
constexpr int CH = 64, NCH = LP / CH;
constexpr int PA = 272, PB = 144;
constexpr int L_CM = 0, L_BM = L_CM + 64 * PA, L_BMT = L_BM + 64 * PA, L_XT = L_BMT + 128 * PB, L_XWT = L_XT + 64 * PB, L_MT = L_XWT + 64 * PB, L_HB = L_MT + 64 * PB, L_ACS = L_HB + 2 * 64 * PA,
              L_DTV = L_ACS + 256, L_WV = L_DTV + 256, L_DEC = L_WV + 256, L_END = L_DEC + 16;
static_assert(L_END <= MISC_OFF, "ssd LDS map");
__device__ __forceinline__ int crow(int r, int hi) { return (r & 3) + 8 * (r >> 2) + 4 * hi; }
__device__ __forceinline__ bf16x8 frag(const LAS unsigned char* base, int row, int pitch, int k0) { return *(const LAS bf16x8*)(base + row * pitch + k0 * 2); }
__device__ __forceinline__ void unit(Frame& F, int b, int h) {
    LAS unsigned char* lds = F.lds;
    const int tid = F.tid, lane = F.lane, wave = F.wave, r = lane & 31, hi = lane >> 5, g = h / (SH / SG);
    const bf16_t* XC = (const bf16_t*)(F.ws + WS_XC); const float* DT = (const float*)(F.ws + WS_DT); bf16_t* YS = (bf16_t*)(F.ws + WS_YS);
    const float A = -expf(F.in[I_ALOG][h]), Dh = F.in[I_DSKIP][h];
    LAS float* acs = (LAS float*)(lds + L_ACS); LAS float* dtv = (LAS float*)(lds + L_DTV); LAS float* wv = (LAS float*)(lds + L_WV); LAS float* decp = (LAS float*)(lds + L_DEC);
    for (int i = tid; i < 64 * PA / 16; i += NTHREADS) *(LAS u32x4*)(lds + L_HB + i * 16) = (u32x4){0u, 0u, 0u, 0u};
    f32x16 accH[2];
#pragma unroll
    for (int i = 0; i < 16; ++i) { accH[0][i] = 0.f; accH[1][i] = 0.f; }
    const int rowBC0 = tid >> 4, nBC = (tid & 15) * 8, rowX = tid >> 3, pX = (tid & 7) * 8;
    u32x4 rb[2], rc[2], rx; float rdt = 0.f;
#define SSD_LOAD(c) do { const size_t sr0_ = (size_t)b * LP + (size_t)(c) * CH; \
        _Pragma("unroll") for (int j = 0; j < 2; ++j) { const bf16_t* rowp = XC + (sr0_ + rowBC0 + 32 * j) * CC; rb[j] = *(const u32x4*)(rowp + SW + g * SN + nBC); rc[j] = *(const u32x4*)(rowp + SW + SG * SN + g * SN + nBC); } \
        rx = *(const u32x4*)(XC + (sr0_ + rowX) * CC + h * SP + pX); rdt = DT[(sr0_ + lane) * SH + h]; } while (0)
    SSD_LOAD(1);
    for (int c = 1; c < NCH; ++c) {
        const int hb_old = L_HB + ((c + 1) & 1) * 64 * PA, hb_new = L_HB + (c & 1) * 64 * PA;
#pragma unroll
        for (int j = 0; j < 2; ++j) { const int row = rowBC0 + 32 * j;
            *(LAS u32x4*)(lds + L_BM + row * PA + nBC * 2) = rb[j]; *(LAS u32x4*)(lds + L_CM + row * PA + nBC * 2) = rc[j];
            const unsigned w[4] = {rb[j].x, rb[j].y, rb[j].z, rb[j].w};
#pragma unroll
            for (int i = 0; i < 8; ++i) *(LAS bf16_t*)(lds + L_BMT + (nBC + i) * PB + row * 2) = (bf16_t)((i & 1) ? (w[i >> 1] >> 16) : (w[i >> 1] & 0xffffu)); }
        if (wave == 0) {
            float cs = rdt * A;
#pragma unroll
            for (int o = 1; o < 64; o <<= 1) { const float t = __shfl_up(cs, o); if (lane >= o) cs += t; }
            const float last = __shfl(cs, 63);
            acs[lane] = cs; dtv[lane] = rdt; wv[lane] = __expf(last - cs); if (lane == 0) decp[0] = __expf(last);
        }
        __syncthreads();
        { const float d = dtv[rowX], dw = d * wv[rowX]; const unsigned w[4] = {rx.x, rx.y, rx.z, rx.w};
#pragma unroll
            for (int i = 0; i < 8; ++i) { const float xf = __uint_as_float((i & 1) ? (w[i >> 1] & 0xffff0000u) : (w[i >> 1] << 16));
                *(LAS bf16_t*)(lds + L_XT + (pX + i) * PB + rowX * 2) = (bf16_t)f2bf(xf * d); *(LAS bf16_t*)(lds + L_XWT + (pX + i) * PB + rowX * 2) = (bf16_t)f2bf(xf * dw); } }
        __syncthreads();
        if (c + 1 < NCH) SSD_LOAD(c + 1);
        f32x16 accy;
#pragma unroll
        for (int i = 0; i < 16; ++i) accy[i] = 0.f;
        if (wave < 4) {
            const int lt = wave >> 1, st = wave & 1;
            if (st <= lt) {
#pragma unroll
                for (int k = 0; k < 8; ++k) accy = __builtin_amdgcn_mfma_f32_32x32x16_bf16(frag(lds + L_CM, 32 * lt + r, PA, 16 * k + 8 * hi), frag(lds + L_BM, 32 * st + r, PA, 16 * k + 8 * hi), accy, 0, 0, 0);
            }
            const float cs_s = acs[32 * st + r]; const int s = 32 * st + r;
#pragma unroll
            for (int i = 0; i < 16; ++i) { const int l = 32 * lt + crow(i, hi); const float e = __expf(fminf(acs[l] - cs_s, 0.f));
                *(LAS bf16_t*)(lds + L_MT + l * PB + s * 2) = (bf16_t)f2bf(s <= l ? accy[i] * e : 0.f); }
        } else {
            const int lt = (wave - 4) >> 1, pt = wave & 1;
#pragma unroll
            for (int k = 0; k < 8; ++k) accy = __builtin_amdgcn_mfma_f32_32x32x16_bf16(frag(lds + L_CM, 32 * lt + r, PA, 16 * k + 8 * hi), frag(lds + hb_old, 32 * pt + r, PA, 16 * k + 8 * hi), accy, 0, 0, 0);
#pragma unroll
            for (int i = 0; i < 16; ++i) accy[i] *= __expf(acs[32 * lt + crow(i, hi)]);
        }
        __syncthreads();
        if (wave >= 4) {
            const int lt = (wave - 4) >> 1, pt = wave & 1;
#pragma unroll
            for (int k = 0; k < 4; ++k) accy = __builtin_amdgcn_mfma_f32_32x32x16_bf16(frag(lds + L_MT, 32 * lt + r, PB, 16 * k + 8 * hi), frag(lds + L_XT, 32 * pt + r, PB, 16 * k + 8 * hi), accy, 0, 0, 0);
            if (c >= 2) {
                const size_t sr0 = (size_t)b * LP + (size_t)c * CH; const size_t m0 = (size_t)b * SEQ + (size_t)(c * CH - ROW_REAL);
#pragma unroll
                for (int i = 0; i < 16; ++i) { const int l = 32 * lt + crow(i, hi), p = 32 * pt + r;
                    const float xv = bf2f(XC[(sr0 + l) * CC + h * SP + p]);
                    YS[(m0 + l) * SW + h * SP + p] = (bf16_t)f2bf(accy[i] + Dh * xv); }
            }
        } else {
            const int pt = wave & 1, nt0 = 2 * (wave >> 1); const float dec = decp[0];
#pragma unroll
            for (int i = 0; i < 16; ++i) { accH[0][i] *= dec; accH[1][i] *= dec; }
#pragma unroll
            for (int k = 0; k < 4; ++k) { const bf16x8 a = frag(lds + L_XWT, 32 * pt + r, PB, 16 * k + 8 * hi);
#pragma unroll
                for (int j = 0; j < 2; ++j) accH[j] = __builtin_amdgcn_mfma_f32_32x32x16_bf16(a, frag(lds + L_BMT, 32 * (nt0 + j) + r, PB, 16 * k + 8 * hi), accH[j], 0, 0, 0); }
#pragma unroll
            for (int j = 0; j < 2; ++j)
#pragma unroll
                for (int i = 0; i < 16; ++i) *(LAS bf16_t*)(lds + hb_new + (32 * pt + crow(i, hi)) * PA + (32 * (nt0 + j) + r) * 2) = (bf16_t)f2bf(accH[j][i]);
        }
        __syncthreads();
    }
#undef SSD_LOAD
}
}
__device__ __forceinline__ void ph2_ssd(Frame& F) {
    for (int u = blockIdx.x; u < NB * SH; u += gridDim.x) ssd::unit(F, u / SH, u % SH);
}

__device__ __forceinline__ void ph3_norms(Frame& F) {
    const bf16_t* O = (const bf16_t*)(F.ws + WS_O); const bf16_t* YS = (const bf16_t*)(F.ws + WS_YS); const bf16_t* Z = (const bf16_t*)(F.ws + WS_Z); bf16_t* A2 = (bf16_t*)(F.ws + WS_A2);
    const float* ga = F.in[I_GATT]; const float* gs = F.in[I_GSSM];
    for (int m = F.gw; m < M; m += F.NGW) {
        float a[16]; float ss = 0.f;
#pragma unroll
        for (int j = 0; j < 2; ++j) { const u32x4 w = *(const u32x4*)(O + (size_t)m * AW + 8 * F.lane + 512 * j); const unsigned ww[4] = {w.x, w.y, w.z, w.w};
#pragma unroll
            for (int i = 0; i < 4; ++i) { a[8 * j + 2 * i] = __uint_as_float(ww[i] << 16); a[8 * j + 2 * i + 1] = __uint_as_float(ww[i] & 0xffff0000u); } }
#pragma unroll
        for (int i = 0; i < 16; ++i) ss += a[i] * a[i];
        float rstd = rsqrtf(wave_sum(ss) * (1.f / AW) + EPS);
#pragma unroll
        for (int j = 0; j < 2; ++j) { const int c0 = 8 * F.lane + 512 * j; u32x4 w;
            w.x = pk2(a[8 * j] * rstd * ga[c0], a[8 * j + 1] * rstd * ga[c0 + 1]); w.y = pk2(a[8 * j + 2] * rstd * ga[c0 + 2], a[8 * j + 3] * rstd * ga[c0 + 3]);
            w.z = pk2(a[8 * j + 4] * rstd * ga[c0 + 4], a[8 * j + 5] * rstd * ga[c0 + 5]); w.w = pk2(a[8 * j + 6] * rstd * ga[c0 + 6], a[8 * j + 7] * rstd * ga[c0 + 7]);
            *(u32x4*)(A2 + (size_t)m * 3072 + c0) = w; }
        float y[32]; ss = 0.f;
#pragma unroll
        for (int j = 0; j < 4; ++j) { const u32x4 w = *(const u32x4*)(YS + (size_t)m * SW + 8 * F.lane + 512 * j); const u32x4 zz = *(const u32x4*)(Z + (size_t)m * SW + 8 * F.lane + 512 * j);
            const unsigned ww[4] = {w.x, w.y, w.z, w.w}, zw[4] = {zz.x, zz.y, zz.z, zz.w};
#pragma unroll
            for (int i = 0; i < 4; ++i) { y[8 * j + 2 * i] = __uint_as_float(ww[i] << 16) * siluf_(__uint_as_float(zw[i] << 16)); y[8 * j + 2 * i + 1] = __uint_as_float(ww[i] & 0xffff0000u) * siluf_(__uint_as_float(zw[i] & 0xffff0000u)); } }
#pragma unroll
        for (int i = 0; i < 32; ++i) ss += y[i] * y[i];
        rstd = rsqrtf(wave_sum(ss) * (1.f / SW) + EPS);
#pragma unroll
        for (int j = 0; j < 4; ++j) { const int c0 = 8 * F.lane + 512 * j; u32x4 w;
            w.x = pk2(y[8 * j] * rstd * gs[c0], y[8 * j + 1] * rstd * gs[c0 + 1]); w.y = pk2(y[8 * j + 2] * rstd * gs[c0 + 2], y[8 * j + 3] * rstd * gs[c0 + 3]);
            w.z = pk2(y[8 * j + 4] * rstd * gs[c0 + 4], y[8 * j + 5] * rstd * gs[c0 + 5]); w.w = pk2(y[8 * j + 6] * rstd * gs[c0 + 6], y[8 * j + 7] * rstd * gs[c0 + 7]);
            *(u32x4*)(A2 + (size_t)m * 3072 + AW + c0) = w; }
    }
}

__device__ __forceinline__ void ph4_outproj_oracle(Frame& F) {
    const bf16_t* A2 = (const bf16_t*)(F.ws + WS_A2); const float* W = F.in[I_WOUT]; const float* X = F.in[I_X]; float* H1 = F.out;
    constexpr int TM = M / 64, TN = DM / 256;
    for (int tile = blockIdx.x; tile < TM * TN; tile += gridDim.x) {
        const int tm = tile / TN, tn = tile % TN;
        gemm_tile_f32(F, 3072,
            [&](int r, int k) -> float { return bf2f(A2[(size_t)(tm * 64 + r) * 3072 + k]); },
            [&](int k, int c) -> float { return W[(size_t)k * DM + tn * 256 + c]; },
            [&](int r, int c, float v0, float v1) { const size_t o = (size_t)(tm * 64 + r) * DM + tn * 256 + c; H1[o] = X[o] + v0; H1[o + 32] = X[o + 32] + v1; });
    }
}

__device__ __forceinline__ void ph5_router(Frame& F) {
    const float* H1 = F.out; bf16_t* XN2 = (bf16_t*)(F.ws + WS_XN2); const float* g = F.in[I_GFFN]; const float* WR = F.in[I_WR]; const float* BR = F.in[I_BR];
    int* TOKE = (int*)(F.ws + WS_TOKE); int* TOKP = (int*)(F.ws + WS_TOKP); int* LIST = (int*)(F.ws + WS_LIST); float* LISTW = (float*)(F.ws + WS_LISTW);
    for (int m = F.gw; m < M; m += F.NGW) {
        f32x4 v[8]; float ss = 0.f;
#pragma unroll
        for (int j = 0; j < 8; ++j) { v[j] = *(const f32x4*)(H1 + (size_t)m * DM + 4 * F.lane + 256 * j); ss += (v[j].x * v[j].x + v[j].y * v[j].y) + (v[j].z * v[j].z + v[j].w * v[j].w); }
        const float rstd = rsqrtf(wave_sum(ss) * (1.f / DM) + EPS);
        float part[32];
#pragma unroll
        for (int e = 0; e < 32; ++e) part[e] = 0.f;
#pragma unroll
        for (int j = 0; j < 8; ++j) { const f32x4 gg = *(const f32x4*)(g + 4 * F.lane + 256 * j);
            v[j].x *= rstd * gg.x; v[j].y *= rstd * gg.y; v[j].z *= rstd * gg.z; v[j].w *= rstd * gg.w;
            u32x2 w; w.x = pk2(v[j].x, v[j].y); w.y = pk2(v[j].z, v[j].w);
            *(u32x2*)(XN2 + (size_t)m * DM + 4 * F.lane + 256 * j) = w;
#pragma unroll
            for (int i = 0; i < 4; ++i) { const float nv = v[j][i]; const float* wr = WR + (size_t)(4 * F.lane + 256 * j + i) * NE;
#pragma unroll
                for (int e4 = 0; e4 < 8; ++e4) { const f32x4 ww = *(const f32x4*)(wr + 4 * e4);
                    part[4 * e4] += nv * ww.x; part[4 * e4 + 1] += nv * ww.y; part[4 * e4 + 2] += nv * ww.z; part[4 * e4 + 3] += nv * ww.w; } } }
        float logit = 0.f;
#pragma unroll
        for (int e = 0; e < 32; ++e) { const float s = wave_sum(part[e]); if (F.lane == e) logit = s; }
        logit = (F.lane < 32) ? logit + BR[F.lane & 31] : -INFINITY;
        float tv[4]; int ti[4]; float cur = logit;
#pragma unroll
        for (int k = 0; k < 4; ++k) {
            float bv = cur; int bi = F.lane;
#pragma unroll
            for (int o = 1; o < 64; o <<= 1) { const float ov = __shfl_xor(bv, o); const int oi = __shfl_xor(bi, o); if (ov > bv || (ov == bv && oi < bi)) { bv = ov; bi = oi; } }
            tv[k] = bv; ti[k] = bi; if (F.lane == bi) cur = -INFINITY;
        }
        const float e0 = 1.f, e1 = __expf(tv[1] - tv[0]), e2 = __expf(tv[2] - tv[0]), e3 = __expf(tv[3] - tv[0]); const float rs = 1.f / (e0 + e1 + e2 + e3);
        if (F.lane < 4) {
            const int e = F.lane == 0 ? ti[0] : F.lane == 1 ? ti[1] : F.lane == 2 ? ti[2] : ti[3];
            const float w = (F.lane == 0 ? e0 : F.lane == 1 ? e1 : F.lane == 2 ? e2 : e3) * rs;
            const int pos = (int)__hip_atomic_fetch_add(F.ctl + CW_CNT + 64 * e, 1u, __ATOMIC_RELAXED, __HIP_MEMORY_SCOPE_AGENT);
            TOKE[m * 4 + F.lane] = e; TOKP[m * 4 + F.lane] = pos; LIST[(size_t)e * M + pos] = m; LISTW[(size_t)e * M + pos] = w;
        }
    }
}

constexpr int TAB_OFF = MISC_OFF + 256;
__device__ __forceinline__ void load_expert_tables(Frame& F, LAS int* tab) {
    __syncthreads();
    if (F.tid == 0) { int rb = 0, tb = 0, t2 = 0;
        for (int e = 0; e < NE; ++e) { const int c = (int)__hip_atomic_load(F.ctl + CW_CNT + 64 * e, __ATOMIC_RELAXED, __HIP_MEMORY_SCOPE_AGENT);
            tab[e] = c; tab[32 + e] = rb; tab[64 + e] = tb; tab[128 + e] = t2; rb += ((c + 255) / 256) * 256; tb += (c + 63) / 64; t2 += (c + 255) / 256; }
        tab[96] = tb; tab[160] = t2; }
    __syncthreads();
}
struct GroupedOrder {
    const LAS int* tab; int NT, G, c, nwg; const char* A; const char* W; size_t wstride, tstep; const int* LIST; bool gather;
    __device__ __forceinline__ bool next(int i, pg8::Unit& u) const {
        const int L = i * G + c; if (L >= nwg) return false;
        int wgid = L; { const int q = nwg / 8, r = nwg % 8, xcd = wgid % 8, off = wgid / 8; wgid = (xcd < r ? xcd * (q + 1) : r * (q + 1) + (xcd - r) * q) + off; }
        int e = 0;
        for (int k = 1; k < NE; ++k) if (tab[128 + k] * NT <= wgid) e = k;
        e = __builtin_amdgcn_readfirstlane(e);
        const int t0 = __builtin_amdgcn_readfirstlane(tab[128 + e]), t1 = __builtin_amdgcn_readfirstlane(tab[128 + e + 1]);
        const int idx = wgid - t0 * NT, tiles = t1 - t0;
        u.x = idx % tiles; u.pn = idx / tiles; u.e = e; u.pm = t0 + u.x; return true;
    }
    __device__ __forceinline__ const char* a_base(const pg8::Unit& u) const { return gather ? A : A + (size_t)u.pm * tstep; }
    __device__ __forceinline__ const char* b_base(const pg8::Unit& u) const { return W + (size_t)u.e * wstride + (size_t)u.pn * tstep; }
    __device__ __forceinline__ int a_row(const pg8::Unit& u, int R) const { const int cnt = __builtin_amdgcn_readfirstlane(tab[u.e]); int pos = u.x * 256 + R; pos = pos < cnt ? pos : cnt - 1; return LIST[(size_t)u.e * M + pos]; }
};
struct EpiGateUp {
    static constexpr bool PERM = true;
    bf16_t* H; const float* Bgu;
    __device__ __forceinline__ void operator()(const f32x4 (&acc)[2][2][4][2], const pg8::Unit& u, int wr, int wc, int fr, int fq) const {
        asm volatile("" : "+v"(fr), "+v"(fq));
        const int j0 = u.pn * 128 + wc * 32 + 8 * fq; const float* bg = Bgu + (size_t)u.e * 4096 + j0;
        const f32x4 bg0 = *(const f32x4*)bg, bg1 = *(const f32x4*)(bg + 4), bu0 = *(const f32x4*)(bg + 2048), bu1 = *(const f32x4*)(bg + 2052);
#pragma unroll
        for (int ai = 0; ai < 2; ++ai)
#pragma unroll
            for (int m = 0; m < 4; ++m) { const int r = ai * 128 + wr * 64 + m * 16 + fr; float h[8];
#pragma unroll
                for (int n = 0; n < 2; ++n) { const f32x4 gv = acc[ai][0][m][n] + (n ? bg1 : bg0), uv = acc[ai][1][m][n] + (n ? bu1 : bu0);
#pragma unroll
                    for (int i = 0; i < 4; ++i) { const float g = fminf(gv[i], 7.f), uu = fminf(fmaxf(uv[i], -7.f), 7.f);
                        h[4 * n + i] = g * __builtin_amdgcn_rcpf(1.f + __expf(-1.702f * g)) * (uu + 1.f); } }
                u32x4 w; w.x = pg8::cvt_pk_bf16(h[0], h[1]); w.y = pg8::cvt_pk_bf16(h[2], h[3]); w.z = pg8::cvt_pk_bf16(h[4], h[5]); w.w = pg8::cvt_pk_bf16(h[6], h[7]);
                *(u32x4*)(H + (size_t)(u.pm * 256 + r) * FF + j0) = w; }
    }
};
__device__ __forceinline__ void ph6_gateup(Frame& F) {
    LAS int* tab = (LAS int*)(F.lds + TAB_OFF);
    load_expert_tables(F, tab);
    GroupedOrder S{tab, 16, (int)gridDim.x, (int)blockIdx.x, __builtin_amdgcn_readfirstlane(tab[160]) * 16, (const char*)(F.ws + WS_XN2), (const char*)(F.ws + WS_WGU), (size_t)4096 * DM * 2, (size_t)256 * DM * 2, (const int*)(F.ws + WS_LIST), true};
    EpiGateUp E{(bf16_t*)(F.ws + WS_H), F.in[I_BGU]};
    pg8::gemm_phase<EpiGateUp, GroupedOrder, true, true>(F.lds, DM, S, E);
}
struct EpiDown {
    static constexpr bool PERM = true;
    bf16_t* Y; const float* Bd; const float* LISTW;
    __device__ __forceinline__ void operator()(const f32x4 (&acc)[2][2][4][2], const pg8::Unit& u, int wr, int wc, int fr, int fq) const {
        asm volatile("" : "+v"(fr), "+v"(fq));
        const int col0 = u.pn * 256 + wc * 32 + 8 * fq; const float* bd = Bd + (size_t)u.e * DM + col0;
        f32x4 bv[2][2];
#pragma unroll
        for (int bj = 0; bj < 2; ++bj)
#pragma unroll
            for (int n = 0; n < 2; ++n) bv[bj][n] = *(const f32x4*)(bd + bj * 128 + 4 * n);
#pragma unroll
        for (int ai = 0; ai < 2; ++ai)
#pragma unroll
            for (int m = 0; m < 4; ++m) { const int r = ai * 128 + wr * 64 + m * 16 + fr; const float gw = LISTW[(size_t)u.e * M + u.x * 256 + r];
                bf16_t* rowp = Y + (size_t)(u.pm * 256 + r) * DM + col0;
#pragma unroll
                for (int bj = 0; bj < 2; ++bj) { const f32x4 v0 = (acc[ai][bj][m][0] + bv[bj][0]) * gw, v1 = (acc[ai][bj][m][1] + bv[bj][1]) * gw;
                    u32x4 w; w.x = pg8::cvt_pk_bf16(v0[0], v0[1]); w.y = pg8::cvt_pk_bf16(v0[2], v0[3]); w.z = pg8::cvt_pk_bf16(v1[0], v1[1]); w.w = pg8::cvt_pk_bf16(v1[2], v1[3]);
                    *(u32x4*)(rowp + bj * 128) = w; } }
    }
};
__device__ __forceinline__ void ph7_down(Frame& F) {
    LAS int* tab = (LAS int*)(F.lds + TAB_OFF);
    load_expert_tables(F, tab);
    GroupedOrder S{tab, 8, (int)gridDim.x, (int)blockIdx.x, __builtin_amdgcn_readfirstlane(tab[160]) * 8, (const char*)(F.ws + WS_H), (const char*)(F.ws + WS_WD), (size_t)DM * FF * 2, (size_t)256 * FF * 2, nullptr, false};
    EpiDown E{(bf16_t*)(F.ws + WS_Y), F.in[I_BD], (const float*)(F.ws + WS_LISTW)};
    pg8::gemm_phase<EpiDown, GroupedOrder, false, true>(F.lds, FF, S, E);
}

__device__ __forceinline__ void ph6_gateup_oracle(Frame& F) {
    const bf16_t* XN2 = (const bf16_t*)(F.ws + WS_XN2); const int* LIST = (const int*)(F.ws + WS_LIST); bf16_t* H = (bf16_t*)(F.ws + WS_H);
    LAS int* tab = (LAS int*)(F.lds + TAB_OFF); LAS int* toks = tab + 192;
    load_expert_tables(F, tab);
    const int ntm = tab[96];
    for (int tile = blockIdx.x; tile < ntm * 16; tile += gridDim.x) {
        const int tmg = tile / 16, nt = tile % 16; int e = 0;
        for (int i = 1; i < NE; ++i) if (tab[64 + i] <= tmg) e = i;
        const int mt = tmg - tab[64 + e], cnt = tab[e], rb = tab[32 + e];
        __syncthreads();
        if (F.tid < 64) { const int pos = mt * 64 + F.tid; toks[F.tid] = pos < cnt ? LIST[(size_t)e * M + pos] : -1; }
        __syncthreads();
        const float* W = F.in[I_WGU] + (size_t)e * DM * 4096; const float* Bg = F.in[I_BGU] + (size_t)e * 4096;
        gemm_tile_f32(F, DM,
            [&](int r, int k) -> float { const int t = toks[r]; return t >= 0 ? bf2f(XN2[(size_t)t * DM + k]) : 0.f; },
            [&](int k, int c) -> float { const int vc = nt * 256 + c, blk = vc >> 6, i = vc & 63; const int col = (i < 32) ? blk * 32 + i : 2048 + blk * 32 + (i - 32); return W[(size_t)k * 4096 + col]; },
            [&](int r, int c, float v0, float v1) { const int pos = mt * 64 + r; if (pos < cnt) { const int vc = nt * 256 + c, j = (vc >> 6) * 32 + (vc & 31);
                float gv = fminf(v0 + Bg[j], 7.f), uv = fminf(fmaxf(v1 + Bg[2048 + j], -7.f), 7.f);
                H[(size_t)(rb + pos) * FF + j] = (bf16_t)f2bf(gv * sigmoidf_(1.702f * gv) * (uv + 1.f)); } });
    }
}
__device__ __forceinline__ void ph7_down_oracle(Frame& F) {
    const bf16_t* H = (const bf16_t*)(F.ws + WS_H); const float* LISTW = (const float*)(F.ws + WS_LISTW); bf16_t* Y = (bf16_t*)(F.ws + WS_Y);
    LAS int* tab = (LAS int*)(F.lds + TAB_OFF);
    load_expert_tables(F, tab);
    const int ntm = tab[96];
    for (int tile = blockIdx.x; tile < ntm * 8; tile += gridDim.x) {
        const int tmg = tile / 8, nt = tile % 8; int e = 0;
        for (int i = 1; i < NE; ++i) if (tab[64 + i] <= tmg) e = i;
        const int mt = tmg - tab[64 + e], cnt = tab[e], rb = tab[32 + e];
        const float* W = F.in[I_WD] + (size_t)e * FF * DM; const float* Bd = F.in[I_BD] + (size_t)e * DM;
        gemm_tile_f32(F, FF,
            [&](int r, int k) -> float { const int pos = mt * 64 + r; return pos < cnt ? bf2f(H[(size_t)(rb + pos) * FF + k]) : 0.f; },
            [&](int k, int c) -> float { return W[(size_t)k * DM + nt * 256 + c]; },
            [&](int r, int c, float v0, float v1) { const int pos = mt * 64 + r; if (pos < cnt) { const float w = LISTW[(size_t)e * M + pos]; const int col = nt * 256 + c;
                Y[(size_t)(rb + pos) * DM + col] = (bf16_t)f2bf(w * (v0 + Bd[col])); Y[(size_t)(rb + pos) * DM + col + 32] = (bf16_t)f2bf(w * (v1 + Bd[col + 32])); } });
    }
}

__device__ __forceinline__ void ph8_final(Frame& F) {
    float* H1 = F.out; const bf16_t* Y = (const bf16_t*)(F.ws + WS_Y); const int* TOKE = (const int*)(F.ws + WS_TOKE); const int* TOKP = (const int*)(F.ws + WS_TOKP); const float* g = F.in[I_GFIN];
    LAS int* tab = (LAS int*)(F.lds + TAB_OFF);
    load_expert_tables(F, tab);
    for (int m = F.gw; m < M; m += F.NGW) {
        size_t rows[4];
#pragma unroll
        for (int k = 0; k < 4; ++k) rows[k] = (size_t)(tab[32 + TOKE[m * 4 + k]] + TOKP[m * 4 + k]);
        f32x4 v[8]; float ss = 0.f;
#pragma unroll
        for (int j = 0; j < 8; ++j) { const int c = 4 * F.lane + 256 * j; v[j] = *(const f32x4*)(H1 + (size_t)m * DM + c);
#pragma unroll
            for (int k = 0; k < 4; ++k) { const u32x2 w = *(const u32x2*)(Y + rows[k] * DM + c);
                v[j].x += __uint_as_float(w.x << 16); v[j].y += __uint_as_float(w.x & 0xffff0000u); v[j].z += __uint_as_float(w.y << 16); v[j].w += __uint_as_float(w.y & 0xffff0000u); }
            ss += (v[j].x * v[j].x + v[j].y * v[j].y) + (v[j].z * v[j].z + v[j].w * v[j].w); }
        const float rstd = rsqrtf(wave_sum(ss) * (1.f / DM) + EPS);
#pragma unroll
        for (int j = 0; j < 8; ++j) { const int c = 4 * F.lane + 256 * j; const f32x4 gg = *(const f32x4*)(g + c);
            *(f32x4*)(H1 + (size_t)m * DM + c) = (f32x4){v[j].x * rstd * gg.x, v[j].y * rstd * gg.y, v[j].z * rstd * gg.z, v[j].w * rstd * gg.w}; }
    }
}

constexpr int NPHASES = 10;
__global__ void __launch_bounds__(NTHREADS, 2) fwd(Params p) {
    extern __shared__ __attribute__((aligned(16))) unsigned char lds_raw[];
    Frame F;
    F.lds = (LAS unsigned char*)lds_raw;
    F.tid = threadIdx.x; F.lane = F.tid & 63; F.wave = __builtin_amdgcn_readfirstlane(F.tid >> 6);
    F.gw = blockIdx.x * NWAVES + F.wave; F.NGW = gridDim.x * NWAVES;
    F.in = p.in; F.out = p.out; F.ws = p.ws; F.ctl = (unsigned*)(p.ws + WS_CTL);
    volatile LAS unsigned* MISC = (volatile LAS unsigned*)(F.lds + MISC_OFF);
    if (F.tid < 32) MISC[F.tid] = 0u;
    __syncthreads();
    const int lo = p.ph_lo, hi = p.ph_hi;
    XcdBarrier bar; bar.bar = F.ctl + CW_BAR; bar.x = 0; bar.st = nullptr;
    if (hi - lo > 1) bar = xcd_barrier_post(F.ctl + CW_BAR, MISC + 8);
#define IN(k) (lo <= (k) && (k) < hi)
#define SEAM(k) do { if (IN(k) && IN((k) + 1)) xcd_barrier(bar); } while (0)
    if (IN(0)) { ph0_prologue(F); ph0_weights(F, true); } SEAM(0);
    if (IN(1)) { ph1_inproj(F); } SEAM(1);
    if (IN(2)) { ph1b_conv_scan(F); } SEAM(2);
    if (IN(3)) { ph2_attn(F); ph2_ssd(F); } SEAM(3);
    if (IN(4)) { ph3_norms(F); } SEAM(4);
    if (IN(5)) { ph4_outproj(F); } SEAM(5);
    if (IN(6)) { ph5_router(F); } SEAM(6);
    if (IN(7)) { ph6_gateup(F); } SEAM(7);
    if (IN(8)) { ph7_down(F); } SEAM(8);
    if (IN(9)) { ph8_final(F); }
#undef IN
#undef SEAM
}

extern "C" void kernel_launch(void* const* d_in, const int* in_sizes, int n_in, void* d_out, int out_size, void* d_ws, size_t ws_size, hipStream_t stream) {
    static int grid = 0;
    if (grid == 0) {
        if (n_in != 21 || out_size != M * DM || ws_size < WS_END) { fprintf(stderr, "kernel_launch: unexpected shapes (n_in %d, out %d, ws %zu < %zu)\n", n_in, out_size, ws_size, (size_t)WS_END); grid = -1; return; }
        int dev = 0, cus = 0, per_cu = 0;
        if (hipGetDevice(&dev) != hipSuccess || hipDeviceGetAttribute(&cus, hipDeviceAttributeMultiprocessorCount, dev) != hipSuccess) { grid = -1; return; }
        if (hipFuncSetAttribute((const void*)fwd, hipFuncAttributeMaxDynamicSharedMemorySize, LDS_BYTES) != hipSuccess) { fprintf(stderr, "kernel_launch: hipFuncSetAttribute failed\n"); grid = -1; return; }
        if (hipOccupancyMaxActiveBlocksPerMultiprocessor(&per_cu, (const void*)fwd, NTHREADS, LDS_BYTES) != hipSuccess || per_cu < 1) fprintf(stderr, "kernel_launch: occupancy query says %d\n", per_cu);
        (void)hipGetLastError();
        grid = cus;
    }
    if (grid < 0) return;
    (void)hipMemsetAsync((char*)d_ws + WS_CTL, 0, CTL_ZERO_BYTES, stream);
    Params p{};
    for (int i = 0; i < 21; ++i) p.in[i] = (const float*)d_in[i];
    p.out = (float*)d_out; p.ws = (unsigned char*)d_ws;
#if MK_ONE_LAUNCH
    p.ph_lo = 0; p.ph_hi = NPHASES;
    hipLaunchKernelGGL(fwd, dim3(grid), dim3(NTHREADS), LDS_BYTES, stream, p);
#else
    for (int k = 0; k < NPHASES; ++k) { p.ph_lo = k; p.ph_hi = k + 1; hipLaunchKernelGGL(fwd, dim3(grid), dim3(NTHREADS), LDS_BYTES, stream, p); }
#endif
}
```

```cpp
#include <hip/hip_runtime.h>
#include <cstdio>
#include <cstdint>

#ifndef PROBE_MASK
#define PROBE_MASK 0
#endif
#ifndef MK_ONE_LAUNCH
#define MK_ONE_LAUNCH 1
#endif

#define GAS __attribute__((address_space(1)))
#define LAS __attribute__((address_space(3)))
typedef unsigned short bf16_t;
typedef float f32x4 __attribute__((ext_vector_type(4)));
typedef float f32x16 __attribute__((ext_vector_type(16)));
typedef unsigned u32x4 __attribute__((ext_vector_type(4)));
typedef unsigned u32x2 __attribute__((ext_vector_type(2)));

constexpr int NB = 4, SEQ = 4096, DM = 2048, NMETA = 16;
constexpr int M = NB * SEQ;
constexpr int LP = 4224;
constexpr int ROW_META = 112, ROW_REAL = 128;
constexpr int SR = NB * LP;
constexpr int AH = 16, HD = 64, AW = 1024;
constexpr int SH = 32, SP = 64, SW = 2048, SG = 4, SN = 128, CC = 3072;
constexpr int INC = 8240;
constexpr int C_Q = 0, C_K = 1024, C_V = 2048, C_F = 3072, C_Z = 3088, C_X = 5136, C_DT = 8208;
constexpr int NE = 32, TOPK = 4, FF = 2048;
constexpr float EPS = 1e-5f, LOG2E = 1.4426950408889634f, QSCALE = 0.125f * 1.4426950408889634f;
constexpr int NTHREADS = 512, NWAVES = 8;

constexpr size_t MiB = 1ull << 20;
constexpr size_t WS_CTL = 0, CTL_ZERO_BYTES = 1 * MiB;
constexpr size_t WS_XN   = 2 * MiB;
constexpr size_t WS_MX   = WS_XN;
constexpr size_t WS_Q    = WS_XN   + (size_t)(M + 256) * DM * 2;
constexpr size_t WS_K    = WS_Q    + (size_t)M * AW * 2;
constexpr size_t WS_V    = WS_K    + (size_t)(SR + 64) * AW * 2;
constexpr size_t WS_Z    = WS_V    + (size_t)(SR + 64) * AW * 2;
constexpr size_t WS_H1B  = WS_Z;
constexpr size_t WS_XBC  = WS_Z    + (size_t)M * SW * 2;
constexpr size_t WS_XC   = WS_XBC  + (size_t)SR * CC * 2;
constexpr size_t WS_FDT  = WS_XC   + (size_t)SR * CC * 2;
constexpr size_t WS_DT   = WS_FDT  + (size_t)SR * 48 * 4;
constexpr size_t WS_CF   = WS_DT   + (size_t)SR * 32 * 4;
constexpr size_t WS_O    = WS_CF   + (size_t)SR * 16 * 4;
constexpr size_t WS_YS   = WS_O    + (size_t)M * AW * 2;
constexpr size_t WS_A2   = WS_YS   + (size_t)M * SW * 2;
constexpr size_t WS_XN2  = WS_A2   + (size_t)M * 3072 * 2;
constexpr size_t WS_TOKE = WS_XN2  + (size_t)M * DM * 2;
constexpr size_t WS_TOKP = WS_TOKE + (size_t)M * 4 * 4;
constexpr size_t WS_LIST = WS_TOKP + (size_t)M * 4 * 4;
constexpr size_t WS_LISTW= WS_LIST + (size_t)NE * M * 4;
constexpr int HROWS = 65536 + NE * 256;
constexpr size_t WS_H    = WS_LISTW+ (size_t)NE * M * 4;
constexpr size_t WS_Y    = WS_H    + (size_t)HROWS * FF * 2;
constexpr size_t WS_WIN  = WS_Y    + (size_t)HROWS * DM * 2;
constexpr size_t WS_WOUT = WS_WIN  + (size_t)8448 * DM * 2;
constexpr size_t WS_WGU  = WS_WOUT + (size_t)DM * 3072 * 2;
constexpr size_t WS_WD   = WS_WGU  + (size_t)NE * 4096 * DM * 2;
constexpr int CFT_LD = 4352;
constexpr size_t WS_CFT  = WS_WD   + (size_t)NE * DM * FF * 2;
constexpr size_t WS_WRT  = WS_CFT  + (size_t)NB * AH * CFT_LD * 4;
constexpr size_t WS_SSQA = WS_WRT  + (size_t)NE * DM * 2;
constexpr size_t WS_SSQS = WS_SSQA + (size_t)M * 16 * 4;
constexpr size_t WS_RS   = WS_SSQS + (size_t)M * 32 * 4;
constexpr size_t WS_END  = WS_RS   + (size_t)M * 2 * 4;
constexpr int CW_BAR = 4096;
constexpr int CW_CNT = 8192;
constexpr int CW_WQ = 12288;

__device__ __forceinline__ float bf2f(bf16_t v) { return __uint_as_float((unsigned)v << 16); }
typedef float f32x2_cv __attribute__((ext_vector_type(2))); typedef __bf16 bf16x2_cv __attribute__((ext_vector_type(2)));
__device__ __forceinline__ unsigned pk2(float lo, float hi) { const f32x2_cv v = {lo, hi}; return __builtin_bit_cast(unsigned, __builtin_convertvector(v, bf16x2_cv)); }
__device__ __forceinline__ unsigned f2bf(float f) { return pk2(f, 0.f) & 0xffffu; }
__device__ __forceinline__ float wave_sum(float v) {
#pragma unroll
    for (int o = 1; o < 64; o <<= 1) v += __shfl_xor(v, o);
    return v;
}
__device__ __forceinline__ float sigmoidf_(float x) { return __builtin_amdgcn_rcpf(1.0f + __expf(-x)); }
__device__ __forceinline__ float siluf_(float x) { return x * __builtin_amdgcn_rcpf(1.0f + __expf(-x)); }
__device__ __forceinline__ float softplusf_(float x) { return x > 20.f ? x : log1pf(expf(x)); }
__device__ __forceinline__ float logsigmoidf_(float x) { return x < 0.f ? x - log1pf(expf(x)) : -log1pf(expf(-x)); }

#define XB_TMO      128
#define XB_XCNT(j)  (256  + 64 * (j))
#define XB_XSUB(j)  (1280 + 64 * (j))
#define XB_XGEN(j)  (2304 + 64 * (j))
#define XB_TOP      3328
#define XB_TOPGEN   3392
#define XCD_BAR_WORDS 3456
#define XB_SPIN_CAP (1u << 23)
__device__ __forceinline__ unsigned xb_ld(unsigned* p)              { return __hip_atomic_load(p, __ATOMIC_RELAXED, __HIP_MEMORY_SCOPE_AGENT); }
__device__ __forceinline__ unsigned xb_add(unsigned* p, unsigned v) { return __hip_atomic_fetch_add(p, v, __ATOMIC_RELAXED, __HIP_MEMORY_SCOPE_AGENT); }
__device__ __forceinline__ unsigned xb_xcc_id() { return (unsigned)__builtin_amdgcn_s_getreg((3 << 11) | 20) & 0xFu; }
#define XB_SPIN(cond, bar) do { unsigned _sp = 0; while (cond) { __builtin_amdgcn_s_sleep(1); \
    if ((++_sp & 255u) == 0u) { if (xb_ld(&(bar)[XB_TMO])) break; if (_sp > XB_SPIN_CAP) { atomicAdd(&(bar)[XB_TMO], 1u); break; } } } } while (0)
struct XcdBarrier { unsigned* bar; unsigned x; volatile LAS unsigned* st; };
__device__ __forceinline__ XcdBarrier xcd_barrier_post(unsigned* bar, volatile LAS unsigned* st) {
    XcdBarrier b; b.bar = bar; b.x = xb_xcc_id(); b.st = st;
    if (threadIdx.x == 0) (void)xb_add(&bar[XB_XCNT(b.x)], 1u);
    return b;
}
__device__ __forceinline__ void xcd_barrier_complete(unsigned* bar, unsigned x, unsigned& nloc, unsigned& nx) {
    const unsigned G = gridDim.x * gridDim.y * gridDim.z;
    unsigned sum, cnt, mine, sp = 0u;
    for (;;) {
        sum = 0u; cnt = 0u; mine = 0u;
#pragma unroll
        for (unsigned j = 0; j < 16; ++j) { const unsigned c = xb_ld(&bar[XB_XCNT(j)]); sum += c; cnt += (c > 0u) ? 1u : 0u; mine = (j == x) ? c : mine; }
        if (sum == G) break;
        __builtin_amdgcn_s_sleep(1);
        if ((++sp & 255u) == 0u) { if (xb_ld(&bar[XB_TMO])) break; if (sp > XB_SPIN_CAP) { atomicAdd(&bar[XB_TMO], 1u); break; } }
    }
    nloc = mine > 0u ? mine : 1u; nx = cnt > 0u ? cnt : 1u;
}
__device__ __forceinline__ void xcd_barrier(const XcdBarrier& b) {
    asm volatile("s_waitcnt vmcnt(0)" ::: "memory");
    __syncthreads();
    if (threadIdx.x == 0) {
        unsigned* bar = b.bar;
        __builtin_amdgcn_s_waitcnt(0);
        unsigned nloc = b.st[0], nx = b.st[1];
        if (nloc == 0u) { xcd_barrier_complete(bar, b.x, nloc, nx); b.st[0] = nloc; b.st[1] = nx; }
        const unsigned old = xb_add(&bar[XB_XSUB(b.x)], 1u);
        const unsigned gen = old / nloc;
        if (old + 1u == (gen + 1u) * nloc) {
            __builtin_amdgcn_fence(__ATOMIC_RELEASE, "agent");
            asm volatile("s_waitcnt vmcnt(0)" ::: "memory");
            const unsigned og = xb_add(&bar[XB_TOP], 1u);
            const unsigned tg = og / nx;
            if (og + 1u == (tg + 1u) * nx) xb_add(&bar[XB_TOPGEN], 1u);
            else XB_SPIN(xb_ld(&bar[XB_TOPGEN]) == tg, bar);
            __builtin_amdgcn_fence(__ATOMIC_ACQUIRE, "agent");
            xb_add(&bar[XB_XGEN(b.x)], 1u);
            asm volatile("s_waitcnt vmcnt(0)" ::: "memory");
        } else {
            XB_SPIN(xb_ld(&bar[XB_XGEN(b.x)]) == gen, bar);
            __builtin_amdgcn_fence(__ATOMIC_ACQUIRE, "agent");
            asm volatile("s_waitcnt vmcnt(0)" ::: "memory");
        }
    }
    __syncthreads();
}

struct Params { const float* in[21]; float* out; unsigned char* ws; int ph_lo, ph_hi; };
enum { I_X = 0, I_META, I_GMIX, I_WIN, I_FB, I_GATT, I_CW, I_CB, I_DTB, I_ALOG, I_DSKIP, I_GSSM, I_WOUT, I_GFFN, I_WR, I_BR, I_WGU, I_BGU, I_WD, I_BD, I_GFIN };
struct Frame {
    LAS unsigned char* lds; int tid, lane, wave, gw, NGW;
    const float* const* in; float* out; unsigned char* ws; unsigned* ctl;
};
constexpr int LDS_BYTES = 147456;
constexpr int MISC_OFF = 131072;

__device__ __forceinline__ void rmsnorm_row_bf16(const float* src, const float* gain, bf16_t* dst, int lane) {
    f32x4 v[8]; float ss = 0.f;
#pragma unroll
    for (int j = 0; j < 8; ++j) { v[j] = *(const f32x4*)(src + 4 * lane + 256 * j); ss += (v[j].x * v[j].x + v[j].y * v[j].y) + (v[j].z * v[j].z + v[j].w * v[j].w); }
    const float rstd = rsqrtf(wave_sum(ss) * (1.f / DM) + EPS);
#pragma unroll
    for (int j = 0; j < 8; ++j) { const f32x4 g = *(const f32x4*)(gain + 4 * lane + 256 * j);
        u32x2 w; w.x = pk2(v[j].x * rstd * g.x, v[j].y * rstd * g.y); w.y = pk2(v[j].z * rstd * g.z, v[j].w * rstd * g.w);
        *(u32x2*)(dst + 4 * lane + 256 * j) = w; }
}
__device__ __forceinline__ void ph0_prologue(Frame& F) {
    bf16_t* XN = (bf16_t*)(F.ws + WS_XN);
    for (int row = F.gw; row < M + 256; row += F.NGW) {
        bf16_t* dst = XN + (size_t)row * DM;
        if (row < M) rmsnorm_row_bf16(F.in[I_X] + (size_t)row * DM, F.in[I_GMIX], dst, F.lane);
        else if (row < M + NMETA) rmsnorm_row_bf16(F.in[I_META] + (size_t)(row - M) * DM, F.in[I_GMIX], dst, F.lane);
        else {
#pragma unroll
            for (int j = 0; j < 8; ++j) *(u32x2*)(dst + 4 * F.lane + 256 * j) = (u32x2){0u, 0u};
        }
    }
    const int gt = blockIdx.x * NTHREADS + F.tid, GT = gridDim.x * NTHREADS;
    for (int i = gt; i < NB * ROW_META * (AW / 8); i += GT) { const int r = i / (AW / 8), c = i % (AW / 8); const int sr = (r / ROW_META) * LP + (r % ROW_META);
        *(u32x4*)((bf16_t*)(F.ws + WS_K) + (size_t)sr * AW + c * 8) = (u32x4){0u, 0u, 0u, 0u};
        *(u32x4*)((bf16_t*)(F.ws + WS_V) + (size_t)sr * AW + c * 8) = (u32x4){0u, 0u, 0u, 0u}; }
    for (int i = gt; i < 64 * (AW / 8); i += GT) { *(u32x4*)((bf16_t*)(F.ws + WS_K) + (size_t)SR * AW + (size_t)i * 8) = (u32x4){0u, 0u, 0u, 0u}; *(u32x4*)((bf16_t*)(F.ws + WS_V) + (size_t)SR * AW + (size_t)i * 8) = (u32x4){0u, 0u, 0u, 0u}; }
    for (int i = gt; i < NB * ROW_META * (CC / 8); i += GT) { const int r = i / (CC / 8), c = i % (CC / 8); const int sr = (r / ROW_META) * LP + (r % ROW_META);
        *(u32x4*)((bf16_t*)(F.ws + WS_XBC) + (size_t)sr * CC + c * 8) = (u32x4){0u, 0u, 0u, 0u}; *(u32x4*)((bf16_t*)(F.ws + WS_XC) + (size_t)sr * CC + c * 8) = (u32x4){0u, 0u, 0u, 0u}; }
    for (int i = gt; i < NB * ROW_META * 12; i += GT) { const int r = i / 12, c = i % 12; const int sr = (r / ROW_META) * LP + (r % ROW_META);
        *(f32x4*)((float*)(F.ws + WS_FDT) + (size_t)sr * 48 + c * 4) = (f32x4){0.f, 0.f, 0.f, 0.f}; }
}


namespace pg8 {
typedef short bf16x8 __attribute__((ext_vector_type(8)));
constexpr int BM = 256, BK = 64, HALF = 128, HTB = HALF * BK * 2, STAGE_BYTES = 8 * HTB, NXCD = 8, WGM = 8;
__host__ __device__ __forceinline__ int lds_byte(int r, int c) { const int st = (r >> 4) * 2 + (c >> 5), rr = r & 15, cc = c & 31, ob = rr * 64 + cc * 2; return st * 1024 + (ob ^ (((ob >> 9) & 1) << 5)); }
__host__ __device__ __forceinline__ void stage_rc(int b, int& R, int& C) { const int st = b / 1024, sb = b % 1024, swz = sb ^ (((sb >> 9) & 1) << 5); R = (st >> 1) * 16 + swz / 64; C = (st & 1) * 32 + (swz % 64) / 2; }
__host__ __device__ __forceinline__ int perm32(int rho) { const int n = rho >> 4, i = rho & 15; return 8 * (i >> 2) + 4 * n + (i & 3); }
struct Unit { int pm, pn, e, x; };
struct StaticOrder {
    int nM, nN, nwg, G, c; const char* A; const char* Bt; size_t tstep;
    __device__ void init(const void* A_, const void* Bt_, int M_, int N_, int K_, int G_, int c_) { A = (const char*)A_; Bt = (const char*)Bt_; nM = M_ / BM; nN = N_ / BM; nwg = nM * nN; G = G_; c = c_; tstep = (size_t)BM * K_ * 2; }
    __device__ __forceinline__ bool next(int i, Unit& u) const {
        const long L = (long)i * G + c; if (L >= nwg) return false;
        int wgid = (int)L; { const int q = nwg / NXCD, r = nwg % NXCD, xcd = wgid % NXCD, off = wgid / NXCD; wgid = (xcd < r ? xcd * (q + 1) : r * (q + 1) + (xcd - r) * q) + off; }
        const int nig = WGM * nN, gid = wgid / nig, fm = gid * WGM, gsz = (nM - fm) < WGM ? (nM - fm) : WGM;
        u.pm = fm + ((wgid % nig) % gsz); u.pn = (wgid % nig) / gsz; u.e = 0; u.x = 0; return true;
    }
    __device__ __forceinline__ const char* a_base(const Unit& u) const { return A + (size_t)u.pm * tstep; }
    __device__ __forceinline__ const char* b_base(const Unit& u) const { return Bt + (size_t)u.pn * tstep; }
    __device__ __forceinline__ int a_row(const Unit&, int) const { return 0; }
};
typedef int i32x8 __attribute__((ext_vector_type(8)));
__device__ __forceinline__ i32x8 cat8(bf16x8 a, bf16x8 b) { typedef int i32x4 __attribute__((ext_vector_type(4))); const i32x4 x = __builtin_bit_cast(i32x4, a), y = __builtin_bit_cast(i32x4, b); return (i32x8){x[0], x[1], x[2], x[3], y[0], y[1], y[2], y[3]}; }
__device__ __forceinline__ unsigned pk4_fp8(float a, float b, float c, float d) { int w = __builtin_amdgcn_cvt_pk_fp8_f32(a, b, 0, false); w = __builtin_amdgcn_cvt_pk_fp8_f32(c, d, w, true); return (unsigned)w; }
__device__ __forceinline__ unsigned cvt_pk_bf16(float lo, float hi) { unsigned r; asm volatile("v_cvt_pk_bf16_f32 %0, %1, %2" : "=v"(r) : "v"(lo), "v"(hi)); return r; }

template <class Epi, class Sched, bool GATHER, bool ALIGN_EPI, bool FP8 = false>
__device__ __forceinline__ void gemm_phase(LAS unsigned char* lds, const int KB, const Sched& S, const Epi& E) {
    const int tid = threadIdx.x, wid = __builtin_amdgcn_readfirstlane(tid >> 6), lane = tid & 63, wr = wid >> 2, wc = wid & 3, fr = lane & 15, fq = lane >> 4;
    const int nt = KB / 128;
    unsigned voffB[2], offC[2][2], offN[2][2]; int Rr[2], Cc[2];
#pragma unroll
    for (int i = 0; i < 2; ++i) { int R, C; stage_rc(tid * 16 + i * 8192, R, C); const int Rb = Epi::PERM ? ((R & ~31) + perm32(R & 31)) : R;
        voffB[i] = (unsigned)(Rb * KB + C * 2); Rr[i] = R; Cc[i] = C;
        offC[0][i] = (unsigned)(R * KB + C * 2); offC[1][i] = (unsigned)((HALF + R) * KB + C * 2); offN[0][i] = offC[0][i]; offN[1][i] = offC[1][i]; }
    const size_t kstep = (size_t)(BK * 2);
    const size_t hstep = (size_t)HALF * KB;
    const unsigned ldsw = (unsigned)wid * 1024u;
    const int aoff = lds_byte(wr * 64 + fr, fq * 8), boff = lds_byte(wc * 32 + fr, fq * 8);
#define PG8_SA(b, h) (((b) * 2 + (h)) * HTB)
#define PG8_SB(b, h) ((4 + (b) * 2 + (h)) * HTB)
#define PG8_GLDS(gp, bufoff, i) __builtin_amdgcn_global_load_lds((const unsigned*)(gp), (LAS unsigned*)(lds + (bufoff) + ldsw + (i) * 8192), 16, 0, 0)
#define PG8_STG_B(bufoff, ptr) do { PG8_GLDS((ptr) + voffB[0], bufoff, 0); PG8_GLDS((ptr) + voffB[1], bufoff, 1); } while (0)
#define PG8_STG_A(bufoff, ptr, o0, o1) do { PG8_GLDS((ptr) + (o0), bufoff, 0); PG8_GLDS((ptr) + (o1), bufoff, 1); } while (0)
#define PG8_LDA(dst, b, h) do { _Pragma("unroll") for (int m = 0; m < 4; ++m) _Pragma("unroll") for (int k = 0; k < 2; ++k) dst[m][k] = *(const LAS bf16x8*)(lds + PG8_SA(b, h) + aoff + m * 2048 + k * 1024); } while (0)
#define PG8_LDB(dst, b, h) do { _Pragma("unroll") for (int n = 0; n < 2; ++n) _Pragma("unroll") for (int k = 0; k < 2; ++k) dst[n][k] = *(const LAS bf16x8*)(lds + PG8_SB(b, h) + boff + n * 2048 + k * 1024); } while (0)
#define PG8_MMA(ai, bj, At, Bt) do { __builtin_amdgcn_s_setprio(1); _Pragma("unroll") for (int m = 0; m < 4; ++m) _Pragma("unroll") for (int n = 0; n < 2; ++n) { \
        if constexpr (FP8) { asm volatile("v_mfma_f32_16x16x128_f8f6f4 %0, %1, %2, %0" : "+v"(acc[ai][bj][m][n]) : "v"(cat8(Bt[n][0], Bt[n][1])), "v"(cat8(At[m][0], At[m][1]))); } \
        else { _Pragma("unroll") for (int k = 0; k < 2; ++k) acc[ai][bj][m][n] = __builtin_amdgcn_mfma_f32_16x16x32_bf16(Bt[n][k], At[m][k], acc[ai][bj][m][n], 0, 0, 0); } } __builtin_amdgcn_s_setprio(0); } while (0)
#define PG8_WAIT_V(n) asm volatile("s_waitcnt vmcnt(" #n ")" ::: "memory")
#define PG8_WAIT_L(n) asm volatile("s_waitcnt lgkmcnt(" #n ")" ::: "memory")
#define PG8_BAR __builtin_amdgcn_s_barrier()
#define PG8_SCHED __builtin_amdgcn_sched_barrier(0)
    Unit cur, nxt; int ui = 0;
    if (!S.next(0, cur)) return;
    bool has_next = S.next(1, nxt);
    if constexpr (GATHER) {
#pragma unroll
        for (int h = 0; h < 2; ++h)
#pragma unroll
            for (int i = 0; i < 2; ++i) { offC[h][i] = (unsigned)S.a_row(cur, h * HALF + Rr[i]) * (unsigned)KB + (unsigned)(Cc[i] * 2);
                offN[h][i] = (unsigned)S.a_row(has_next ? nxt : cur, h * HALF + Rr[i]) * (unsigned)KB + (unsigned)(Cc[i] * 2); }
        asm volatile("s_waitcnt vmcnt(0)" : "+v"(offC[0][0]), "+v"(offC[0][1]), "+v"(offC[1][0]), "+v"(offC[1][1]), "+v"(offN[0][0]), "+v"(offN[0][1]), "+v"(offN[1][0]), "+v"(offN[1][1]) :: "memory");
    }
    LAS float* mtab = (LAS float*)(lds + STAGE_BYTES + 4096);
    if constexpr (Epi::MIDSCALE) { cur.x = 0; if (tid < 256) { float f0, f1; E.row_factors(cur, tid, f0, f1); mtab[tid] = f0; mtab[256 + tid] = f1; } }
    f32x4 acc[2][2][4][2];
#pragma unroll
    for (int a = 0; a < 2; ++a)
#pragma unroll
        for (int b = 0; b < 2; ++b)
#pragma unroll
            for (int m = 0; m < 4; ++m)
#pragma unroll
                for (int n = 0; n < 2; ++n) acc[a][b][m][n] = (f32x4){0.f, 0.f, 0.f, 0.f};
    bf16x8 At[4][2], B0[2][2], B1[2][2];
    const char* cA = S.a_base(cur); const char* cB = S.b_base(cur);
    PG8_STG_B(PG8_SB(0, 0), cB); PG8_STG_B(PG8_SB(0, 1), cB + hstep); PG8_STG_A(PG8_SA(0, 0), cA, offC[0][0], offC[0][1]); PG8_STG_A(PG8_SA(0, 1), cA, offC[1][0], offC[1][1]);
    if (wr == 1) PG8_BAR;
    PG8_WAIT_V(2); PG8_BAR;
    PG8_STG_B(PG8_SB(1, 0), cB + kstep); PG8_STG_A(PG8_SA(1, 0), cA + kstep, offC[0][0], offC[0][1]); PG8_STG_B(PG8_SB(1, 1), cB + hstep + kstep);
    PG8_WAIT_V(6); PG8_BAR;
    for (;;) {
        const char* nA = has_next ? S.a_base(nxt) : cA; const char* nB = has_next ? S.b_base(nxt) : cB;
        for (int t = 0; t < nt; t += 2) {
            const bool last = (t == nt - 2);
            if constexpr (Epi::MIDSCALE) { if (t == Epi::MID_T) { float esc[8];
#pragma unroll
                for (int a = 0; a < 2; ++a)
#pragma unroll
                    for (int m = 0; m < 4; ++m) esc[4 * a + m] = mtab[(ui & 1) * 512 + a * 128 + wr * 64 + m * 16 + fr];
#pragma unroll
                for (int a = 0; a < 2; ++a)
#pragma unroll
                    for (int b = 0; b < 2; ++b)
#pragma unroll
                        for (int m = 0; m < 4; ++m)
#pragma unroll
                            for (int n = 0; n < 2; ++n) acc[a][b][m][n] *= esc[4 * a + m]; } }
            const char* a1 = cA + (size_t)(t + 1) * kstep;
            const char* a2 = last ? nA : cA + (size_t)(t + 2) * kstep; const char* b2 = last ? nB : cB + (size_t)(t + 2) * kstep;
            const char* a3 = a2 + kstep; const char* b3 = b2 + kstep;
            unsigned o00 = offC[0][0], o01 = offC[0][1], o10 = offC[1][0], o11 = offC[1][1];
            if constexpr (GATHER) { if (last) { o00 = offN[0][0]; o01 = offN[0][1]; o10 = offN[1][0]; o11 = offN[1][1]; } }
            PG8_LDB(B0, 0, 0); PG8_LDB(B1, 0, 1); PG8_SCHED; PG8_LDA(At, 0, 0); PG8_STG_A(PG8_SA(1, 1), a1, offC[1][0], offC[1][1]);
            PG8_WAIT_V(8); PG8_WAIT_L(0); PG8_BAR; PG8_MMA(0, 0, At, B0); PG8_MMA(0, 1, At, B1); PG8_BAR; PG8_SCHED;
            PG8_LDA(At, 0, 1); PG8_STG_B(PG8_SB(0, 0), b2); PG8_STG_B(PG8_SB(0, 1), b2 + hstep); PG8_STG_A(PG8_SA(0, 0), a2, o00, o01);
            PG8_WAIT_V(8); PG8_WAIT_L(0); PG8_BAR; PG8_MMA(1, 0, At, B0); PG8_MMA(1, 1, At, B1); PG8_BAR; PG8_SCHED;
            PG8_LDB(B0, 1, 0); PG8_LDB(B1, 1, 1); PG8_SCHED; PG8_LDA(At, 1, 0); PG8_STG_A(PG8_SA(0, 1), a2, o10, o11);
            PG8_WAIT_V(8); PG8_WAIT_L(0); PG8_BAR; PG8_MMA(0, 0, At, B0); PG8_MMA(0, 1, At, B1); PG8_BAR; PG8_SCHED;
            PG8_LDA(At, 1, 1); PG8_STG_B(PG8_SB(1, 0), b3); PG8_STG_B(PG8_SB(1, 1), b3 + hstep); PG8_STG_A(PG8_SA(1, 0), a3, o00, o01);
            PG8_WAIT_V(8); PG8_WAIT_L(0); PG8_BAR; PG8_MMA(1, 0, At, B0); PG8_MMA(1, 1, At, B1); PG8_BAR; PG8_SCHED;
        }
        if constexpr (ALIGN_EPI) { if (wr == 0) PG8_BAR; }
        Unit nn = nxt; bool nn_has = false;
        if (has_next) {
            nn_has = S.next(ui + 2, nn);
            if constexpr (GATHER) {
                int t2 = tid; asm volatile("" : "+v"(t2));
#pragma unroll
                for (int i = 0; i < 2; ++i) { int R, C; stage_rc(t2 * 16 + i * 8192, R, C);
#pragma unroll
                    for (int h = 0; h < 2; ++h) { offC[h][i] = offN[h][i];
                        offN[h][i] = (unsigned)S.a_row(nn_has ? nn : nxt, h * HALF + R) * (unsigned)KB + (unsigned)(C * 2); } }
            }
        }
        if constexpr (FP8) asm volatile("s_nop 15\n\ts_nop 15" ::: "memory");
        E(acc, cur, wr, wc, fr, fq);
        if (!has_next) break;
#pragma unroll
        for (int a = 0; a < 2; ++a)
#pragma unroll
            for (int b = 0; b < 2; ++b)
#pragma unroll
                for (int m = 0; m < 4; ++m)
#pragma unroll
                    for (int n = 0; n < 2; ++n) acc[a][b][m][n] = (f32x4){0.f, 0.f, 0.f, 0.f};
        cur = nxt; cA = nA; cB = nB; ++ui;
        nxt = nn; has_next = nn_has;
        if constexpr (Epi::MIDSCALE) { cur.x = ui & 1; if (tid < 256) { float f0, f1; E.row_factors(cur, tid, f0, f1); mtab[(ui & 1) * 512 + tid] = f0; mtab[(ui & 1) * 512 + 256 + tid] = f1; } }
        if constexpr (GATHER) asm volatile("s_waitcnt vmcnt(0)" : "+v"(offN[0][0]), "+v"(offN[0][1]), "+v"(offN[1][0]), "+v"(offN[1][1]) :: "memory");
        if constexpr (ALIGN_EPI) { if (wr == 1) PG8_BAR; }
    }
    PG8_WAIT_V(0);
    if constexpr (!ALIGN_EPI) { if (wr == 0) PG8_BAR; }
    PG8_BAR;
#undef PG8_SA
#undef PG8_SB
#undef PG8_GLDS
#undef PG8_STG_A
#undef PG8_STG_B
#undef PG8_LDA
#undef PG8_LDB
#undef PG8_MMA
#undef PG8_WAIT_V
#undef PG8_WAIT_L
#undef PG8_BAR
#undef PG8_SCHED
}
}

template <bool FP8, class RM>
__device__ __forceinline__ void transpose_item(const float* W, int K, int N, void* WTv, LAS float* scr, int item, int lane, RM rm, const float* kgain = nullptr) {
    const int nkb = K / 64, kb = item % nkb, nb = item / nkb, k0 = 64 * kb, n0 = 32 * nb;
    const bool nok = n0 + (lane & 31) < N;
    float v[32];
#pragma unroll
    for (int i = 0; i < 32; ++i) { const int kk = 2 * i + (lane >> 5); v[i] = nok ? __builtin_nontemporal_load(W + (size_t)(k0 + kk) * N + n0 + (lane & 31)) : 0.f; }
#pragma unroll
    for (int i = 0; i < 32; ++i) { const int kk = 2 * i + (lane >> 5); scr[kk * 33 + (lane & 31)] = kgain ? v[i] * kgain[k0 + kk] : v[i]; }
    asm volatile("s_waitcnt lgkmcnt(0)" ::: "memory");
    const int c = lane & 7;
#pragma unroll
    for (int j = 0; j < 4; ++j) { const int n = (lane >> 3) + 8 * j; const LAS float* s = scr + (8 * c) * 33 + n;
        if constexpr (FP8) { u32x2 o; o.x = pg8::pk4_fp8(s[0 * 33] * 64.f, s[1 * 33] * 64.f, s[2 * 33] * 64.f, s[3 * 33] * 64.f); o.y = pg8::pk4_fp8(s[4 * 33] * 64.f, s[5 * 33] * 64.f, s[6 * 33] * 64.f, s[7 * 33] * 64.f);
            if (n0 + n < N) *(u32x2*)((unsigned char*)WTv + (size_t)rm(n0 + n) * K + k0 + 8 * c) = o; }
        else { u32x4 o; o.x = pk2(s[0 * 33], s[1 * 33]); o.y = pk2(s[2 * 33], s[3 * 33]); o.z = pk2(s[4 * 33], s[5 * 33]); o.w = pk2(s[6 * 33], s[7 * 33]);
            if (n0 + n < N) *(u32x4*)((bf16_t*)WTv + (size_t)rm(n0 + n) * K + k0 + 8 * c) = o; } }
    asm volatile("s_waitcnt lgkmcnt(0)" ::: "memory");
}
constexpr int INC_P = 8448;
__device__ __forceinline__ int win_remap(int c) { return c < C_F ? c : c < C_Z ? 8192 + (c - C_F) : c < C_X ? 3072 + (c - C_Z) : c < C_DT ? 5120 + (c - C_X) : 8208 + (c - C_DT); }
struct MoeItem { const float* src; unsigned char* dst; int N, k0, n0, kind; };
__device__ __forceinline__ MoeItem moe_item(Frame& F, int it) {
    constexpr int I_GU = (DM / 64) * (4096 / 32), I_D = (FF / 64) * (DM / 32);
    MoeItem m;
    if (it < NE * I_GU) { const int e = it / I_GU, r = it % I_GU; m.src = F.in[I_WGU] + (size_t)e * DM * 4096; m.dst = F.ws + WS_WGU + (size_t)e * 4096 * DM; m.N = 4096; m.k0 = 64 * (r % 32); m.n0 = 32 * (r / 32); m.kind = 0; }
    else { it -= NE * I_GU; const int e = it / I_D, r = it % I_D; m.src = F.in[I_WD] + (size_t)e * FF * DM; m.dst = F.ws + WS_WD + (size_t)e * DM * FF; m.N = DM; m.k0 = 64 * (r % 32); m.n0 = 32 * (r / 32); m.kind = 1; }
    return m;
}
__device__ __forceinline__ void moe_load(float (&v)[32], const MoeItem& m, int lane) {
    const float* p = m.src + (size_t)(m.k0 + (lane >> 5)) * m.N + m.n0 + (lane & 31);
#pragma unroll
    for (int i = 0; i < 32; ++i) v[i] = __builtin_nontemporal_load(p + (size_t)(2 * i) * m.N);
}
__device__ __forceinline__ void moe_half(const float (&v)[32], LAS float* scr, int lane, int half, u32x4 (&o)[4]) {
#pragma unroll
    for (int i = 0; i < 32; ++i) scr[(2 * i + (lane >> 5)) * 33 + (lane & 31)] = v[i];
    asm volatile("s_waitcnt lgkmcnt(0)" ::: "memory");
    const int cp = lane & 7;
    if ((cp >> 2) == half) {
#pragma unroll
        for (int j = 0; j < 4; ++j) { const LAS float* s = scr + (16 * (cp & 3)) * 33 + (lane >> 3) + 8 * j;
            o[j].x = pg8::pk4_fp8(s[0 * 33] * 64.f, s[1 * 33] * 64.f, s[2 * 33] * 64.f, s[3 * 33] * 64.f); o[j].y = pg8::pk4_fp8(s[4 * 33] * 64.f, s[5 * 33] * 64.f, s[6 * 33] * 64.f, s[7 * 33] * 64.f);
            o[j].z = pg8::pk4_fp8(s[8 * 33] * 64.f, s[9 * 33] * 64.f, s[10 * 33] * 64.f, s[11 * 33] * 64.f); o[j].w = pg8::pk4_fp8(s[12 * 33] * 64.f, s[13 * 33] * 64.f, s[14 * 33] * 64.f, s[15 * 33] * 64.f); }
    }
    asm volatile("s_waitcnt lgkmcnt(0)" ::: "memory");
}
__device__ __forceinline__ void moe_store_pair(const MoeItem& m, int lane, const u32x4 (&o)[4]) {
#pragma unroll
    for (int j = 0; j < 4; ++j) { const int n = m.n0 + (lane >> 3) + 8 * j; const int row = m.kind == 0 ? ((n & 2047) >> 7) * 256 + (n >> 11) * 128 + (n & 127) : n;
        *(u32x4*)(m.dst + (size_t)row * 2048 + m.k0 + 16 * (lane & 7)) = o[j]; }
}
constexpr int MOE_PAIRS = NE * ((DM / 64) * (4096 / 32) + (FF / 64) * (DM / 32)) / 2;
constexpr int MOE_DQ = 2, MOE_DYN = 4096, MOE_STAT = MOE_PAIRS - MOE_DYN;
__device__ __forceinline__ void moe_convert(Frame& F, int g0, int g1) {
    LAS float* scr = (LAS float*)(F.lds + F.wave * 16384);
    float va[32], vb[32];
    if (g0 < g1) moe_load(va, moe_item(F, 2 * g0), F.lane);
    for (int g = g0; g < g1; ++g) {
        const MoeItem ma = moe_item(F, 2 * g), mb = moe_item(F, 2 * g + 1);
        u32x4 o[4];
        moe_load(vb, mb, F.lane);
        moe_half(va, scr, F.lane, 0, o);
        if (g + 1 < g1) moe_load(va, moe_item(F, 2 * (g + 1)), F.lane);
        moe_half(vb, scr, F.lane, 1, o);
        moe_store_pair(ma, F.lane, o);
    }
}
__device__ __forceinline__ void moe_weights(Frame& F) {
    constexpr int PAIRS = MOE_STAT;
    constexpr int N9 = ((M + 256) / 256) * (INC_P / 256) - 8 * 256, LIGHT = 337;
    int p0, p1;
    if ((int)gridDim.x == 256 && N9 > 0 && N9 < 256) {
        const int c = blockIdx.x, rest = PAIRS - N9 * LIGHT, nh = 256 - N9;
        if (c < N9) { p0 = c * LIGHT; p1 = p0 + LIGHT; } else { p0 = N9 * LIGHT + (int)((long)(c - N9) * rest / nh); p1 = N9 * LIGHT + (int)((long)(c - N9 + 1) * rest / nh); }
    } else { p0 = (int)((long)blockIdx.x * PAIRS / gridDim.x); p1 = (int)((long)(blockIdx.x + 1) * PAIRS / gridDim.x); }
    const int n = p1 - p0;
    moe_convert(F, p0 + F.wave * n / NWAVES, p0 + (F.wave + 1) * n / NWAVES);
    __syncthreads();
}
__device__ __forceinline__ void ph0_weights(Frame& F) {
    LAS float* scr = (LAS float*)(F.lds + F.wave * 16384);
    bf16_t* WinT = (bf16_t*)(F.ws + WS_WIN); bf16_t* WoutT = (bf16_t*)(F.ws + WS_WOUT);
    constexpr int I_IN = (DM / 64) * ((INC + 31) / 32), I_OUT = (3072 / 64) * (DM / 32);
    const int total = I_IN + I_OUT;
    for (int it0 = F.gw * 2; it0 < total; it0 += F.NGW * 2) for (int it = it0; it < it0 + 2 && it < total; ++it) {
        int r = it;
        if (r < I_IN) { transpose_item<false>(F.in[I_WIN], DM, INC, WinT, scr, r, F.lane, [](int n) { return win_remap(n); }); continue; } r -= I_IN;
        { const int k0w = 64 * (r % (3072 / 64));
          transpose_item<false>(F.in[I_WOUT], 3072, DM, WoutT, scr, r, F.lane, [](int n) { return n; }, k0w < AW ? F.in[I_GATT] : F.in[I_GSSM] - AW); }
    }
    { bf16_t* WrT = (bf16_t*)(F.ws + WS_WRT); const float* WR = F.in[I_WR];
      for (int i = blockIdx.x * NTHREADS + F.tid; i < NE * DM; i += gridDim.x * NTHREADS) { const int e = i / DM, k = i % DM; WrT[i] = (bf16_t)f2bf(WR[(size_t)k * NE + e]); } }
    const int gt = blockIdx.x * NTHREADS + F.tid, GT = gridDim.x * NTHREADS;
    for (int i = gt; i < (INC_P - INC) * (DM / 8); i += GT) *(u32x4*)(WinT + (size_t)INC * DM + (size_t)i * 8) = (u32x4){0u, 0u, 0u, 0u};
}

template <int J> __device__ __forceinline__ float conv_rowm(float cur, float prv) {
    const int ror = __builtin_amdgcn_update_dpp(0, __builtin_bit_cast(int, prv), 0x120 + J, 0xF, 0xF, false);
    return __builtin_bit_cast(float, __builtin_amdgcn_update_dpp(ror, __builtin_bit_cast(int, cur), 0x110 + J, 0xF, 0xF, false));
}
struct EpiInproj {
    static constexpr bool PERM = true, MIDSCALE = false;
    unsigned char* ws; const float* cw; const float* cb;
    __device__ __forceinline__ void conv_tile(const f32x4 (&acc)[2][2][4][2], int pn, int pm, bool meta, int wr, int wc, int fr, int fq) const {
        bf16_t* XC = (bf16_t*)(ws + WS_XC); bf16_t* XBC = (bf16_t*)(ws + WS_XBC);
#pragma unroll
        for (int bj = 0; bj < 2; ++bj) {
            const int c0 = (pn - 20) * 256 + bj * 128 + wc * 32 + 8 * fq;
            float w[4][8], bb[8];
#pragma unroll
            for (int k = 0; k < 4; ++k) { const f32x4 a = *(const f32x4*)(cw + k * CC + c0), b = *(const f32x4*)(cw + k * CC + c0 + 4); w[k][0] = a.x; w[k][1] = a.y; w[k][2] = a.z; w[k][3] = a.w; w[k][4] = b.x; w[k][5] = b.y; w[k][6] = b.z; w[k][7] = b.w; }
            { const f32x4 a = *(const f32x4*)(cb + c0), b = *(const f32x4*)(cb + c0 + 4); bb[0] = a.x; bb[1] = a.y; bb[2] = a.z; bb[3] = a.w; bb[4] = b.x; bb[5] = b.y; bb[6] = b.z; bb[7] = b.w; }
#pragma unroll
            for (int ai = 0; ai < 2; ++ai)
#pragma unroll
                for (int m = 0; m < 4; ++m) { const int r = ai * 128 + wr * 64 + m * 16 + fr;
                    float o[8], raw[8];
#pragma unroll
                    for (int i = 0; i < 8; ++i) { const float cur = acc[ai][bj][m][i >> 2][i & 3], prv = m > 0 ? acc[ai][bj][m > 0 ? m - 1 : 0][i >> 2][i & 3] : 0.f;
                        const float x1 = conv_rowm<1>(cur, prv), x2 = conv_rowm<2>(cur, prv), x3 = conv_rowm<3>(cur, prv);
                        const float a = bb[i] + w[3][i] * cur + w[2][i] * x1 + w[1][i] * x2 + w[0][i] * x3;
                        o[i] = a * __builtin_amdgcn_rcpf(1.f + __expf(-a)); raw[i] = cur; }
                    const u32x4 ov = (u32x4){pk2(o[0], o[1]), pk2(o[2], o[3]), pk2(o[4], o[5]), pk2(o[6], o[7])}, rv = (u32x4){pk2(raw[0], raw[1]), pk2(raw[2], raw[3]), pk2(raw[4], raw[5]), pk2(raw[6], raw[7])};
                    if (!meta) { const int mrow = pm * 256 + r; const size_t drow = (size_t)(mrow + ROW_REAL * ((mrow >> 12) + 1));
                        const bool head = (m == 0 && fr < 3), tail = (m == 3 && fr >= 13);
                        if (!head) *(u32x4*)(XC + drow * CC + c0) = ov;
                        if (head || tail) *(u32x4*)(XBC + drow * CC + c0) = rv; }
                    else if (r < NMETA) {
#pragma unroll
                        for (int b = 0; b < NB; ++b) *(u32x4*)(XBC + (size_t)(b * LP + ROW_META + r) * CC + c0) = rv; }
                }
        }
    }
    __device__ __forceinline__ void operator()(const f32x4 (&acc)[2][2][4][2], const pg8::Unit& u, int wr, int wc, int fr, int fq) const {
        asm volatile("" : "+v"(fr), "+v"(fq));
        const int pn = u.pn, pm = u.pm; const bool meta = pm >= M / 256;
        if (pn >= 20 && pn < 32) { conv_tile(acc, pn, pm, meta, wr, wc, fr, fq); return; }
        if (pn < 32) {
            bf16_t* base; int ld, colt; bool seq; float sc = 1.f;
            if (pn < 4) { base = (bf16_t*)(ws + WS_Q); ld = AW; colt = pn * 256; seq = false; sc = QSCALE; }
            else if (pn < 8) { base = (bf16_t*)(ws + WS_K); ld = AW; colt = (pn - 4) * 256; seq = true; }
            else if (pn < 12) { base = (bf16_t*)(ws + WS_V); ld = AW; colt = (pn - 8) * 256; seq = true; }
            else if (pn < 20) { base = (bf16_t*)(ws + WS_Z); ld = SW; colt = (pn - 12) * 256; seq = false; }
            else { base = (bf16_t*)(ws + WS_XBC); ld = CC; colt = (pn - 20) * 256; seq = true; }
            if (meta && !seq) return;
            const int col0 = colt + wc * 32 + 8 * fq;
#pragma unroll
            for (int ai = 0; ai < 2; ++ai)
#pragma unroll
                for (int m = 0; m < 4; ++m) { const int r = ai * 128 + wr * 64 + m * 16 + fr;
                    u32x4 w[2];
#pragma unroll
                    for (int bj = 0; bj < 2; ++bj) { const f32x4 v0 = acc[ai][bj][m][0] * sc, v1 = acc[ai][bj][m][1] * sc;
                        w[bj].x = pg8::cvt_pk_bf16(v0[0], v0[1]); w[bj].y = pg8::cvt_pk_bf16(v0[2], v0[3]); w[bj].z = pg8::cvt_pk_bf16(v1[0], v1[1]); w[bj].w = pg8::cvt_pk_bf16(v1[2], v1[3]); }
                    if (!meta) { const int mrow = pm * 256 + r; const size_t drow = seq ? (size_t)(mrow + ROW_REAL * ((mrow >> 12) + 1)) : (size_t)mrow;
                        bf16_t* rowp = base + drow * ld + col0; *(u32x4*)rowp = w[0]; *(u32x4*)(rowp + 128) = w[1]; }
                    else if (r < NMETA) {
#pragma unroll
                        for (int b = 0; b < NB; ++b) { bf16_t* rowp = base + (size_t)(b * LP + ROW_META + r) * ld + col0; *(u32x4*)rowp = w[0]; *(u32x4*)(rowp + 128) = w[1]; } }
                }
        } else {
            float* FDT = (float*)(ws + WS_FDT);
            const int col0 = wc * 32 + 8 * fq;
            if (col0 >= 48) return;
#pragma unroll
            for (int ai = 0; ai < 2; ++ai)
#pragma unroll
                for (int m = 0; m < 4; ++m) { const int r = ai * 128 + wr * 64 + m * 16 + fr;
                    if (!meta) { const int mrow = pm * 256 + r; float* rowp = FDT + (size_t)(mrow + ROW_REAL * ((mrow >> 12) + 1)) * 48 + col0;
                        *(f32x4*)rowp = acc[ai][0][m][0]; *(f32x4*)(rowp + 4) = acc[ai][0][m][1]; }
                    else if (r < NMETA) {
#pragma unroll
                        for (int b = 0; b < NB; ++b) { float* rowp = FDT + (size_t)(b * LP + ROW_META + r) * 48 + col0; *(f32x4*)rowp = acc[ai][0][m][0]; *(f32x4*)(rowp + 4) = acc[ai][0][m][1]; } }
                }
        }
    }
};
__device__ __forceinline__ void ph1_inproj(Frame& F) {
    pg8::StaticOrder S; S.init(F.ws + WS_XN, F.ws + WS_WIN, M + 256, INC_P, DM, gridDim.x, blockIdx.x);
    EpiInproj E{F.ws, F.in[I_CW], F.in[I_CB]};
    pg8::gemm_phase<EpiInproj, pg8::StaticOrder, false, true>(F.lds, DM * 2, S, E);
}
struct EpiOutproj {
    static constexpr bool PERM = true, MIDSCALE = true; static constexpr int MID_T = AW / 64;
    bf16_t* MX; const float* SSQA; const float* SSQS; const LAS float* tab;
    __device__ __forceinline__ void row_factors(const pg8::Unit& u, int r, float& f0, float& f1) const { const size_t m = (size_t)(u.pm * 256 + r); float sa = 0.f, ss = 0.f;
#pragma unroll
        for (int j = 0; j < 4; ++j) { const f32x4 v = *(const f32x4*)(SSQA + m * 16 + 4 * j); sa += (v.x + v.y) + (v.z + v.w); }
#pragma unroll
        for (int j = 0; j < 8; ++j) { const f32x4 v = *(const f32x4*)(SSQS + m * 32 + 4 * j); ss += (v.x + v.y) + (v.z + v.w); }
        const float ra = rsqrtf(sa * (1.f / AW) + EPS), rs = rsqrtf(ss * (1.f / SW) + EPS); f0 = ra / rs; f1 = rs; }
    __device__ __forceinline__ void operator()(const f32x4 (&acc)[2][2][4][2], const pg8::Unit& u, int wr, int wc, int fr, int fq) const {
        asm volatile("" : "+v"(fr), "+v"(fq));
        const int col0 = u.pn * 256 + wc * 32 + 8 * fq;
#pragma unroll
        for (int ai = 0; ai < 2; ++ai)
#pragma unroll
            for (int m = 0; m < 4; ++m) { const int tr = ai * 128 + wr * 64 + m * 16 + fr; bf16_t* rowp = MX + (size_t)(u.pm * 256 + tr) * DM + col0; const float rs = tab[u.x * 512 + 256 + tr];
#pragma unroll
                for (int bj = 0; bj < 2; ++bj) { const f32x4 v0 = acc[ai][bj][m][0] * rs, v1 = acc[ai][bj][m][1] * rs;
                    u32x4 w; w.x = pg8::cvt_pk_bf16(v0[0], v0[1]); w.y = pg8::cvt_pk_bf16(v0[2], v0[3]); w.z = pg8::cvt_pk_bf16(v1[0], v1[1]); w.w = pg8::cvt_pk_bf16(v1[2], v1[3]);
                    *(u32x4*)(rowp + bj * 128) = w; } }
    }
};
__device__ __forceinline__ void ph4_outproj(Frame& F) {
    pg8::StaticOrder S; S.init(F.ws + WS_A2, F.ws + WS_WOUT, M, DM, 3072, gridDim.x, blockIdx.x);
    EpiOutproj E{(bf16_t*)(F.ws + WS_MX), (const float*)(F.ws + WS_SSQA), (const float*)(F.ws + WS_SSQS), (const LAS float*)(F.lds + pg8::STAGE_BYTES + 4096)};
    pg8::gemm_phase<EpiOutproj, pg8::StaticOrder, false, true>(F.lds, 3072 * 2, S, E);
}

__device__ __forceinline__ float softplus_fast(float x) { return x > 20.f ? x : __logf(1.f + __expf(x)); }
__device__ __forceinline__ float logsigmoid_fast(float x) { return x < 0.f ? x - __logf(1.f + __expf(x)) : -__logf(1.f + __expf(-x)); }
template <int PART> __device__ __forceinline__ void ph1b_conv_scan(Frame& F) {
    const bf16_t* XBC = (const bf16_t*)(F.ws + WS_XBC); bf16_t* XC = (bf16_t*)(F.ws + WS_XC);
    const float* FDT = (const float*)(F.ws + WS_FDT); float* DT = (float*)(F.ws + WS_DT); float* CF = (float*)(F.ws + WS_CF); float* CFT = (float*)(F.ws + WS_CFT);
    const float* cw = F.in[I_CW]; const float* cb = F.in[I_CB];
    const int gt = blockIdx.x * NTHREADS + F.tid, GT = gridDim.x * NTHREADS;
    constexpr int FIXB = NMETA + (SEQ / 64) * 3;
    if (PART & 1) for (int it = gt; it < NB * FIXB * (CC / 8); it += GT) {
        const int cv = it % (CC / 8), f = it / (CC / 8), b = f / FIXB, q = f % FIXB, c0 = cv * 8;
        const int pos = q < NMETA ? ROW_META + q : ROW_REAL + 64 * ((q - NMETA) / 3) + (q - NMETA) % 3; const size_t sr = (size_t)b * LP + pos;
        float acc[8];
#pragma unroll
        for (int j = 0; j < 8; ++j) acc[j] = cb[c0 + j];
#pragma unroll
        for (int k = 0; k < 4; ++k) { const u32x4 xv = *(const u32x4*)(XBC + (sr - 3 + k) * CC + c0); const unsigned xw[4] = {xv.x, xv.y, xv.z, xv.w};
#pragma unroll
            for (int j = 0; j < 8; ++j) { const float xf = __uint_as_float((j & 1) ? (xw[j >> 1] & 0xffff0000u) : (xw[j >> 1] << 16)); acc[j] += cw[k * CC + c0 + j] * xf; } }
#pragma unroll
        for (int j = 0; j < 8; ++j) acc[j] = acc[j] * __builtin_amdgcn_rcpf(1.f + __expf(-acc[j]));
        *(u32x4*)(XC + sr * CC + c0) = (u32x4){pk2(acc[0], acc[1]), pk2(acc[2], acc[3]), pk2(acc[4], acc[5]), pk2(acc[6], acc[7])};
    }
    if (PART & 2) for (int i = gt; i < SR * SH; i += GT) { const int sr = i / SH, h = i % SH, pos = sr % LP;
        DT[i] = pos >= ROW_META ? softplus_fast(FDT[(size_t)sr * 48 + 16 + h] + F.in[I_DTB][h]) : 0.f; }
    LAS float* red = (LAS float*)F.lds;
    if (PART & 2) for (int w = (int)gridDim.x - 1 - (int)blockIdx.x; w < NB * AH; w += gridDim.x) {
        const int b = w / AH, h = w % AH; const float fb = F.in[I_FB][h];
        float v[9]; float run = 0.f;
#pragma unroll
        for (int j = 0; j < 9; ++j) { const int pos = F.tid * 9 + j; float lf = 0.f;
            if (pos >= ROW_META && pos < LP) lf = logsigmoid_fast(FDT[(size_t)(b * LP + pos) * 48 + h] + fb);
            run += lf; v[j] = run; }
        float inc = run;
#pragma unroll
        for (int o = 1; o < 64; o <<= 1) { const float t = __shfl_up(inc, o); if (F.lane >= o) inc += t; }
        __syncthreads();
        if (F.lane == 63) red[F.wave] = inc;
        __syncthreads();
        float off = inc - run;
#pragma unroll
        for (int ww = 0; ww < NWAVES; ++ww) if (ww < F.wave) off += red[ww];
#pragma unroll
        for (int j = 0; j < 9; ++j) { const int pos = F.tid * 9 + j;
            if (pos < CFT_LD) CFT[(size_t)w * CFT_LD + pos] = pos < LP ? (v[j] + off) * LOG2E : 0.f; }
    }
}

namespace attn_body {
using bf16=unsigned short;
using bf16x8=__attribute__((ext_vector_type(8)))short;
using s16x4=__attribute__((ext_vector_type(4)))short;
using f32x16=__attribute__((ext_vector_type(16)))float;
using u32x4=__attribute__((ext_vector_type(4)))unsigned;
using f32x4v=__attribute__((ext_vector_type(4)))float;
constexpr int BATCH=4,NHEAD=16,SEQ=4096,D=64,DM=NHEAD*D;
constexpr int NW=8,QBLK=32,QB=QBLK*NW,KVBLK=64,NQB=SEQ/QB;
constexpr int ATTN_PITCH=DM, ATTN_UNIT_ROWS=QB;
__device__ __forceinline__ int crow(int r,int hi){return (r&3)+8*(r>>2)+4*hi;}
#define SBAR() __builtin_amdgcn_sched_barrier(0)
__device__ __forceinline__ void cmask(f32x16&p0,f32x16&p1,int jb,int qrel,int hi){
  const float NEG=-INFINITY; int kb=64*jb+4*hi;
  #pragma unroll
  for(int r=0;r<16;++r){int kv=kb+(r&3)+8*(r>>2); if(kv>qrel)p0[r]=NEG; if(kv+32>qrel)p1[r]=NEG;}
}

constexpr int NSLOT=3, SLOTB=8192;
constexpr int LDS_K=0, LDS_V=NSLOT*SLOTB, LDS_WS=2*NSLOT*SLOTB, LDS_OST=LDS_WS+NW*64*4, LDS_C2=LDS_OST+NW*4096, C2_LEN=4352, LDS_BYTES=LDS_C2+C2_LEN*4;
constexpr float C2=0.125f*1.4426950408889634f;
__device__ __forceinline__ void glds16(const void*gsrc,unsigned lds_dst){unsigned keep;
  asm volatile("s_mov_b32 %0, m0\n\ts_mov_b32 m0, %2\n\ts_nop 0\n\tglobal_load_lds_dwordx4 %1, off\n\ts_mov_b32 m0, %0":"=&s"(keep):"v"(gsrc),"s"(lds_dst):"memory");}
__device__ __forceinline__ float max3f(float a,float b,float c){float r;asm("v_max3_f32 %0, %1, %2, %3":"=v"(r):"v"(a),"v"(b),"v"(c));return r;}
__device__ __forceinline__ float max2f(float a,float b){float r;asm("v_max_f32_e32 %0, %1, %2":"=v"(r):"v"(a),"v"(b));return r;}
__device__ __forceinline__ float fadd_s(float a,float b){float r;asm("v_add_f32_e32 %0, %1, %2":"=v"(r):"v"(a),"v"(b));return r;}
__device__ __forceinline__ float fsub_s(float a,float b){float r;asm("v_sub_f32_e32 %0, %1, %2":"=v"(r):"v"(a),"v"(b));return r;}
typedef float f32x2_t __attribute__((ext_vector_type(2))); typedef __bf16 bf16x2_t __attribute__((ext_vector_type(2)));
__device__ __forceinline__ unsigned cvtpk_s(float lo,float hi){f32x2_t v={lo,hi};bf16x2_t b=__builtin_convertvector(v,bf16x2_t);return __builtin_bit_cast(unsigned,b);}
#define WAIT_BAR(N) asm volatile("s_waitcnt vmcnt(" #N ") lgkmcnt(0)\n\ts_barrier":::"memory")

__device__ __forceinline__ void qkt(f32x16&p0,f32x16&p1,const char*Kslot,const bf16x8*qr,int r32,int hi){
  const char*kb=Kslot+hi*1024+r32*16;
  #pragma unroll
  for(int d0=0;d0<4;++d0){
    const bf16x8 b0=*reinterpret_cast<const bf16x8*>(kb+d0*2048);
    const bf16x8 b1=*reinterpret_cast<const bf16x8*>(kb+d0*2048+512);
    p0=__builtin_amdgcn_mfma_f32_32x32x16_bf16(b0,qr[d0],p0,0,0,0);p1=__builtin_amdgcn_mfma_f32_32x32x16_bf16(b1,qr[d0],p1,0,0,0);}
}
typedef __attribute__((address_space(3))) const char* lds_cptr;
typedef short v4i16_t __attribute__((ext_vector_type(4)));
__device__ __forceinline__ void kload8(bf16x8*kf,lds_cptr kp){
  kf[0]=*(const __attribute__((address_space(3))) bf16x8*)(kp);      kf[1]=*(const __attribute__((address_space(3))) bf16x8*)(kp+512);
  kf[2]=*(const __attribute__((address_space(3))) bf16x8*)(kp+2048); kf[3]=*(const __attribute__((address_space(3))) bf16x8*)(kp+2560);
  kf[4]=*(const __attribute__((address_space(3))) bf16x8*)(kp+4096); kf[5]=*(const __attribute__((address_space(3))) bf16x8*)(kp+4608);
  kf[6]=*(const __attribute__((address_space(3))) bf16x8*)(kp+6144); kf[7]=*(const __attribute__((address_space(3))) bf16x8*)(kp+6656);
}
__device__ __forceinline__ void kload2(bf16x8*kf,lds_cptr kp,int j){ kf[2*j]=*(const __attribute__((address_space(3))) bf16x8*)(kp+j*2048); kf[2*j+1]=*(const __attribute__((address_space(3))) bf16x8*)(kp+j*2048+512); }
__device__ __forceinline__ s16x4 vtr(lds_cptr p){ return __builtin_bit_cast(s16x4,__builtin_amdgcn_ds_read_tr16_b64_v4i16((__attribute__((address_space(3))) v4i16_t*)p)); }
__device__ __forceinline__ float rowmax(const f32x16&p0,const f32x16&p1){
  float a=max3f(p0[0],p0[1],p1[0]),b=max3f(p0[2],p0[3],p1[1]);a=max3f(a,p1[2],p1[3]);
  #pragma unroll
  for(int r=4;r<16;r+=4){a=max3f(a,p0[r],p0[r+1]);b=max3f(b,p0[r+2],p0[r+3]);a=max3f(a,p1[r],p1[r+1]);b=max3f(b,p1[r+2],p1[r+3]);}
  const float m=max2f(a,b);
  auto rr=__builtin_amdgcn_permlane32_swap(__float_as_uint(m),__float_as_uint(m),false,false);
  return max2f(__uint_as_float(rr[0]),__uint_as_float(rr[1]));
}
__device__ __forceinline__ void pv(f32x16*o,int vb,bf16x8 pa0,bf16x8 pa1,bf16x8 pa2,bf16x8 pa3){
  #pragma unroll
  for(int d0=0;d0<2;++d0){s16x4 lo[4],hi[4];
    #pragma unroll
    for(int ks=0;ks<4;++ks){
      asm volatile("ds_read_b64_tr_b16 %0,%1 offset:%c2":"=&v"(lo[ks]):"v"(vb),"i"(d0*4096+ks*1024):"memory");
      asm volatile("ds_read_b64_tr_b16 %0,%1 offset:%c2":"=&v"(hi[ks]):"v"(vb),"i"(d0*4096+ks*1024+512):"memory");}
    asm volatile("s_waitcnt lgkmcnt(0)":::"memory");SBAR();
    #define PK(k) (bf16x8){lo[k][0],lo[k][1],lo[k][2],lo[k][3],hi[k][0],hi[k][1],hi[k][2],hi[k][3]}
    o[d0]=__builtin_amdgcn_mfma_f32_32x32x16_bf16(pa0,PK(0),o[d0],0,0,0);
    o[d0]=__builtin_amdgcn_mfma_f32_32x32x16_bf16(pa1,PK(1),o[d0],0,0,0);
    o[d0]=__builtin_amdgcn_mfma_f32_32x32x16_bf16(pa2,PK(2),o[d0],0,0,0);
    o[d0]=__builtin_amdgcn_mfma_f32_32x32x16_bf16(pa3,PK(3),o[d0],0,0,0);
    #undef PK
  }
}

#ifndef ATTN_STORE16
#define ATTN_STORE16(p,v) (*(u32x4*)(p)=(v))
#endif
constexpr int OPITCH=3072;
template<int THRL> __device__ __forceinline__ void attn_unit(int b,int h,int qb,const bf16*Q,const bf16*__restrict__ K,const bf16*__restrict__ V,bf16*O,const float*__restrict__ CFT,float*SSQA,char*shm){
  int tid_=threadIdx.x; asm volatile("":"+v"(tid_));
  const int tid=tid_,lane=tid&63,r32=lane&31,hi=lane>>5; const int wid=__builtin_amdgcn_readfirstlane(tid>>6);
  const long rowbase=(long)b*SEQ; const long rowbase_k=(long)b*LP+64; const int q0=qb*QB;
  const bf16*Qw=Q+(rowbase+q0+wid*QBLK)*DM+h*D;
  const int NT0=(q0+QB)/KVBLK+2;
  const float*cft0=CFT+(long)(b*NHEAD+h)*C2_LEN+64;
  int t_start;
  { constexpr float SKIP_T=64.f; const float c2q0=cft0[64+q0];
    const bool n0=(lane<NT0)&&(c2q0-cft0[64*lane+63]>=-SKIP_T), n1=(lane+64<NT0)&&(c2q0-cft0[64*(lane+64)+63]>=-SKIP_T);
    const unsigned long long m0=__ballot(n0),m1=__ballot(n1);
    int tf=m0?__builtin_ctzll(m0):(m1?64+__builtin_ctzll(m1):NT0);
    tf&=~1; if(tf>NT0-6)tf=NT0-6; t_start=__builtin_amdgcn_readfirstlane(tf); }
  const bf16*Kh=K+(rowbase_k+(long)t_start*KVBLK)*DM+h*D,*Vh=V+(rowbase_k+(long)t_start*KVBLK)*DM+h*D;
  const unsigned lds0=(unsigned)(uintptr_t)shm;
  float*wsf=(float*)(shm+LDS_WS)+wid*64;
  const bf16*ksrc=Kh+(long)lane*DM+wid*8;
  const bf16*vsrc=Vh+(long)(16*(wid&3)+(lane>>2))*DM+(wid>>2)*32+(lane&3)*8;
  const unsigned kdst=lds0+LDS_K+wid*1024, vdst=lds0+LDS_V+wid*1024;
  #define DMA_K(t,slot) glds16(ksrc+(long)(t)*KVBLK*DM,(unsigned)__builtin_amdgcn_readfirstlane(kdst+(slot)))
  #define DMA_V(t,slot) glds16(vsrc+(long)(t)*KVBLK*DM,(unsigned)__builtin_amdgcn_readfirstlane(vdst+(slot)))
  const int vb0=(int)(lds0+LDS_V)+((lane>>4)&1)*32+(lane&3)*8+(4*hi+((lane&15)>>2))*64;
  const char*Kbase=shm+LDS_K; bf16x8 kf[8];
  const lds_cptr shm3=(lds_cptr)shm; const lds_cptr kp0=shm3+LDS_K+hi*1024+r32*16; const lds_cptr vp0=shm3+LDS_V+((lane>>4)&1)*32+(lane&3)*8+(4*hi+((lane&15)>>2))*64;
  const int NT=NT0-t_start;
  const float*cft=cft0+KVBLK*t_start;
  { float*c2w=(float*)(shm+LDS_C2); for(int i=tid;i<KVBLK*NT;i+=NW*64)c2w[i]=cft[i]; }
  const float cq2=cft0[64+q0+wid*QBLK+r32];
  const __attribute__((address_space(3))) f32x4v*c2p=(const __attribute__((address_space(3))) f32x4v*)(shm3+LDS_C2)+hi;
  DMA_K(0,0);DMA_V(0,0);DMA_K(1,SLOTB);
  bf16x8 qr[4];
  #pragma unroll
  for(int d0=0;d0<4;++d0)qr[d0]=*reinterpret_cast<const bf16x8*>(&Qw[(long)r32*DM+d0*16+hi*8]);
  float mhat=0.f,l_reg=0.f;f32x16 o[2];o[0]=f32x16{};o[1]=f32x16{};float cqm=cq2;
  const int qrel=wid*QBLK+r32;
  #define CMASK(P0,P1,t) do{int jb_=(t)-(NT-5); if(jb_>=0)cmask(P0,P1,jb_,qrel,hi);}while(0)
  bool resc=false;
  #define START(P0,P1) do{ const float rm=rowmax(P0,P1); resc=false; \
    { const float dl=rm; mhat=fadd_s(mhat,dl); \
      _Pragma("unroll") for(int r=0;r<16;++r){P0[r]=fsub_s(P0[r],dl);P1[r]=fsub_s(P1[r],dl);} \
      cqm=cq2-mhat; } \
    _Pragma("unroll") for(int r=0;r<16;++r)P0[r]=__builtin_amdgcn_exp2f(P0[r]); }while(0)
  #define RESC() do{ if(resc){ asm volatile("s_waitcnt lgkmcnt(0)":::"memory"); \
      _Pragma("unroll") for(int d_=0;d_<2;++d_) _Pragma("unroll") for(int r=0;r<16;++r)o[d_][r]*=wsf[crow(r,hi)]; } }while(0)
  f32x16 pA0,pA1,pB0,pB1;
  int sl_prev=0,sl_cur=0,sl_next=SLOTB;
  #define ROT() do{sl_prev=sl_cur;sl_cur=sl_next;sl_next=(sl_next==(NSLOT-1)*SLOTB)?0:sl_next+SLOTB;}while(0)
  DMA_K(2,2*SLOTB);
  WAIT_BAR(3);
  #define CINIT(P0,P1,t) do{ const __attribute__((address_space(3))) f32x4v*cp_=c2p+16*(t); \
    _Pragma("unroll") for(int g_=0;g_<4;++g_){ const f32x4v a_=cp_[2*g_], b_=cp_[2*g_+8]; \
      P0[4*g_]=cqm-a_[0];P0[4*g_+1]=cqm-a_[1];P0[4*g_+2]=cqm-a_[2];P0[4*g_+3]=cqm-a_[3]; P1[4*g_]=cqm-b_[0];P1[4*g_+1]=cqm-b_[1];P1[4*g_+2]=cqm-b_[2];P1[4*g_+3]=cqm-b_[3]; } }while(0)
  CINIT(pA0,pA1,0); qkt(pA0,pA1,Kbase,qr,r32,hi);asm volatile("s_nop 15\n\ts_nop 7":"+v"(pA0),"+v"(pA1));
  if(t_start==0){ const float NEG_=-INFINITY;
    _Pragma("unroll") for(int r=0;r<16;++r)pA0[r]=NEG_;
    _Pragma("unroll") for(int r=0;r<8;++r)pA1[r]=NEG_; }
  START(pA0,pA1);
  _Pragma("unroll") for(int r=0;r<16;++r)pA1[r]=__builtin_amdgcn_exp2f(pA1[r]);
  WAIT_BAR(0);
  DMA_K(3,0);DMA_V(1,SLOTB);
  ROT();
  kload8(kf,kp0+sl_cur);
  WAIT_BAR(2);
  s16x4 vlo[8],vhi[8]; u32x4 pw0,pw1,pw2,pw3;
  #define PKW(P,B) cvtpk_s(P[B],P[B+1])
  #define PAF(k) __builtin_bit_cast(bf16x8,pw##k)
  #define VFR(i) (bf16x8){vlo[i][0],vlo[i][1],vlo[i][2],vlo[i][3],vhi[i][0],vhi[i][1],vhi[i][2],vhi[i][3]}
  #define PIN(x) asm volatile("":"+v"(x))
  #define MX3(a,b,c) __builtin_fmaxf(__builtin_fmaxf((a),(b)),(c))
  #define GAPA(MF,A0,A1,A2,A3,W0,W1,PW) do{ MF; sacc+=A0; sacc+=A1; sacc+=A2; sacc+=A3; PIN(sacc); W0; W1; PIN(PW); SBAR(); }while(0)
  #define EX(v) __builtin_amdgcn_exp2f(v)
  #define GAPB(MF,X,B) do{ MF; X[B]=EX(X[B]); X[B+1]=EX(X[B+1]); X[B+2]=EX(X[B+2]); X[B+3]=EX(X[B+3]); PIN(X); SBAR(); }while(0)
  #define VRD(i) do{ vlo[i]=vtr(vp_+(((i)>>2)*4096+((i)&3)*1024)); vhi[i]=vtr(vp_+(((i)>>2)*4096+((i)&3)*1024+512)); }while(0)
  #define KRD(G,j) do{ if(G){ kload2(kf,kp0+sl_next,j); SBAR(); } }while(0)
  #define STEP(C0,C1,P0,P1,t,GK,GV,GL) do{ SBAR(); \
    const lds_cptr vp_=vp0+sl_prev; CINIT(C0,C1,t); SBAR(); \
    VRD(0); SBAR(); float sacc=(P0[0]+P0[1]); \
    GAPA(C0=__builtin_amdgcn_mfma_f32_32x32x16_bf16(kf[0],qr[0],C0,0,0,0), P0[2],P0[3],P0[4],P0[5],     pw0[0]=PKW(P0,0), pw0[1]=PKW(P0,2), pw0); \
    VRD(4); SBAR(); GAPA(C1=__builtin_amdgcn_mfma_f32_32x32x16_bf16(kf[1],qr[0],C1,0,0,0), P0[6],P0[7],P0[8],P0[9],     pw0[2]=PKW(P0,4), pw0[3]=PKW(P0,6), pw0); \
    VRD(1); SBAR(); GAPA(C0=__builtin_amdgcn_mfma_f32_32x32x16_bf16(kf[2],qr[1],C0,0,0,0),   P0[10],P0[11],P0[12],P0[13], pw1[0]=PKW(P0,8), pw1[1]=PKW(P0,10), pw1); \
    VRD(5); SBAR(); GAPA(C1=__builtin_amdgcn_mfma_f32_32x32x16_bf16(kf[3],qr[1],C1,0,0,0),   P0[14],P0[15],P1[0],P1[1],   pw1[2]=PKW(P0,12),pw1[3]=PKW(P0,14), pw1); \
    VRD(2); SBAR(); GAPA(C0=__builtin_amdgcn_mfma_f32_32x32x16_bf16(kf[4],qr[2],C0,0,0,0),   P1[2],P1[3],P1[4],P1[5],     pw2[0]=PKW(P1,0), pw2[1]=PKW(P1,2), pw2); \
    VRD(6); SBAR(); GAPA(C1=__builtin_amdgcn_mfma_f32_32x32x16_bf16(kf[5],qr[2],C1,0,0,0),   P1[6],P1[7],P1[8],P1[9],     pw2[2]=PKW(P1,4), pw2[3]=PKW(P1,6), pw2); \
    VRD(3); SBAR(); GAPA(C0=__builtin_amdgcn_mfma_f32_32x32x16_bf16(kf[6],qr[3],C0,0,0,0),   P1[10],P1[11],P1[12],P1[13], pw3[0]=PKW(P1,8), pw3[1]=PKW(P1,10), pw3); \
    VRD(7); SBAR(); GAPA(C1=__builtin_amdgcn_mfma_f32_32x32x16_bf16(kf[7],qr[3],C1,0,0,0),   P1[14],P1[15],0.f,0.f,       pw3[2]=PKW(P1,12),pw3[3]=PKW(P1,14), pw3); \
    l_reg+=sacc; \
    if(GK){DMA_K((t)+3,sl_cur);} if(GV){DMA_V((t)+1,sl_next);} \
    CMASK(C0,C1,t); \
    { float a=MX3(C0[0],C0[1],C1[0]),b=MX3(C0[2],C0[3],C1[1]); a=MX3(a,C1[2],C1[3]); \
      _Pragma("unroll") for(int r=4;r<16;r+=4){a=MX3(a,C0[r],C0[r+1]);b=MX3(b,C0[r+2],C0[r+3]);a=MX3(a,C1[r],C1[r+1]);b=MX3(b,C1[r+2],C1[r+3]);} \
      float rm=__builtin_fmaxf(a,b); { auto rr=__builtin_amdgcn_permlane32_swap(__float_as_uint(rm),__float_as_uint(rm),false,false); rm=__builtin_fmaxf(__uint_as_float(rr[0]),__uint_as_float(rr[1])); } \
      resc=false; \
      if(__builtin_expect(__any(rm>(float)THRL),0)){ const float dl=__builtin_fmaxf(rm,0.f); mhat+=dl; \
        _Pragma("unroll") for(int r=0;r<16;++r){C0[r]-=dl;C1[r]-=dl;} \
        cqm=cq2-mhat; \
        const float f=__builtin_amdgcn_exp2f(-dl); l_reg*=f; if(hi==0)wsf[r32]=f; resc=true; } } \
    SBAR(); \
    GAPB(o[0]=__builtin_amdgcn_mfma_f32_32x32x16_bf16(PAF(0),VFR(0),o[0],0,0,0), C0,0); \
    GAPB(o[1]=__builtin_amdgcn_mfma_f32_32x32x16_bf16(PAF(0),VFR(4),o[1],0,0,0), C0,4); \
    KRD(GL,0); GAPB(o[0]=__builtin_amdgcn_mfma_f32_32x32x16_bf16(PAF(1),VFR(1),o[0],0,0,0), C0,8); \
    KRD(GL,1); GAPB(o[1]=__builtin_amdgcn_mfma_f32_32x32x16_bf16(PAF(1),VFR(5),o[1],0,0,0), C0,12); \
    KRD(GL,2); GAPB(o[0]=__builtin_amdgcn_mfma_f32_32x32x16_bf16(PAF(2),VFR(2),o[0],0,0,0), C1,0); \
    KRD(GL,3); GAPB(o[1]=__builtin_amdgcn_mfma_f32_32x32x16_bf16(PAF(2),VFR(6),o[1],0,0,0), C1,4); \
    GAPB(o[0]=__builtin_amdgcn_mfma_f32_32x32x16_bf16(PAF(3),VFR(3),o[0],0,0,0), C1,8); \
    GAPB(o[1]=__builtin_amdgcn_mfma_f32_32x32x16_bf16(PAF(3),VFR(7),o[1],0,0,0), C1,12); \
    }while(0)
  int t=1;
  #undef CMASK
  #define CMASK(P0,P1,t) do{}while(0)
  for(;t+5<NT;t+=2){
    STEP(pB0,pB1,pA0,pA1,t,true,true,true);     WAIT_BAR(2); RESC(); ROT();
    STEP(pA0,pA1,pB0,pB1,t+1,true,true,true);   WAIT_BAR(2); RESC(); ROT();
  }
  #undef CMASK
  #define CMASK(P0,P1,t) do{int jb_=(t)-(NT-5); if(jb_>=0)cmask(P0,P1,jb_,qrel,hi);}while(0)
  #define ENDW(tt) do{ if((tt)+3<NT){WAIT_BAR(2);} else if((tt)+2<NT){WAIT_BAR(1);} else {WAIT_BAR(0);} }while(0)
  for(;t+1<NT;t+=2){
    STEP(pB0,pB1,pA0,pA1,t,(t+3<NT),(t+1<NT),(t+1<NT));       ENDW(t);   RESC(); ROT();
    STEP(pA0,pA1,pB0,pB1,t+1,(t+4<NT),(t+2<NT),(t+2<NT));     ENDW(t+1); RESC(); ROT();
  }
  STEP(pB0,pB1,pA0,pA1,NT-1,false,false,false); RESC();
  { float sacc=pB0[0]+pB0[1]; _Pragma("unroll") for(int r=2;r<16;++r)sacc+=pB0[r]; _Pragma("unroll") for(int r=0;r<16;++r)sacc+=pB1[r]; l_reg+=sacc;
    pw0=(u32x4){PKW(pB0,0),PKW(pB0,2),PKW(pB0,4),PKW(pB0,6)};pw1=(u32x4){PKW(pB0,8),PKW(pB0,10),PKW(pB0,12),PKW(pB0,14)};pw2=(u32x4){PKW(pB1,0),PKW(pB1,2),PKW(pB1,4),PKW(pB1,6)};pw3=(u32x4){PKW(pB1,8),PKW(pB1,10),PKW(pB1,12),PKW(pB1,14)};
    SBAR(); pv(o,vb0+sl_cur,PAF(0),PAF(1),PAF(2),PAF(3)); }
  #undef PKW
  #undef PAF
  #undef VFR
  #undef PIN
  #undef MX3
  #undef GAPA
  #undef GAPB
  #undef EX
  #undef VRD
  #undef KRD
  #undef STEP
  #undef ENDW
  {auto rr=__builtin_amdgcn_permlane32_swap(__float_as_uint(l_reg),__float_as_uint(l_reg),false,false);l_reg=__uint_as_float(rr[0])+__uint_as_float(rr[1]);}
  if(hi==0)wsf[32+r32]=l_reg;asm volatile("s_waitcnt lgkmcnt(0)":::"memory");
  int lane_e=lane; asm volatile("":"+v"(lane_e));
  const int r32e=lane_e&31, hie=lane_e>>5;
  float rli[16];
  #pragma unroll
  for(int r=0;r<16;++r)rli[r]=__builtin_amdgcn_rcpf(wsf[32+crow(r,hie)]);
  bf16*Ow=O+(rowbase+q0+wid*QBLK)*OPITCH+h*D;
  { bf16*stg=(bf16*)(shm+LDS_OST)+wid*2048;
    #pragma unroll
    for(int r=0;r<16;++r){const int orow=crow(r,hie);
      #pragma unroll
      for(int d0=0;d0<2;++d0)stg[orow*64+d0*32+r32e]=(bf16)f2bf(o[d0][r]*rli[r]);}
    asm volatile("s_waitcnt lgkmcnt(0)":::"memory");
    #pragma unroll
    for(int i=0;i<4;++i){const int row=i*8+(lane_e>>3),ch=lane_e&7; const u32x4 v=*(const u32x4*)(stg+row*64+ch*8); ATTN_STORE16(Ow+(long)row*OPITCH+ch*8,v);
      float s=0.f; { const unsigned w_[4]={v.x,v.y,v.z,v.w};
        _Pragma("unroll") for(int e=0;e<4;++e){const float a=__uint_as_float(w_[e]<<16),c=__uint_as_float(w_[e]&0xffff0000u); s+=a*a+c*c;} }
      s+=__builtin_bit_cast(float,__builtin_amdgcn_mov_dpp(__builtin_bit_cast(int,s),0xB1,0xF,0xF,true));
      s+=__builtin_bit_cast(float,__builtin_amdgcn_mov_dpp(__builtin_bit_cast(int,s),0x4E,0xF,0xF,true));
      s+=__builtin_bit_cast(float,__builtin_amdgcn_mov_dpp(__builtin_bit_cast(int,s),0x141,0xF,0xF,true));
      if(ch==0)SSQA[(rowbase+q0+wid*QBLK+row)*NHEAD+h]=s; } }
  asm volatile("s_waitcnt lgkmcnt(0)\n\ts_barrier":::"memory");
  #undef DMA_K
  #undef CINIT
  #undef DMA_V
  #undef CMASK
  #undef START
  #undef RESC
  #undef ROT
}
constexpr int ATTN_LDS_BYTES=LDS_BYTES;
struct AttnTensors { const bf16* Q; const bf16* K; const bf16* V; bf16* O; const float* CFT; float* SSQA; };
struct AttnUnit { int bh; int qb; };
struct StaticOrder {
  int vcu;
  __device__ __forceinline__ explicit StaticOrder(int grid,int block):vcu((block%8)*(grid/8)+block/8){}
  __device__ __forceinline__ bool next(int i,AttnUnit&u)const{ if(i>=4||vcu>=256)return false; const int s=vcu&3; u.bh=vcu>>2; u.qb=(i==0)?15-s:(i==1)?8+s:(i==2)?7-s:s; return true; }
  __device__ __forceinline__ void a_ready(const AttnUnit&)const{}
  __device__ __forceinline__ void done(const AttnUnit&)const{}
};
template<class Sched,int THRL=8> __device__ __forceinline__ void attn_phase(char*lds,const AttnTensors&T,const Sched&S){
  AttnUnit u;
  for(int i=0;S.next(i,u);++i){ S.a_ready(u); attn_unit<THRL>(u.bh/NHEAD,u.bh%NHEAD,u.qb,T.Q,T.K,T.V,T.O,T.CFT,T.SSQA,lds); S.done(u); }
}
#undef SBAR
#undef WAIT_BAR
}


namespace ssd {
typedef short bf16x8 __attribute__((ext_vector_type(8)));
typedef short s16x4 __attribute__((ext_vector_type(4)));
constexpr int CH = 64, NCH = LP / CH;
constexpr int PB = 144, PX = 160, PY = 128;
constexpr int L_CM = 0, L_BM = L_CM + 64 * 256, L_HB = L_BM + 64 * 256, L_XD = L_HB + 2 * 64 * 256, L_XW = L_XD + 64 * PX, L_MT = L_XW + 64 * PX, L_XS = L_MT + 64 * PB, L_SC = L_XS + 64 * PY, L_YT = L_SC + 2 * 1024, L_DTA = L_YT + 64 * PY, L_END = L_DTA + (NCH - 1) * CH * 4;
static_assert(L_END <= MISC_OFF, "ssd LDS map");
__device__ __forceinline__ int crow(int r, int hi) { return (r & 3) + 8 * (r >> 2) + 4 * hi; }
__device__ __forceinline__ int offb(int row, int ch) { return 256 * row + 16 * (ch ^ (((row & 3) << 2) | ((row >> 2) & 3))); }
__device__ __forceinline__ bf16x8 rowfrag_b(const LAS unsigned char* T, int row, int kk, int hi) { return *(const LAS bf16x8*)(T + offb(row, 2 * kk + hi)); }
__device__ __forceinline__ bf16x8 rowfrag_p(const LAS unsigned char* T, int row, int pitch, int kk, int hi) { return *(const LAS bf16x8*)(T + row * pitch + (16 * kk + 8 * hi) * 2); }
__device__ __forceinline__ s16x4 tr4(const LAS unsigned char* p) { return __builtin_bit_cast(s16x4, __builtin_amdgcn_ds_read_tr16_b64_v4i16((LAS s16x4*)p)); }
__device__ __forceinline__ bf16x8 trfrag_p(const LAS unsigned char* T, int pitch, int kk, int cb, int lane) {
    const int hi = lane >> 5, g16 = (lane >> 4) & 1, i = lane & 15; const LAS unsigned char* a = T + (16 * kk + 8 * hi + (i >> 2)) * pitch + (cb + 16 * g16 + 4 * (i & 3)) * 2;
    const s16x4 lo = tr4(a), hh = tr4(a + 4 * pitch); return (bf16x8){lo[0], lo[1], lo[2], lo[3], hh[0], hh[1], hh[2], hh[3]}; }
__device__ __forceinline__ bf16x8 trfrag_b(const LAS unsigned char* T, int kk, int cb, int lane) {
    const int hi = lane >> 5, g16 = (lane >> 4) & 1, i = lane & 15, r0 = 16 * kk + 8 * hi + (i >> 2), ch = (cb >> 3) + 2 * g16 + ((i & 3) >> 1), sub = 8 * (i & 1);
    const s16x4 lo = tr4(T + offb(r0, ch) + sub), hh = tr4(T + offb(r0 + 4, ch) + sub); return (bf16x8){lo[0], lo[1], lo[2], lo[3], hh[0], hh[1], hh[2], hh[3]}; }
__device__ __forceinline__ void unit(Frame& F, int b, int h) {
    LAS unsigned char* lds = F.lds;
    const int tid = F.tid, lane = F.lane, wave = F.wave, r = lane & 31, hi = lane >> 5, g = h / (SH / SG);
    const bf16_t* XC = (const bf16_t*)(F.ws + WS_XC); const float* DT = (const float*)(F.ws + WS_DT); bf16_t* A2 = (bf16_t*)(F.ws + WS_A2); const bf16_t* Zg = (const bf16_t*)(F.ws + WS_Z); float* SSQS = (float*)(F.ws + WS_SSQS);
    const float A = -expf(F.in[I_ALOG][h]), Dh = F.in[I_DSKIP][h];
#define SC_ACS(c) ((LAS float*)(lds + L_SC + ((c) & 1) * 1024))
#define SC_DT(c)  ((LAS float*)(lds + L_SC + ((c) & 1) * 1024 + 256))
#define SC_W(c)   ((LAS float*)(lds + L_SC + ((c) & 1) * 1024 + 512))
#define SC_DEC(c) ((LAS float*)(lds + L_SC + ((c) & 1) * 1024 + 768))
#define SSD_SCAN(c, dtval) do { float cs_ = (dtval) * A; \
        _Pragma("unroll") for (int o = 1; o < 64; o <<= 1) { const float t_ = __shfl_up(cs_, o); if (lane >= o) cs_ += t_; } \
        const float last_ = __shfl(cs_, 63); SC_ACS(c)[lane] = cs_; SC_DT(c)[lane] = (dtval); SC_W(c)[lane] = __expf(last_ - cs_); if (lane == 0) SC_DEC(c)[0] = __expf(last_); } while (0)
    for (int i = tid; i < 64 * 256 / 16; i += NTHREADS) *(LAS u32x4*)(lds + L_HB + i * 16) = (u32x4){0u, 0u, 0u, 0u};
    f32x16 accH[2];
#pragma unroll
    for (int i = 0; i < 16; ++i) { accH[0][i] = 0.f; accH[1][i] = 0.f; }
    const int rowBC0 = tid >> 4, chBC = tid & 15, rowX = tid >> 3, pX = (tid & 7) * 8;
    u32x4 rb[2], rc[2], rx;
    LAS float* dta = (LAS float*)(lds + L_DTA);
    for (int i = tid; i < (NCH - 1) * CH; i += NTHREADS) dta[i] = DT[((size_t)b * LP + CH + i) * SH + h];
    __syncthreads();
#define SSD_LOAD(c) do { const size_t sr0_ = (size_t)b * LP + (size_t)(c) * CH; int t_ = tid; asm volatile("" : "+v"(t_));     \
        _Pragma("unroll") for (int j = 0; j < 2; ++j) { const bf16_t* rowp = XC + (sr0_ + (t_ >> 4) + 32 * j) * CC; rb[j] = *(const u32x4*)(rowp + SW + g * SN + (t_ & 15) * 8); rc[j] = *(const u32x4*)(rowp + SW + SG * SN + g * SN + (t_ & 15) * 8); } \
        rx = *(const u32x4*)(XC + (sr0_ + (t_ >> 3)) * CC + h * SP + (t_ & 7) * 8); } while (0)
#define SSD_FLUSH(cc) do { const u32x4 yv_ = *(const LAS u32x4*)(lds + L_YT + rowX * PY + pX * 2); const size_t m_ = (size_t)b * SEQ + (size_t)((cc) * CH - ROW_REAL) + rowX; \
        const unsigned yw_[4] = {yv_.x, yv_.y, yv_.z, yv_.w}, zw_[4] = {rz.x, rz.y, rz.z, rz.w}; unsigned ow_[4]; float s_ = 0.f; \
        _Pragma("unroll") for (int e = 0; e < 4; ++e) { const float g0 = __uint_as_float(yw_[e] << 16) * siluf_(__uint_as_float(zw_[e] << 16)), g1 = __uint_as_float(yw_[e] & 0xffff0000u) * siluf_(__uint_as_float(zw_[e] & 0xffff0000u)); \
            ow_[e] = pk2(g0, g1); const float r0_ = __uint_as_float(ow_[e] << 16), r1_ = __uint_as_float(ow_[e] & 0xffff0000u); s_ += r0_ * r0_ + r1_ * r1_; } \
        *(u32x4*)(A2 + m_ * 3072 + AW + h * SP + pX) = (u32x4){ow_[0], ow_[1], ow_[2], ow_[3]}; \
        s_ += __shfl_xor(s_, 1); s_ += __shfl_xor(s_, 2); s_ += __shfl_xor(s_, 4); if ((tid & 7) == 0) SSQS[m_ * SH + h] = s_; } while (0)
#define SSD_LOADZ(cc) do { rz = *(const u32x4*)(Zg + ((size_t)b * SEQ + (size_t)((cc) * CH - ROW_REAL) + rowX) * SW + h * SP + pX); } while (0)
    u32x4 rz = (u32x4){0u, 0u, 0u, 0u};
    unsigned long long pacc_ = 0, pt_ = 0;
#define SP_T0(bit) do { if ((PROBE_MASK >> (bit)) & 1) pt_ = __builtin_amdgcn_s_memrealtime(); } while (0)
#define SP_T1(bit) do { if ((PROBE_MASK >> (bit)) & 1) pacc_ += __builtin_amdgcn_s_memrealtime() - pt_; } while (0)
    if (wave == 0) SSD_SCAN(1, dta[lane]);
    __syncthreads();
    auto chunk = [&](const int c, u32x4 (&rb)[2], u32x4 (&rc)[2], u32x4& rx, u32x4& rz) {
        const int hb_old = L_HB + ((c + 1) & 1) * 64 * 256, hb_new = L_HB + (c & 1) * 64 * 256;
        SP_T0(16);
#pragma unroll
        for (int j = 0; j < 2; ++j) { const int row = rowBC0 + 32 * j; *(LAS u32x4*)(lds + L_BM + offb(row, chBC)) = rb[j]; *(LAS u32x4*)(lds + L_CM + offb(row, chBC)) = rc[j]; }
        { const float d = SC_DT(c)[rowX], dw = d * SC_W(c)[rowX]; const unsigned w[4] = {rx.x, rx.y, rx.z, rx.w}; float xf[8];
#pragma unroll
            for (int i = 0; i < 8; ++i) xf[i] = __uint_as_float((i & 1) ? (w[i >> 1] & 0xffff0000u) : (w[i >> 1] << 16));
            *(LAS u32x4*)(lds + L_XS + rowX * PY + pX * 2) = rx;
            *(LAS u32x4*)(lds + L_XD + rowX * PX + pX * 2) = (u32x4){pk2(xf[0] * d, xf[1] * d), pk2(xf[2] * d, xf[3] * d), pk2(xf[4] * d, xf[5] * d), pk2(xf[6] * d, xf[7] * d)};
            *(LAS u32x4*)(lds + L_XW + rowX * PX + pX * 2) = (u32x4){pk2(xf[0] * dw, xf[1] * dw), pk2(xf[2] * dw, xf[3] * dw), pk2(xf[4] * dw, xf[5] * dw), pk2(xf[6] * dw, xf[7] * dw)}; }
        if (c >= 3) SSD_FLUSH(c - 1);
        if (c + 1 >= 2 && c + 1 < NCH) SSD_LOADZ(c + 1);
        if (c + 2 < NCH) SSD_LOAD(c + 2);
        __syncthreads();
        SP_T1(16); SP_T0(17);
        const LAS float* acs = SC_ACS(c);
        f32x16 accy;
#pragma unroll
        for (int i = 0; i < 16; ++i) accy[i] = 0.f;
        if (wave < 4) {
            const int lt = wave >> 1, st = wave & 1, l = 32 * lt + r;
            { f32x4 cs4[4];
#pragma unroll
                for (int gq = 0; gq < 4; ++gq) cs4[gq] = *(const LAS f32x4*)(acs + 32 * st + 8 * gq + 4 * hi);
                const float cs_l = acs[l];
#pragma unroll
                for (int k0 = 0; k0 < 8; k0 += 4) { bf16x8 fa[4], fb[4];
#pragma unroll
                    for (int k = 0; k < 4; ++k) { fa[k] = rowfrag_b(lds + L_BM, 32 * st + r, k0 + k, hi); fb[k] = rowfrag_b(lds + L_CM, l, k0 + k, hi); }
#pragma unroll
                    for (int k = 0; k < 4; ++k) accy = __builtin_amdgcn_mfma_f32_32x32x16_bf16(fa[k], fb[k], accy, 0, 0, 0); }
#pragma unroll
                for (int gq = 0; gq < 4; ++gq) { const int s0 = 32 * st + 8 * gq + 4 * hi; float m[4];
#pragma unroll
                    for (int i = 0; i < 4; ++i) { const float e = __expf(fminf(cs_l - cs4[gq][i], 0.f)); m[i] = (s0 + i <= l) ? accy[4 * gq + i] * e : 0.f; }
                    *(LAS u32x2*)(lds + L_MT + l * PB + s0 * 2) = (u32x2){pk2(m[0], m[1]), pk2(m[2], m[3])}; } }
        } else {
            const int lt = (wave - 4) >> 1, pt = wave & 1;
            f32x4 cs4[4];
#pragma unroll
            for (int gq = 0; gq < 4; ++gq) cs4[gq] = *(const LAS f32x4*)(acs + 32 * lt + 8 * gq + 4 * hi);
#pragma unroll
            for (int k0 = 0; k0 < 8; k0 += 4) { bf16x8 fa[4], fb[4];
#pragma unroll
                for (int k = 0; k < 4; ++k) { fa[k] = rowfrag_b(lds + L_CM, 32 * lt + r, k0 + k, hi); fb[k] = rowfrag_b(lds + hb_old, 32 * pt + r, k0 + k, hi); }
#pragma unroll
                for (int k = 0; k < 4; ++k) accy = __builtin_amdgcn_mfma_f32_32x32x16_bf16(fa[k], fb[k], accy, 0, 0, 0); }
#pragma unroll
            for (int i = 0; i < 16; ++i) accy[i] *= __expf(cs4[i >> 2][i & 3]);
        }
        __syncthreads();
        SP_T1(17); SP_T0(18);
        if (wave >= 4) {
            const int lt = (wave - 4) >> 1, pt = wave & 1;
            { bf16x8 fa[4], fb[4];
#pragma unroll
                for (int k = 0; k < 4; ++k) { fa[k] = rowfrag_p(lds + L_MT, 32 * lt + r, PB, k, hi); fb[k] = trfrag_p(lds + L_XD, PX, k, 32 * pt, lane); }
#pragma unroll
                for (int k = 0; k < 4; ++k) accy = __builtin_amdgcn_mfma_f32_32x32x16_bf16(fa[k], fb[k], accy, 0, 0, 0); }
            if (c >= 2) {
#pragma unroll
                for (int i = 0; i < 16; ++i) { const int l = 32 * lt + crow(i, hi), p = 32 * pt + r;
                    const float xv = bf2f(*(const LAS bf16_t*)(lds + L_XS + l * PY + p * 2));
                    *(LAS bf16_t*)(lds + L_YT + l * PY + p * 2) = (bf16_t)f2bf(accy[i] + Dh * xv); }
            }
        } else {
            const int pt = wave & 1, nt0 = 2 * (wave >> 1); const float dec = SC_DEC(c)[0];
#pragma unroll
            for (int i = 0; i < 16; ++i) { accH[0][i] *= dec; accH[1][i] *= dec; }
            { bf16x8 fx[4], fn[2][4];
#pragma unroll
                for (int k = 0; k < 4; ++k) { fx[k] = trfrag_p(lds + L_XW, PX, k, 32 * pt, lane); fn[0][k] = trfrag_b(lds + L_BM, k, 32 * nt0, lane); fn[1][k] = trfrag_b(lds + L_BM, k, 32 * (nt0 + 1), lane); }
#pragma unroll
                for (int k = 0; k < 4; ++k)
#pragma unroll
                    for (int j = 0; j < 2; ++j) accH[j] = __builtin_amdgcn_mfma_f32_32x32x16_bf16(fn[j][k], fx[k], accH[j], 0, 0, 0); }
            const int p = 32 * pt + r;
#pragma unroll
            for (int j = 0; j < 2; ++j)
#pragma unroll
                for (int gq = 0; gq < 4; ++gq) { const int n0 = 32 * (nt0 + j) + 8 * gq + 4 * hi;
                    *(LAS u32x2*)(lds + hb_new + offb(p, n0 >> 3) + (n0 & 7) * 2) = (u32x2){pk2(accH[j][4 * gq], accH[j][4 * gq + 1]), pk2(accH[j][4 * gq + 2], accH[j][4 * gq + 3])}; }
            if (wave == 0 && c + 1 < NCH) SSD_SCAN(c + 1, dta[c * CH + lane]);
        }
        __syncthreads();
        SP_T1(18);
    };
    u32x4 rbB[2], rcB[2], rxB, rzO = (u32x4){0u, 0u, 0u, 0u};
    SSD_LOAD(1);
    { u32x4 (&rb)[2] = rbB; u32x4 (&rc)[2] = rcB; u32x4& rx = rxB; SSD_LOAD(2); }
    for (int c = 1; c + 1 < NCH; c += 2) { chunk(c, rb, rc, rx, rz); chunk(c + 1, rbB, rcB, rxB, rzO); }
    chunk(NCH - 1, rb, rc, rx, rz);
    { u32x4& rz = rzO;
    if (PROBE_MASK & (7 << 16)) { const unsigned long long t1_ = __builtin_amdgcn_s_memrealtime(); while (__builtin_amdgcn_s_memrealtime() - t1_ < pacc_) __builtin_amdgcn_s_sleep(8); }
    SSD_FLUSH(NCH - 1); }
    __syncthreads();
#undef SSD_FLUSH
#undef SSD_LOADZ
#undef SSD_LOAD
#undef SSD_SCAN
#undef SC_ACS
#undef SC_DT
#undef SC_W
#undef SC_DEC
}
}
constexpr int WQ_SSD = NB * SH, WQ_TOTAL = WQ_SSD + NB * AH * 16;
__device__ __forceinline__ void ph2_queue(Frame& F) {
    const attn_body::AttnTensors AT{(const bf16_t*)(F.ws + WS_Q), (const bf16_t*)(F.ws + WS_K), (const bf16_t*)(F.ws + WS_V), (bf16_t*)(F.ws + WS_A2), (const float*)(F.ws + WS_CFT), (float*)(F.ws + WS_SSQA)};
    volatile LAS unsigned* slot = (volatile LAS unsigned*)(F.lds + MISC_OFF + 64);
    for (;;) {
        if (F.tid == 0) slot[0] = __hip_atomic_fetch_add(F.ctl + CW_WQ, 1u, __ATOMIC_RELAXED, __HIP_MEMORY_SCOPE_AGENT);
        __syncthreads();
        const int u = __builtin_amdgcn_readfirstlane((int)slot[0]);
        __syncthreads();
        if (u >= WQ_SSD) break;
        ssd::unit(F, u / SH, u % SH);
    }
    unsigned nxt = 0u;
    if (F.tid == 0) nxt = __hip_atomic_fetch_add(F.ctl + CW_WQ + 64, 1u, __ATOMIC_RELAXED, __HIP_MEMORY_SCOPE_AGENT);
    for (;;) {
        if (F.tid == 0) slot[0] = nxt;
        __syncthreads();
        const int a = __builtin_amdgcn_readfirstlane((int)slot[0]);
        __syncthreads();
        if (a >= WQ_TOTAL - WQ_SSD) break;
        if (F.tid == 0) nxt = __hip_atomic_fetch_add(F.ctl + CW_WQ + 64, 1u, __ATOMIC_RELAXED, __HIP_MEMORY_SCOPE_AGENT);
        const int qb = 15 - (a >> 6), bh = a & 63;
        attn_body::attn_unit<8>(bh / AH, bh % AH, qb, AT.Q, AT.K, AT.V, AT.O, AT.CFT, AT.SSQA, (char*)F.lds);
    }
    for (;;) {
        if (F.tid == 0) slot[0] = __hip_atomic_fetch_add(F.ctl + CW_WQ + 128, 1u, __ATOMIC_RELAXED, __HIP_MEMORY_SCOPE_AGENT);
        __syncthreads();
        const int it = __builtin_amdgcn_readfirstlane((int)slot[0]);
        __syncthreads();
        if (it >= MOE_DYN / (NWAVES * MOE_DQ)) break;
        const int g0 = MOE_STAT + (it * NWAVES + F.wave) * MOE_DQ;
        moe_convert(F, g0, g0 + MOE_DQ);
    }
}
__device__ __forceinline__ void ph5_router(Frame& F) {
    typedef short bf16x8 __attribute__((ext_vector_type(8)));
    const float* X = F.in[I_X]; const bf16_t* MX = (const bf16_t*)(F.ws + WS_MX); unsigned char* XN2 = F.ws + WS_XN2; bf16_t* H1B = (bf16_t*)(F.ws + WS_H1B); const float* g = F.in[I_GFFN]; const float* BR = F.in[I_BR]; const bf16_t* WrT = (const bf16_t*)(F.ws + WS_WRT);
    int* TOKE = (int*)(F.ws + WS_TOKE); int* TOKP = (int*)(F.ws + WS_TOKP); int* LIST = (int*)(F.ws + WS_LIST); float* LISTW = (float*)(F.ws + WS_LISTW);
    constexpr int PITCH = DM * 2 + 16;
    LAS unsigned char* n2t = F.lds; LAS float* part = (LAS float*)(F.lds + 16 * PITCH);
    const int lane = F.lane, w = F.wave, q = lane >> 4, c16 = lane & 15;
    bf16x8 bw[8][2];
#pragma unroll
    for (int ks = 0; ks < 8; ++ks)
#pragma unroll
        for (int blk = 0; blk < 2; ++blk) bw[ks][blk] = *(const bf16x8*)(WrT + (size_t)(c16 + 16 * blk) * DM + 256 * w + 32 * ks + 8 * q);
    f32x4 gg[8];
#pragma unroll
    for (int j = 0; j < 8; ++j) gg[j] = *(const f32x4*)(g + 4 * lane + 256 * j);
    for (int it = blockIdx.x; it < M / 16; it += gridDim.x) {
        const int r0 = it * 16;
#pragma unroll
        for (int rr = 0; rr < 2; ++rr) { const int row = 2 * w + rr, m = r0 + row;
            f32x4 v[8]; float ss = 0.f;
#pragma unroll
            for (int j = 0; j < 8; ++j) { v[j] = *(const f32x4*)(X + (size_t)m * DM + 4 * lane + 256 * j); const u32x2 mw = *(const u32x2*)(MX + (size_t)m * DM + 4 * lane + 256 * j);
                v[j].x += __uint_as_float(mw.x << 16); v[j].y += __uint_as_float(mw.x & 0xffff0000u); v[j].z += __uint_as_float(mw.y << 16); v[j].w += __uint_as_float(mw.y & 0xffff0000u);
                ss += (v[j].x * v[j].x + v[j].y * v[j].y) + (v[j].z * v[j].z + v[j].w * v[j].w); }
            const float rstd = rsqrtf(wave_sum(ss) * (1.f / DM) + EPS);
#pragma unroll
            for (int j = 0; j < 8; ++j) { const float a0 = v[j].x * rstd * gg[j].x, a1 = v[j].y * rstd * gg[j].y, a2 = v[j].z * rstd * gg[j].z, a3 = v[j].w * rstd * gg[j].w;
                u32x2 o; o.x = pk2(a0, a1); o.y = pk2(a2, a3);
                *(u32x2*)(H1B + (size_t)m * DM + 4 * lane + 256 * j) = (u32x2){pk2(v[j].x, v[j].y), pk2(v[j].z, v[j].w)};
                *(unsigned*)(XN2 + (size_t)m * DM + 4 * lane + 256 * j) = pg8::pk4_fp8(a0, a1, a2, a3); *(LAS u32x2*)(n2t + row * PITCH + (4 * lane + 256 * j) * 2) = o; } }
        __syncthreads();
        f32x4 acc[2] = {(f32x4){0.f, 0.f, 0.f, 0.f}, (f32x4){0.f, 0.f, 0.f, 0.f}};
#pragma unroll
        for (int ks = 0; ks < 8; ++ks) { const bf16x8 a = *(const LAS bf16x8*)(n2t + c16 * PITCH + (256 * w + 32 * ks + 8 * q) * 2);
            acc[0] = __builtin_amdgcn_mfma_f32_16x16x32_bf16(a, bw[ks][0], acc[0], 0, 0, 0); acc[1] = __builtin_amdgcn_mfma_f32_16x16x32_bf16(a, bw[ks][1], acc[1], 0, 0, 0); }
#pragma unroll
        for (int blk = 0; blk < 2; ++blk)
#pragma unroll
            for (int i = 0; i < 4; ++i) part[(w * 16 + 4 * q + i) * 32 + 16 * blk + c16] = acc[blk][i];
        __syncthreads();
        { const int row = F.tid >> 5, e = F.tid & 31, m = r0 + row;
            float logit = BR[e];
#pragma unroll
            for (int ww = 0; ww < 8; ++ww) logit += part[(ww * 16 + row) * 32 + e];
            float tv[4]; int ti[4]; float cur = logit;
#pragma unroll
            for (int k = 0; k < 4; ++k) { float bv = cur; int bi = e;
#pragma unroll
                for (int o = 1; o < 32; o <<= 1) { const float ov = __shfl_xor(bv, o); const int oi = __shfl_xor(bi, o); if (ov > bv || (ov == bv && oi < bi)) { bv = ov; bi = oi; } }
                tv[k] = bv; ti[k] = bi; if (e == bi) cur = -INFINITY; }
            const float e1 = __expf(tv[1] - tv[0]), e2 = __expf(tv[2] - tv[0]), e3 = __expf(tv[3] - tv[0]); const float rs = 1.f / (1.f + e1 + e2 + e3);
            if (e < 4) { const int ex = e == 0 ? ti[0] : e == 1 ? ti[1] : e == 2 ? ti[2] : ti[3]; const float wg = (e == 0 ? 1.f : e == 1 ? e1 : e == 2 ? e2 : e3) * rs;
                const int pos = (int)__hip_atomic_fetch_add(F.ctl + CW_CNT + 64 * ex, 1u, __ATOMIC_RELAXED, __HIP_MEMORY_SCOPE_AGENT);
                TOKE[m * 4 + e] = ex; TOKP[m * 4 + e] = pos; LIST[(size_t)ex * M + pos] = m; LISTW[(size_t)ex * M + pos] = wg; } }
    }
}

constexpr int TAB_OFF = MISC_OFF + 256;
__device__ __forceinline__ void load_expert_tables(Frame& F, LAS int* tab) {
    __syncthreads();
    if (F.tid == 0) { int rb = 0, tb = 0, t2 = 0;
        for (int e = 0; e < NE; ++e) { const int c = (int)__hip_atomic_load(F.ctl + CW_CNT + 64 * e, __ATOMIC_RELAXED, __HIP_MEMORY_SCOPE_AGENT);
            tab[e] = c; tab[32 + e] = rb; tab[64 + e] = tb; tab[128 + e] = t2; rb += ((c + 255) / 256) * 256; tb += (c + 63) / 64; t2 += (c + 255) / 256; }
        tab[96] = tb; tab[160] = t2; }
    __syncthreads();
}
constexpr float YSCALE = 32.f, YSCALE_INV = 1.f / 32.f;
constexpr float WSCALE = 64.f, WSCALE_INV = 1.f / 64.f;
struct GroupedOrder {
    const LAS int* tab; int NT, G, c, nwg; const char* A; const char* W; size_t wstride, tstep; const int* LIST; bool gather;
    __device__ __forceinline__ bool next(int i, pg8::Unit& u) const {
        const int L = i * G + c; if (L >= nwg) return false;
        int wgid = L; { const int q = nwg / 8, r = nwg % 8, xcd = wgid % 8, off = wgid / 8; wgid = (xcd < r ? xcd * (q + 1) : r * (q + 1) + (xcd - r) * q) + off; }
        int e = 0;
        for (int k = 1; k < NE; ++k) if (tab[128 + k] * NT <= wgid) e = k;
        e = __builtin_amdgcn_readfirstlane(e);
        const int t0 = __builtin_amdgcn_readfirstlane(tab[128 + e]), t1 = __builtin_amdgcn_readfirstlane(tab[128 + e + 1]);
        const int idx = wgid - t0 * NT, tiles = t1 - t0;
        u.x = idx % tiles; u.pn = idx / tiles; u.e = e; u.pm = t0 + u.x; return true;
    }
    __device__ __forceinline__ const char* a_base(const pg8::Unit& u) const { return gather ? A : A + (size_t)u.pm * tstep; }
    __device__ __forceinline__ const char* b_base(const pg8::Unit& u) const { return W + (size_t)u.e * wstride + (size_t)u.pn * tstep; }
    __device__ __forceinline__ int a_row(const pg8::Unit& u, int R) const { const int cnt = __builtin_amdgcn_readfirstlane(tab[u.e]); int pos = u.x * 256 + R; pos = pos < cnt ? pos : cnt - 1; return LIST[(size_t)u.e * M + pos]; }
};
struct EpiGateUp {
    static constexpr bool PERM = true, MIDSCALE = false;
    unsigned char* H; const float* Bgu;
    __device__ __forceinline__ void operator()(const f32x4 (&acc)[2][2][4][2], const pg8::Unit& u, int wr, int wc, int fr, int fq) const {
        asm volatile("" : "+v"(fr), "+v"(fq));
        const int j0 = u.pn * 128 + wc * 32 + 8 * fq; const float* bg = Bgu + (size_t)u.e * 4096 + j0;
        const f32x4 bg0 = *(const f32x4*)bg, bg1 = *(const f32x4*)(bg + 4), bu0 = *(const f32x4*)(bg + 2048), bu1 = *(const f32x4*)(bg + 2052);
#pragma unroll
        for (int ai = 0; ai < 2; ++ai)
#pragma unroll
            for (int m = 0; m < 4; ++m) { const int r = ai * 128 + wr * 64 + m * 16 + fr; float h[8];
#pragma unroll
                for (int n = 0; n < 2; ++n) { const f32x4 gv = acc[ai][0][m][n] * WSCALE_INV + (n ? bg1 : bg0), uv = acc[ai][1][m][n] * WSCALE_INV + (n ? bu1 : bu0);
#pragma unroll
                    for (int i = 0; i < 4; i += 2) { f32x2_cv g = {fminf(gv[i], 7.f), fminf(gv[i + 1], 7.f)}, uu = {fminf(fmaxf(uv[i], -7.f), 7.f), fminf(fmaxf(uv[i + 1], -7.f), 7.f)};
                        const f32x2_cv t = g * (-1.702f * LOG2E); f32x2_cv e = {__builtin_amdgcn_exp2f(t.x), __builtin_amdgcn_exp2f(t.y)}; e = e + 1.0f;
                        const f32x2_cv rr = {__builtin_amdgcn_rcpf(e.x), __builtin_amdgcn_rcpf(e.y)}; const f32x2_cv hv = (g * rr) * (uu + 1.0f);
                        h[4 * n + i] = hv.x; h[4 * n + i + 1] = hv.y; } }
                u32x2 w; w.x = pg8::pk4_fp8(h[0], h[1], h[2], h[3]); w.y = pg8::pk4_fp8(h[4], h[5], h[6], h[7]);
                *(u32x2*)(H + (size_t)(u.pm * 256 + r) * FF + j0) = w; }
    }
};
__device__ __forceinline__ void ph6_gateup(Frame& F) {
    LAS int* tab = (LAS int*)(F.lds + TAB_OFF);
    load_expert_tables(F, tab);
    GroupedOrder S{tab, 16, (int)gridDim.x, (int)blockIdx.x, __builtin_amdgcn_readfirstlane(tab[160]) * 16, (const char*)(F.ws + WS_XN2), (const char*)(F.ws + WS_WGU), (size_t)4096 * DM, (size_t)256 * DM, (const int*)(F.ws + WS_LIST), true};
    EpiGateUp E{F.ws + WS_H, F.in[I_BGU]};
    pg8::gemm_phase<EpiGateUp, GroupedOrder, true, true, true>(F.lds, DM, S, E);
}
struct EpiDown {
    static constexpr bool PERM = true, MIDSCALE = false;
    unsigned char* Y; const float* Bd; const float* LISTW;
    __device__ __forceinline__ void operator()(const f32x4 (&acc)[2][2][4][2], const pg8::Unit& u, int wr, int wc, int fr, int fq) const {
        asm volatile("" : "+v"(fr), "+v"(fq));
        const int col0 = u.pn * 256 + wc * 32 + 8 * fq; const float* bd = Bd + (size_t)u.e * DM + col0;
        f32x4 bv[2][2];
#pragma unroll
        for (int bj = 0; bj < 2; ++bj)
#pragma unroll
            for (int n = 0; n < 2; ++n) bv[bj][n] = *(const f32x4*)(bd + bj * 128 + 4 * n);
#pragma unroll
        for (int ai = 0; ai < 2; ++ai)
#pragma unroll
            for (int m = 0; m < 4; ++m) { const int r = ai * 128 + wr * 64 + m * 16 + fr; const float gw = LISTW[(size_t)u.e * M + u.x * 256 + r];
                unsigned char* rowp = Y + (size_t)(u.pm * 256 + r) * DM + col0; const float gs = gw * YSCALE;
#pragma unroll
                for (int bj = 0; bj < 2; ++bj) { const f32x4 v0 = (acc[ai][bj][m][0] * WSCALE_INV + bv[bj][0]) * gs, v1 = (acc[ai][bj][m][1] * WSCALE_INV + bv[bj][1]) * gs;
                    u32x2 w; w.x = pg8::pk4_fp8(v0[0], v0[1], v0[2], v0[3]); w.y = pg8::pk4_fp8(v1[0], v1[1], v1[2], v1[3]);
                    *(u32x2*)(rowp + bj * 128) = w; } }
    }
};
__device__ __forceinline__ void ph7_down(Frame& F) {
    LAS int* tab = (LAS int*)(F.lds + TAB_OFF);
    load_expert_tables(F, tab);
    GroupedOrder S{tab, 8, (int)gridDim.x, (int)blockIdx.x, __builtin_amdgcn_readfirstlane(tab[160]) * 8, (const char*)(F.ws + WS_H), (const char*)(F.ws + WS_WD), (size_t)DM * FF, (size_t)256 * FF, nullptr, false};
    EpiDown E{F.ws + WS_Y, F.in[I_BD], (const float*)(F.ws + WS_LISTW)};
    pg8::gemm_phase<EpiDown, GroupedOrder, false, true, true>(F.lds, FF, S, E);
}


__device__ __forceinline__ void ph8_final(Frame& F) {
    const bf16_t* H1B = (const bf16_t*)(F.ws + WS_H1B); float* OUT = F.out; const unsigned char* Y = F.ws + WS_Y;
    const int* TOKE = (const int*)(F.ws + WS_TOKE); const int* TOKP = (const int*)(F.ws + WS_TOKP); const float* g = F.in[I_GFIN];
    LAS int* tab = (LAS int*)(F.lds + TAB_OFF);
    load_expert_tables(F, tab);
    for (int m = F.gw; m < M; m += F.NGW) {
        size_t rows[4];
#pragma unroll
        for (int k = 0; k < 4; ++k) rows[k] = (size_t)(tab[32 + TOKE[m * 4 + k]] + TOKP[m * 4 + k]);
        f32x4 v[8]; float ss = 0.f;
#pragma unroll
        for (int j = 0; j < 8; ++j) { const int c = 4 * F.lane + 256 * j; v[j] = (f32x4){0.f, 0.f, 0.f, 0.f}; const u32x2 mw = *(const u32x2*)(H1B + (size_t)m * DM + c);
            f32x4 ys = (f32x4){0.f, 0.f, 0.f, 0.f};
#pragma unroll
            for (int k = 0; k < 4; ++k) { const int w = *(const int*)(Y + rows[k] * DM + c); const auto lo = __builtin_amdgcn_cvt_pk_f32_fp8(w, false), hi = __builtin_amdgcn_cvt_pk_f32_fp8(w, true);
                ys.x += lo[0]; ys.y += lo[1]; ys.z += hi[0]; ys.w += hi[1]; }
            v[j].x += __uint_as_float(mw.x << 16) + ys.x * YSCALE_INV; v[j].y += __uint_as_float(mw.x & 0xffff0000u) + ys.y * YSCALE_INV;
            v[j].z += __uint_as_float(mw.y << 16) + ys.z * YSCALE_INV; v[j].w += __uint_as_float(mw.y & 0xffff0000u) + ys.w * YSCALE_INV;
            ss += (v[j].x * v[j].x + v[j].y * v[j].y) + (v[j].z * v[j].z + v[j].w * v[j].w); }
        const float rstd = rsqrtf(wave_sum(ss) * (1.f / DM) + EPS);
#pragma unroll
        for (int j = 0; j < 8; ++j) { const int c = 4 * F.lane + 256 * j; const f32x4 gg = *(const f32x4*)(g + c);
            *(f32x4*)(OUT + (size_t)m * DM + c) = (f32x4){v[j].x * rstd * gg.x, v[j].y * rstd * gg.y, v[j].z * rstd * gg.z, v[j].w * rstd * gg.w}; }
    }
}

constexpr int NPHASES = 10;
__global__ void __launch_bounds__(NTHREADS, 2) fwd(Params p) {
    extern __shared__ __attribute__((aligned(16))) unsigned char lds_raw[];
    Frame F;
    F.lds = (LAS unsigned char*)lds_raw;
    F.tid = threadIdx.x; F.lane = F.tid & 63; F.wave = __builtin_amdgcn_readfirstlane(F.tid >> 6);
    F.gw = blockIdx.x * NWAVES + F.wave; F.NGW = gridDim.x * NWAVES;
    F.in = p.in; F.out = p.out; F.ws = p.ws; F.ctl = (unsigned*)(p.ws + WS_CTL);
    volatile LAS unsigned* MISC = (volatile LAS unsigned*)(F.lds + MISC_OFF);
    if (F.tid < 32) MISC[F.tid] = 0u;
    __syncthreads();
    const int lo = p.ph_lo, hi = p.ph_hi;
    XcdBarrier bar; bar.bar = F.ctl + CW_BAR; bar.x = 0; bar.st = nullptr;
    if (hi - lo > 1) bar = xcd_barrier_post(F.ctl + CW_BAR, MISC + 8);
#define IN(k) (lo <= (k) && (k) < hi)
#ifndef PROBE_MASK
#define PROBE_MASK 0
#endif
    unsigned long long pt0_ = 0;
#define PSTART(k) do { if ((PROBE_MASK >> (k)) & 1) pt0_ = __builtin_amdgcn_s_memrealtime(); } while (0)
#define PEND(k) do { if ((PROBE_MASK >> (k)) & 1) { const unsigned long long t1_ = __builtin_amdgcn_s_memrealtime(); while (__builtin_amdgcn_s_memrealtime() - t1_ < t1_ - pt0_) __builtin_amdgcn_s_sleep(8); } } while (0)
#define SEAM(k) do { if (IN(k) && IN((k) + 1)) xcd_barrier(bar); } while (0)
    if (IN(0)) { PSTART(0); ph0_prologue(F); ph0_weights(F); PEND(0); } SEAM(0);
    if (IN(1)) { PSTART(1); { const bool conv_first = (blockIdx.x & 1) != 0; if (conv_first) moe_weights(F); ph1_inproj(F); if (!conv_first) moe_weights(F); } PEND(1); } SEAM(1);
    if (IN(2)) { PSTART(2); PSTART(14); ph1b_conv_scan<1>(F); PEND(14); PSTART(15); ph1b_conv_scan<2>(F); PEND(15); PEND(2); } SEAM(2);
    if (IN(3)) { PSTART(3); ph2_queue(F); PEND(3); } if (IN(3) && IN(5)) xcd_barrier(bar);
    if (IN(5)) { PSTART(5); ph4_outproj(F); PEND(5); } SEAM(5);
    if (IN(6)) { PSTART(6); ph5_router(F); PEND(6); } SEAM(6);
    if (IN(7)) { PSTART(7); ph6_gateup(F); PEND(7); } SEAM(7);
    if (IN(8)) { PSTART(8); ph7_down(F); PEND(8); } SEAM(8);
    if (IN(9)) { PSTART(9); ph8_final(F); PEND(9); }
#undef IN
#undef SEAM
}

extern "C" void kernel_launch(void* const* d_in, const int* in_sizes, int n_in, void* d_out, int out_size, void* d_ws, size_t ws_size, hipStream_t stream) {
    static int grid = 0;
    if (grid == 0) {
        if (n_in != 21 || out_size != M * DM || ws_size < WS_END) { fprintf(stderr, "kernel_launch: unexpected shapes (n_in %d, out %d, ws %zu < %zu)\n", n_in, out_size, ws_size, (size_t)WS_END); grid = -1; return; }
        int dev = 0, cus = 0, per_cu = 0;
        if (hipGetDevice(&dev) != hipSuccess || hipDeviceGetAttribute(&cus, hipDeviceAttributeMultiprocessorCount, dev) != hipSuccess) { grid = -1; return; }
        if (hipFuncSetAttribute((const void*)fwd, hipFuncAttributeMaxDynamicSharedMemorySize, LDS_BYTES) != hipSuccess) { fprintf(stderr, "kernel_launch: hipFuncSetAttribute failed\n"); grid = -1; return; }
        if (hipOccupancyMaxActiveBlocksPerMultiprocessor(&per_cu, (const void*)fwd, NTHREADS, LDS_BYTES) != hipSuccess || per_cu < 1) fprintf(stderr, "kernel_launch: occupancy query says %d\n", per_cu);
        (void)hipGetLastError();
        grid = cus;
    }
    if (grid < 0) return;
    (void)hipMemsetAsync((char*)d_ws + WS_CTL, 0, CTL_ZERO_BYTES, stream);
    Params p{};
    for (int i = 0; i < 21; ++i) p.in[i] = (const float*)d_in[i];
    p.out = (float*)d_out; p.ws = (unsigned char*)d_ws;
#if MK_ONE_LAUNCH
    p.ph_lo = 0; p.ph_hi = NPHASES;
    hipLaunchKernelGGL(fwd, dim3(grid), dim3(NTHREADS), LDS_BYTES, stream, p);
#else
    for (int k = 0; k < NPHASES; ++k) { p.ph_lo = k; p.ph_hi = k + 1; hipLaunchKernelGGL(fwd, dim3(grid), dim3(NTHREADS), LDS_BYTES, stream, p); }
#endif
}
```

```cpp
#include <hip/hip_runtime.h>
#include <cstdio>
#include <cstdint>

#ifndef PROBE_MASK
#define PROBE_MASK 0
#endif
#ifndef MK_ONE_LAUNCH
#define MK_ONE_LAUNCH 1
#endif

#define GAS __attribute__((address_space(1)))
#define LAS __attribute__((address_space(3)))
typedef unsigned short bf16_t;
typedef float f32x4 __attribute__((ext_vector_type(4)));
typedef float f32x16 __attribute__((ext_vector_type(16)));
typedef unsigned u32x4 __attribute__((ext_vector_type(4)));
typedef unsigned u32x2 __attribute__((ext_vector_type(2)));

constexpr int NB = 4, SEQ = 4096, DM = 2048, NMETA = 16;
constexpr int M = NB * SEQ;
constexpr int LP = 4224;
constexpr int ROW_META = 112, ROW_REAL = 128;
constexpr int SR = NB * LP;
constexpr int AH = 16, HD = 64, AW = 1024;
constexpr int A2P = 3136;
constexpr int SH = 32, SP = 64, SW = 2048, SG = 4, SN = 128, CC = 3072;
constexpr int INC = 8240;
constexpr int C_Q = 0, C_K = 1024, C_V = 2048, C_F = 3072, C_Z = 3088, C_X = 5136, C_DT = 8208;
constexpr int NE = 32, TOPK = 4, FF = 2048;
constexpr float EPS = 1e-5f, LOG2E = 1.4426950408889634f, QSCALE = 0.125f * 1.4426950408889634f;
constexpr int NTHREADS = 512, NWAVES = 8;

constexpr size_t MiB = 1ull << 20;
constexpr size_t WS_CTL = 0, CTL_ZERO_BYTES = 1 * MiB;
constexpr size_t WS_XN   = 2 * MiB;
constexpr size_t WS_MX   = WS_XN;
constexpr size_t WS_Q    = WS_XN   + (size_t)(M + 256) * DM * 2;
constexpr size_t WS_K    = WS_Q    + (size_t)M * AW * 2;
constexpr size_t WS_V    = WS_K    + (size_t)(SR + 64) * AW * 2;
constexpr size_t WS_Z    = WS_V    + (size_t)(SR + 64) * AW * 2;
constexpr size_t WS_H1B  = WS_Z;
constexpr size_t WS_XBC  = WS_Z    + (size_t)M * SW * 2;
constexpr size_t WS_XC   = WS_XBC  + (size_t)SR * CC * 2;
constexpr size_t WS_FDT  = WS_XC   + (size_t)SR * CC * 2;
constexpr size_t WS_DT   = WS_FDT  + (size_t)SR * 48 * 4;
constexpr size_t WS_CF   = WS_DT   + (size_t)SR * 32 * 4;
constexpr size_t WS_O    = WS_CF   + (size_t)SR * 16 * 4;
constexpr size_t WS_YS   = WS_O    + (size_t)M * AW * 2;
constexpr size_t WS_A2   = WS_YS   + (size_t)M * SW * 2;
constexpr size_t WS_XN2  = WS_A2   + (size_t)M * A2P * 2;
constexpr size_t WS_TOKE = WS_XN2  + (size_t)M * DM * 2;
constexpr size_t WS_TOKP = WS_TOKE + (size_t)M * 4 * 4;
constexpr size_t WS_LIST = WS_TOKP + (size_t)M * 4 * 4;
constexpr size_t WS_LISTW= WS_LIST + (size_t)NE * M * 4;
constexpr int HROWS = 65536 + NE * 256;
constexpr size_t WS_H    = WS_LISTW+ (size_t)NE * M * 4;
constexpr size_t WS_Y    = WS_H    + (size_t)HROWS * FF * 2;
constexpr size_t WS_WIN  = WS_Y    + (size_t)HROWS * DM * 2;
constexpr size_t WS_WOUT = WS_WIN  + (size_t)8448 * DM * 2;
constexpr size_t WS_WGU  = WS_WOUT + (size_t)DM * A2P * 2;
constexpr size_t WS_WD   = WS_WGU  + (size_t)NE * 4096 * DM * 2;
constexpr int CFT_LD = 4352;
constexpr size_t WS_CFT  = WS_WD   + (size_t)NE * DM * FF * 2;
constexpr size_t WS_WRT  = WS_CFT  + (size_t)NB * AH * CFT_LD * 4;
constexpr size_t WS_SSQA = WS_WRT  + (size_t)NE * DM * 2;
constexpr size_t WS_SSQS = WS_SSQA + (size_t)M * 16 * 4;
constexpr size_t WS_RS   = WS_SSQS + (size_t)M * 32 * 4;
constexpr size_t WS_END  = WS_RS   + (size_t)M * 2 * 4;
constexpr int CW_BAR = 4096;
constexpr int CW_CNT = 8192;
constexpr int CW_WQ = 12288;

__device__ __forceinline__ float bf2f(bf16_t v) { return __uint_as_float((unsigned)v << 16); }
typedef float f32x2_cv __attribute__((ext_vector_type(2))); typedef __bf16 bf16x2_cv __attribute__((ext_vector_type(2)));
__device__ __forceinline__ unsigned pk2(float lo, float hi) { const f32x2_cv v = {lo, hi}; return __builtin_bit_cast(unsigned, __builtin_convertvector(v, bf16x2_cv)); }
__device__ __forceinline__ unsigned f2bf(float f) { return pk2(f, 0.f) & 0xffffu; }
__device__ __forceinline__ float wave_sum(float v) {
#pragma unroll
    for (int o = 1; o < 64; o <<= 1) v += __shfl_xor(v, o);
    return v;
}
__device__ __forceinline__ float sigmoidf_(float x) { return __builtin_amdgcn_rcpf(1.0f + __expf(-x)); }
__device__ __forceinline__ float siluf_(float x) { return x * __builtin_amdgcn_rcpf(1.0f + __expf(-x)); }
__device__ __forceinline__ float softplusf_(float x) { return x > 20.f ? x : log1pf(expf(x)); }
__device__ __forceinline__ float logsigmoidf_(float x) { return x < 0.f ? x - log1pf(expf(x)) : -log1pf(expf(-x)); }

#define XB_TMO      128
#define XB_XCNT(j)  (256  + 64 * (j))
#define XB_XSUB(j)  (1280 + 64 * (j))
#define XB_XGEN(j)  (2304 + 64 * (j))
#define XB_TOP      3328
#define XB_TOPGEN   3392
#define XCD_BAR_WORDS 3456
#define XB_SPIN_CAP (1u << 23)
__device__ __forceinline__ unsigned xb_ld(unsigned* p)              { return __hip_atomic_load(p, __ATOMIC_RELAXED, __HIP_MEMORY_SCOPE_AGENT); }
__device__ __forceinline__ unsigned xb_add(unsigned* p, unsigned v) { return __hip_atomic_fetch_add(p, v, __ATOMIC_RELAXED, __HIP_MEMORY_SCOPE_AGENT); }
__device__ __forceinline__ unsigned xb_xcc_id() { return (unsigned)__builtin_amdgcn_s_getreg((3 << 11) | 20) & 0xFu; }
#define XB_SPIN(cond, bar) do { unsigned _sp = 0; while (cond) { __builtin_amdgcn_s_sleep(1); \
    if ((++_sp & 255u) == 0u) { if (xb_ld(&(bar)[XB_TMO])) break; if (_sp > XB_SPIN_CAP) { atomicAdd(&(bar)[XB_TMO], 1u); break; } } } } while (0)
struct XcdBarrier { unsigned* bar; unsigned x; volatile LAS unsigned* st; };
__device__ __forceinline__ XcdBarrier xcd_barrier_post(unsigned* bar, volatile LAS unsigned* st) {
    XcdBarrier b; b.bar = bar; b.x = xb_xcc_id(); b.st = st;
    if (threadIdx.x == 0) (void)xb_add(&bar[XB_XCNT(b.x)], 1u);
    return b;
}
__device__ __forceinline__ void xcd_barrier_complete(unsigned* bar, unsigned x, unsigned& nloc, unsigned& nx) {
    const unsigned G = gridDim.x * gridDim.y * gridDim.z;
    unsigned sum, cnt, mine, sp = 0u;
    for (;;) {
        sum = 0u; cnt = 0u; mine = 0u;
#pragma unroll
        for (unsigned j = 0; j < 16; ++j) { const unsigned c = xb_ld(&bar[XB_XCNT(j)]); sum += c; cnt += (c > 0u) ? 1u : 0u; mine = (j == x) ? c : mine; }
        if (sum == G) break;
        __builtin_amdgcn_s_sleep(1);
        if ((++sp & 255u) == 0u) { if (xb_ld(&bar[XB_TMO])) break; if (sp > XB_SPIN_CAP) { atomicAdd(&bar[XB_TMO], 1u); break; } }
    }
    nloc = mine > 0u ? mine : 1u; nx = cnt > 0u ? cnt : 1u;
}
__device__ __forceinline__ void xcd_barrier(const XcdBarrier& b) {
    asm volatile("s_waitcnt vmcnt(0)" ::: "memory");
    __syncthreads();
    if (threadIdx.x == 0) {
        unsigned* bar = b.bar;
        __builtin_amdgcn_s_waitcnt(0);
        unsigned nloc = b.st[0], nx = b.st[1];
        if (nloc == 0u) { xcd_barrier_complete(bar, b.x, nloc, nx); b.st[0] = nloc; b.st[1] = nx; }
        const unsigned old = xb_add(&bar[XB_XSUB(b.x)], 1u);
        const unsigned gen = old / nloc;
        if (old + 1u == (gen + 1u) * nloc) {
            __builtin_amdgcn_fence(__ATOMIC_RELEASE, "agent");
            asm volatile("s_waitcnt vmcnt(0)" ::: "memory");
            const unsigned og = xb_add(&bar[XB_TOP], 1u);
            const unsigned tg = og / nx;
            if (og + 1u == (tg + 1u) * nx) xb_add(&bar[XB_TOPGEN], 1u);
            else XB_SPIN(xb_ld(&bar[XB_TOPGEN]) == tg, bar);
            __builtin_amdgcn_fence(__ATOMIC_ACQUIRE, "agent");
            xb_add(&bar[XB_XGEN(b.x)], 1u);
            asm volatile("s_waitcnt vmcnt(0)" ::: "memory");
        } else {
            XB_SPIN(xb_ld(&bar[XB_XGEN(b.x)]) == gen, bar);
            __builtin_amdgcn_fence(__ATOMIC_ACQUIRE, "agent");
            asm volatile("s_waitcnt vmcnt(0)" ::: "memory");
        }
    }
    __syncthreads();
}

struct Params { const float* in[21]; float* out; unsigned char* ws; int ph_lo, ph_hi; };
enum { I_X = 0, I_META, I_GMIX, I_WIN, I_FB, I_GATT, I_CW, I_CB, I_DTB, I_ALOG, I_DSKIP, I_GSSM, I_WOUT, I_GFFN, I_WR, I_BR, I_WGU, I_BGU, I_WD, I_BD, I_GFIN };
struct Frame {
    LAS unsigned char* lds; int tid, lane, wave, gw, NGW;
    const float* const* in; float* out; unsigned char* ws; unsigned* ctl;
};
constexpr int LDS_BYTES = 147456;
constexpr int MISC_OFF = 131072;

__device__ __forceinline__ void rmsnorm_row_bf16(const float* src, const float* gain, bf16_t* dst, int lane) {
    f32x4 v[8]; float ss = 0.f;
#pragma unroll
    for (int j = 0; j < 8; ++j) { v[j] = *(const f32x4*)(src + 4 * lane + 256 * j); ss += (v[j].x * v[j].x + v[j].y * v[j].y) + (v[j].z * v[j].z + v[j].w * v[j].w); }
    const float rstd = rsqrtf(wave_sum(ss) * (1.f / DM) + EPS);
#pragma unroll
    for (int j = 0; j < 8; ++j) { const f32x4 g = *(const f32x4*)(gain + 4 * lane + 256 * j);
        u32x2 w; w.x = pk2(v[j].x * rstd * g.x, v[j].y * rstd * g.y); w.y = pk2(v[j].z * rstd * g.z, v[j].w * rstd * g.w);
        *(u32x2*)(dst + 4 * lane + 256 * j) = w; }
}
__device__ __forceinline__ void ph0_prologue(Frame& F) {
    bf16_t* XN = (bf16_t*)(F.ws + WS_XN);
    for (int row = F.gw; row < M + 256; row += F.NGW) {
        bf16_t* dst = XN + (size_t)row * DM;
        if (row < M) rmsnorm_row_bf16(F.in[I_X] + (size_t)row * DM, F.in[I_GMIX], dst, F.lane);
        else if (row < M + NMETA) rmsnorm_row_bf16(F.in[I_META] + (size_t)(row - M) * DM, F.in[I_GMIX], dst, F.lane);
        else {
#pragma unroll
            for (int j = 0; j < 8; ++j) *(u32x2*)(dst + 4 * F.lane + 256 * j) = (u32x2){0u, 0u};
        }
    }
    const int gt = blockIdx.x * NTHREADS + F.tid, GT = gridDim.x * NTHREADS;
    for (int i = gt; i < NB * ROW_META * (AW / 8); i += GT) { const int r = i / (AW / 8), c = i % (AW / 8); const int sr = (r / ROW_META) * LP + (r % ROW_META);
        *(u32x4*)((bf16_t*)(F.ws + WS_K) + (size_t)sr * AW + c * 8) = (u32x4){0u, 0u, 0u, 0u};
        *(u32x4*)((bf16_t*)(F.ws + WS_V) + (size_t)sr * AW + c * 8) = (u32x4){0u, 0u, 0u, 0u}; }
    for (int i = gt; i < 64 * (AW / 8); i += GT) { *(u32x4*)((bf16_t*)(F.ws + WS_K) + (size_t)SR * AW + (size_t)i * 8) = (u32x4){0u, 0u, 0u, 0u}; *(u32x4*)((bf16_t*)(F.ws + WS_V) + (size_t)SR * AW + (size_t)i * 8) = (u32x4){0u, 0u, 0u, 0u}; }
    for (int i = gt; i < NB * ROW_META * (CC / 8); i += GT) { const int r = i / (CC / 8), c = i % (CC / 8); const int sr = (r / ROW_META) * LP + (r % ROW_META);
        *(u32x4*)((bf16_t*)(F.ws + WS_XBC) + (size_t)sr * CC + c * 8) = (u32x4){0u, 0u, 0u, 0u}; *(u32x4*)((bf16_t*)(F.ws + WS_XC) + (size_t)sr * CC + c * 8) = (u32x4){0u, 0u, 0u, 0u}; }
    for (int i = gt; i < NB * ROW_META * 12; i += GT) { const int r = i / 12, c = i % 12; const int sr = (r / ROW_META) * LP + (r % ROW_META);
        *(f32x4*)((float*)(F.ws + WS_FDT) + (size_t)sr * 48 + c * 4) = (f32x4){0.f, 0.f, 0.f, 0.f}; }
}


namespace pg8 {
typedef short bf16x8 __attribute__((ext_vector_type(8)));
constexpr int BM = 256, BK = 64, HALF = 128, HTB = HALF * BK * 2, STAGE_BYTES = 8 * HTB, NXCD = 8, WGM = 8;
__host__ __device__ __forceinline__ int lds_byte(int r, int c) { const int st = (r >> 4) * 2 + (c >> 5), rr = r & 15, cc = c & 31, ob = rr * 64 + cc * 2; return st * 1024 + (ob ^ (((ob >> 9) & 1) << 5)); }
__host__ __device__ __forceinline__ void stage_rc(int b, int& R, int& C) { const int st = b / 1024, sb = b % 1024, swz = sb ^ (((sb >> 9) & 1) << 5); R = (st >> 1) * 16 + swz / 64; C = (st & 1) * 32 + (swz % 64) / 2; }
__host__ __device__ __forceinline__ int perm32(int rho) { const int n = rho >> 4, i = rho & 15; return 8 * (i >> 2) + 4 * n + (i & 3); }
struct Unit { int pm, pn, e, x; };
struct StaticOrder {
    int nM, nN, nwg, G, c; const char* A; const char* Bt; size_t tstep;
    __device__ void init(const void* A_, const void* Bt_, int M_, int N_, int K_, int G_, int c_) { A = (const char*)A_; Bt = (const char*)Bt_; nM = M_ / BM; nN = N_ / BM; nwg = nM * nN; G = G_; c = c_; tstep = (size_t)BM * K_ * 2; }
    __device__ __forceinline__ bool next(int i, Unit& u) const {
        const long L = (long)i * G + c; if (L >= nwg) return false;
        int wgid = (int)L; { const int q = nwg / NXCD, r = nwg % NXCD, xcd = wgid % NXCD, off = wgid / NXCD; wgid = (xcd < r ? xcd * (q + 1) : r * (q + 1) + (xcd - r) * q) + off; }
        const int nig = WGM * nN, gid = wgid / nig, fm = gid * WGM, gsz = (nM - fm) < WGM ? (nM - fm) : WGM;
        u.pm = fm + ((wgid % nig) % gsz); u.pn = (wgid % nig) / gsz; u.e = 0; u.x = 0; return true;
    }
    __device__ __forceinline__ const char* a_base(const Unit& u) const { return A + (size_t)u.pm * tstep; }
    __device__ __forceinline__ const char* b_base(const Unit& u) const { return Bt + (size_t)u.pn * tstep; }
    __device__ __forceinline__ int a_row(const Unit&, int) const { return 0; }
};
typedef int i32x8 __attribute__((ext_vector_type(8)));
__device__ __forceinline__ i32x8 cat8(bf16x8 a, bf16x8 b) { typedef int i32x4 __attribute__((ext_vector_type(4))); const i32x4 x = __builtin_bit_cast(i32x4, a), y = __builtin_bit_cast(i32x4, b); return (i32x8){x[0], x[1], x[2], x[3], y[0], y[1], y[2], y[3]}; }
__device__ __forceinline__ unsigned pk4_fp8(float a, float b, float c, float d) { int w = __builtin_amdgcn_cvt_pk_fp8_f32(a, b, 0, false); w = __builtin_amdgcn_cvt_pk_fp8_f32(c, d, w, true); return (unsigned)w; }
__device__ __forceinline__ unsigned cvt_pk_bf16(float lo, float hi) { unsigned r; asm volatile("v_cvt_pk_bf16_f32 %0, %1, %2" : "=v"(r) : "v"(lo), "v"(hi)); return r; }

template <class Epi, class Sched, bool GATHER, bool ALIGN_EPI, bool FP8 = false>
__device__ __forceinline__ void gemm_phase(LAS unsigned char* lds, const int KB, const Sched& S, const Epi& E, const int ktiles = 0) {
    const int tid = threadIdx.x, wid = __builtin_amdgcn_readfirstlane(tid >> 6), lane = tid & 63, wr = wid >> 2, wc = wid & 3, fr = lane & 15, fq = lane >> 4;
    const int nt = ktiles ? ktiles : KB / 128;
    unsigned voffB[2], offC[2][2], offN[2][2]; int Rr[2], Cc[2];
#pragma unroll
    for (int i = 0; i < 2; ++i) { int R, C; stage_rc(tid * 16 + i * 8192, R, C); const int Rb = Epi::PERM ? ((R & ~31) + perm32(R & 31)) : R;
        voffB[i] = (unsigned)(Rb * KB + C * 2); Rr[i] = R; Cc[i] = C;
        offC[0][i] = (unsigned)(R * KB + C * 2); offC[1][i] = (unsigned)((HALF + R) * KB + C * 2); offN[0][i] = offC[0][i]; offN[1][i] = offC[1][i]; }
    const size_t kstep = (size_t)(BK * 2);
    const size_t hstep = (size_t)HALF * KB;
    const unsigned ldsw = (unsigned)wid * 1024u;
    const int aoff = lds_byte(wr * 64 + fr, fq * 8), boff = lds_byte(wc * 32 + fr, fq * 8);
#define PG8_SA(b, h) (((b) * 2 + (h)) * HTB)
#define PG8_SB(b, h) ((4 + (b) * 2 + (h)) * HTB)
#define PG8_GLDS(gp, bufoff, i) __builtin_amdgcn_global_load_lds((const unsigned*)(gp), (LAS unsigned*)(lds + (bufoff) + ldsw + (i) * 8192), 16, 0, 0)
#define PG8_STG_B(bufoff, ptr) do { PG8_GLDS((ptr) + voffB[0], bufoff, 0); PG8_GLDS((ptr) + voffB[1], bufoff, 1); } while (0)
#define PG8_STG_A(bufoff, ptr, o0, o1) do { PG8_GLDS((ptr) + (o0), bufoff, 0); PG8_GLDS((ptr) + (o1), bufoff, 1); } while (0)
#define PG8_LDA(dst, b, h) do { _Pragma("unroll") for (int m = 0; m < 4; ++m) _Pragma("unroll") for (int k = 0; k < 2; ++k) dst[m][k] = *(const LAS bf16x8*)(lds + PG8_SA(b, h) + aoff + m * 2048 + k * 1024); } while (0)
#define PG8_LDB(dst, b, h) do { _Pragma("unroll") for (int n = 0; n < 2; ++n) _Pragma("unroll") for (int k = 0; k < 2; ++k) dst[n][k] = *(const LAS bf16x8*)(lds + PG8_SB(b, h) + boff + n * 2048 + k * 1024); } while (0)
#define PG8_MMA(ai, bj, At, Bt) do { __builtin_amdgcn_s_setprio(1); _Pragma("unroll") for (int m = 0; m < 4; ++m) _Pragma("unroll") for (int n = 0; n < 2; ++n) { \
        if constexpr (FP8) { asm volatile("v_mfma_f32_16x16x128_f8f6f4 %0, %1, %2, %0" : "+v"(acc[ai][bj][m][n]) : "v"(cat8(Bt[n][0], Bt[n][1])), "v"(cat8(At[m][0], At[m][1]))); } \
        else { _Pragma("unroll") for (int k = 0; k < 2; ++k) acc[ai][bj][m][n] = __builtin_amdgcn_mfma_f32_16x16x32_bf16(Bt[n][k], At[m][k], acc[ai][bj][m][n], 0, 0, 0); } } __builtin_amdgcn_s_setprio(0); } while (0)
#define PG8_WAIT_V(n) asm volatile("s_waitcnt vmcnt(" #n ")" ::: "memory")
#define PG8_WAIT_L(n) asm volatile("s_waitcnt lgkmcnt(" #n ")" ::: "memory")
#define PG8_BAR __builtin_amdgcn_s_barrier()
#define PG8_SCHED __builtin_amdgcn_sched_barrier(0)
    Unit cur, nxt; int ui = 0;
    if (!S.next(0, cur)) return;
    bool has_next = S.next(1, nxt);
    if constexpr (GATHER) {
#pragma unroll
        for (int h = 0; h < 2; ++h)
#pragma unroll
            for (int i = 0; i < 2; ++i) { offC[h][i] = (unsigned)S.a_row(cur, h * HALF + Rr[i]) * (unsigned)KB + (unsigned)(Cc[i] * 2);
                offN[h][i] = (unsigned)S.a_row(has_next ? nxt : cur, h * HALF + Rr[i]) * (unsigned)KB + (unsigned)(Cc[i] * 2); }
        asm volatile("s_waitcnt vmcnt(0)" : "+v"(offC[0][0]), "+v"(offC[0][1]), "+v"(offC[1][0]), "+v"(offC[1][1]), "+v"(offN[0][0]), "+v"(offN[0][1]), "+v"(offN[1][0]), "+v"(offN[1][1]) :: "memory");
    }
    LAS float* mtab = (LAS float*)(lds + STAGE_BYTES + 4096);
    if constexpr (Epi::MIDSCALE) { cur.x = 0; if (tid < 256) { float f0, f1; E.row_factors(cur, tid, f0, f1); mtab[tid] = f0; mtab[256 + tid] = f1; } }
    f32x4 acc[2][2][4][2];
#pragma unroll
    for (int a = 0; a < 2; ++a)
#pragma unroll
        for (int b = 0; b < 2; ++b)
#pragma unroll
            for (int m = 0; m < 4; ++m)
#pragma unroll
                for (int n = 0; n < 2; ++n) acc[a][b][m][n] = (f32x4){0.f, 0.f, 0.f, 0.f};
    bf16x8 At[4][2], B0[2][2], B1[2][2];
    const char* cA = S.a_base(cur); const char* cB = S.b_base(cur);
    PG8_STG_B(PG8_SB(0, 0), cB); PG8_STG_B(PG8_SB(0, 1), cB + hstep); PG8_STG_A(PG8_SA(0, 0), cA, offC[0][0], offC[0][1]); PG8_STG_A(PG8_SA(0, 1), cA, offC[1][0], offC[1][1]);
    if (wr == 1) PG8_BAR;
    PG8_WAIT_V(2); PG8_BAR;
    PG8_STG_B(PG8_SB(1, 0), cB + kstep); PG8_STG_A(PG8_SA(1, 0), cA + kstep, offC[0][0], offC[0][1]); PG8_STG_B(PG8_SB(1, 1), cB + hstep + kstep);
    PG8_WAIT_V(6); PG8_BAR;
    for (;;) {
        const char* nA = has_next ? S.a_base(nxt) : cA; const char* nB = has_next ? S.b_base(nxt) : cB;
        for (int t = 0; t < nt; t += 2) {
            const bool last = (t == nt - 2);
            if constexpr (Epi::MIDSCALE) { if (t == Epi::MID_T) { float esc[8];
#pragma unroll
                for (int a = 0; a < 2; ++a)
#pragma unroll
                    for (int m = 0; m < 4; ++m) esc[4 * a + m] = mtab[(ui & 1) * 512 + a * 128 + wr * 64 + m * 16 + fr];
#pragma unroll
                for (int a = 0; a < 2; ++a)
#pragma unroll
                    for (int b = 0; b < 2; ++b)
#pragma unroll
                        for (int m = 0; m < 4; ++m)
#pragma unroll
                            for (int n = 0; n < 2; ++n) acc[a][b][m][n] *= esc[4 * a + m]; } }
            const char* a1 = cA + (size_t)(t + 1) * kstep;
            const char* a2 = last ? nA : cA + (size_t)(t + 2) * kstep; const char* b2 = last ? nB : cB + (size_t)(t + 2) * kstep;
            const char* a3 = a2 + kstep; const char* b3 = b2 + kstep;
            unsigned o00 = offC[0][0], o01 = offC[0][1], o10 = offC[1][0], o11 = offC[1][1];
            if constexpr (GATHER) { if (last) { o00 = offN[0][0]; o01 = offN[0][1]; o10 = offN[1][0]; o11 = offN[1][1]; } }
            PG8_LDB(B0, 0, 0); PG8_LDB(B1, 0, 1); PG8_SCHED; PG8_LDA(At, 0, 0); PG8_STG_A(PG8_SA(1, 1), a1, offC[1][0], offC[1][1]);
            PG8_WAIT_V(8); PG8_WAIT_L(0); PG8_BAR; PG8_MMA(0, 0, At, B0); PG8_MMA(0, 1, At, B1); PG8_BAR; PG8_SCHED;
            PG8_LDA(At, 0, 1); PG8_STG_B(PG8_SB(0, 0), b2); PG8_STG_B(PG8_SB(0, 1), b2 + hstep); PG8_STG_A(PG8_SA(0, 0), a2, o00, o01);
            PG8_WAIT_V(8); PG8_WAIT_L(0); PG8_BAR; PG8_MMA(1, 0, At, B0); PG8_MMA(1, 1, At, B1); PG8_BAR; PG8_SCHED;
            PG8_LDB(B0, 1, 0); PG8_LDB(B1, 1, 1); PG8_SCHED; PG8_LDA(At, 1, 0); PG8_STG_A(PG8_SA(0, 1), a2, o10, o11);
            PG8_WAIT_V(8); PG8_WAIT_L(0); PG8_BAR; PG8_MMA(0, 0, At, B0); PG8_MMA(0, 1, At, B1); PG8_BAR; PG8_SCHED;
            PG8_LDA(At, 1, 1); PG8_STG_B(PG8_SB(1, 0), b3); PG8_STG_B(PG8_SB(1, 1), b3 + hstep); PG8_STG_A(PG8_SA(1, 0), a3, o00, o01);
            PG8_WAIT_V(8); PG8_WAIT_L(0); PG8_BAR; PG8_MMA(1, 0, At, B0); PG8_MMA(1, 1, At, B1); PG8_BAR; PG8_SCHED;
        }
        if constexpr (ALIGN_EPI) { if (wr == 0) PG8_BAR; }
        Unit nn = nxt; bool nn_has = false;
        if (has_next) {
            nn_has = S.next(ui + 2, nn);
            if constexpr (GATHER) {
                int t2 = tid; asm volatile("" : "+v"(t2));
#pragma unroll
                for (int i = 0; i < 2; ++i) { int R, C; stage_rc(t2 * 16 + i * 8192, R, C);
#pragma unroll
                    for (int h = 0; h < 2; ++h) { offC[h][i] = offN[h][i];
                        offN[h][i] = (unsigned)S.a_row(nn_has ? nn : nxt, h * HALF + R) * (unsigned)KB + (unsigned)(C * 2); } }
            }
        }
        if constexpr (FP8) asm volatile("s_nop 15\n\ts_nop 15" ::: "memory");
        E(acc, cur, wr, wc, fr, fq);
        if (!has_next) break;
#pragma unroll
        for (int a = 0; a < 2; ++a)
#pragma unroll
            for (int b = 0; b < 2; ++b)
#pragma unroll
                for (int m = 0; m < 4; ++m)
#pragma unroll
                    for (int n = 0; n < 2; ++n) acc[a][b][m][n] = (f32x4){0.f, 0.f, 0.f, 0.f};
        cur = nxt; cA = nA; cB = nB; ++ui;
        nxt = nn; has_next = nn_has;
        if constexpr (Epi::MIDSCALE) { cur.x = ui & 1; if (tid < 256) { float f0, f1; E.row_factors(cur, tid, f0, f1); mtab[(ui & 1) * 512 + tid] = f0; mtab[(ui & 1) * 512 + 256 + tid] = f1; } }
        if constexpr (GATHER) asm volatile("s_waitcnt vmcnt(0)" : "+v"(offN[0][0]), "+v"(offN[0][1]), "+v"(offN[1][0]), "+v"(offN[1][1]) :: "memory");
        if constexpr (ALIGN_EPI) { if (wr == 1) PG8_BAR; }
    }
    PG8_WAIT_V(0);
    if constexpr (!ALIGN_EPI) { if (wr == 0) PG8_BAR; }
    PG8_BAR;
#undef PG8_SA
#undef PG8_SB
#undef PG8_GLDS
#undef PG8_STG_A
#undef PG8_STG_B
#undef PG8_LDA
#undef PG8_LDB
#undef PG8_MMA
#undef PG8_WAIT_V
#undef PG8_WAIT_L
#undef PG8_BAR
#undef PG8_SCHED
}
}

template <bool FP8, class RM>
__device__ __forceinline__ void transpose_item(const float* W, int K, int N, void* WTv, LAS float* scr, int item, int lane, RM rm, const float* kgain = nullptr, int ldk = 0) {
    const int LD = ldk ? ldk : K;
    const int nkb = K / 64, kb = item % nkb, nb = item / nkb, k0 = 64 * kb, n0 = 32 * nb;
    const bool nok = n0 + (lane & 31) < N;
    float v[32];
#pragma unroll
    for (int i = 0; i < 32; ++i) { const int kk = 2 * i + (lane >> 5); v[i] = nok ? __builtin_nontemporal_load(W + (size_t)(k0 + kk) * N + n0 + (lane & 31)) : 0.f; }
#pragma unroll
    for (int i = 0; i < 32; ++i) { const int kk = 2 * i + (lane >> 5); scr[kk * 33 + (lane & 31)] = kgain ? v[i] * kgain[k0 + kk] : v[i]; }
    asm volatile("s_waitcnt lgkmcnt(0)" ::: "memory");
    const int c = lane & 7;
#pragma unroll
    for (int j = 0; j < 4; ++j) { const int n = (lane >> 3) + 8 * j; const LAS float* s = scr + (8 * c) * 33 + n;
        if constexpr (FP8) { u32x2 o; o.x = pg8::pk4_fp8(s[0 * 33] * 64.f, s[1 * 33] * 64.f, s[2 * 33] * 64.f, s[3 * 33] * 64.f); o.y = pg8::pk4_fp8(s[4 * 33] * 64.f, s[5 * 33] * 64.f, s[6 * 33] * 64.f, s[7 * 33] * 64.f);
            if (n0 + n < N) *(u32x2*)((unsigned char*)WTv + (size_t)rm(n0 + n) * LD + k0 + 8 * c) = o; }
        else { u32x4 o; o.x = pk2(s[0 * 33], s[1 * 33]); o.y = pk2(s[2 * 33], s[3 * 33]); o.z = pk2(s[4 * 33], s[5 * 33]); o.w = pk2(s[6 * 33], s[7 * 33]);
            if (n0 + n < N) *(u32x4*)((bf16_t*)WTv + (size_t)rm(n0 + n) * LD + k0 + 8 * c) = o; } }
    asm volatile("s_waitcnt lgkmcnt(0)" ::: "memory");
}
constexpr int INC_P = 8448;
__device__ __forceinline__ int win_remap(int c) { return c < C_F ? c : c < C_Z ? 8192 + (c - C_F) : c < C_X ? 3072 + (c - C_Z) : c < C_DT ? 5120 + (c - C_X) : 8208 + (c - C_DT); }
struct MoeItem { const float* src; unsigned char* dst; int N, k0, n0, kind; };
__device__ __forceinline__ MoeItem moe_item(Frame& F, int it) {
    constexpr int I_GU = (DM / 64) * (4096 / 32), I_D = (FF / 64) * (DM / 32);
    MoeItem m;
    if (it < NE * I_GU) { const int e = it / I_GU, r = it % I_GU; m.src = F.in[I_WGU] + (size_t)e * DM * 4096; m.dst = F.ws + WS_WGU + (size_t)e * 4096 * DM; m.N = 4096; m.k0 = 64 * (r % 32); m.n0 = 32 * (r / 32); m.kind = 0; }
    else { it -= NE * I_GU; const int e = it / I_D, r = it % I_D; m.src = F.in[I_WD] + (size_t)e * FF * DM; m.dst = F.ws + WS_WD + (size_t)e * DM * FF; m.N = DM; m.k0 = 64 * (r % 32); m.n0 = 32 * (r / 32); m.kind = 1; }
    return m;
}
__device__ __forceinline__ void moe_load(float (&v)[32], const MoeItem& m, int lane) {
    const float* p = m.src + (size_t)(m.k0 + (lane >> 5)) * m.N + m.n0 + (lane & 31);
#pragma unroll
    for (int i = 0; i < 32; ++i) v[i] = __builtin_nontemporal_load(p + (size_t)(2 * i) * m.N);
}
__device__ __forceinline__ void moe_half(const float (&v)[32], LAS float* scr, int lane, int half, u32x4 (&o)[4]) {
#pragma unroll
    for (int i = 0; i < 32; ++i) scr[(2 * i + (lane >> 5)) * 33 + (lane & 31)] = v[i];
    asm volatile("s_waitcnt lgkmcnt(0)" ::: "memory");
    const int cp = lane & 7;
    if ((cp >> 2) == half) {
#pragma unroll
        for (int j = 0; j < 4; ++j) { const LAS float* s = scr + (16 * (cp & 3)) * 33 + (lane >> 3) + 8 * j;
            o[j].x = pg8::pk4_fp8(s[0 * 33] * 64.f, s[1 * 33] * 64.f, s[2 * 33] * 64.f, s[3 * 33] * 64.f); o[j].y = pg8::pk4_fp8(s[4 * 33] * 64.f, s[5 * 33] * 64.f, s[6 * 33] * 64.f, s[7 * 33] * 64.f);
            o[j].z = pg8::pk4_fp8(s[8 * 33] * 64.f, s[9 * 33] * 64.f, s[10 * 33] * 64.f, s[11 * 33] * 64.f); o[j].w = pg8::pk4_fp8(s[12 * 33] * 64.f, s[13 * 33] * 64.f, s[14 * 33] * 64.f, s[15 * 33] * 64.f); }
    }
    asm volatile("s_waitcnt lgkmcnt(0)" ::: "memory");
}
__device__ __forceinline__ void moe_store_pair(const MoeItem& m, int lane, const u32x4 (&o)[4]) {
#pragma unroll
    for (int j = 0; j < 4; ++j) { const int n = m.n0 + (lane >> 3) + 8 * j; const int row = m.kind == 0 ? ((n & 2047) >> 7) * 256 + (n >> 11) * 128 + (n & 127) : n;
        *(u32x4*)(m.dst + (size_t)row * 2048 + m.k0 + 16 * (lane & 7)) = o[j]; }
}
__device__ __forceinline__ void moe_weights(Frame& F) {
    LAS float* scr = (LAS float*)(F.lds + F.wave * 16384);
    constexpr int total = NE * ((DM / 64) * (4096 / 32) + (FF / 64) * (DM / 32)), PAIRS = total / 2;
    constexpr int N9 = ((M + 256) / 256) * (INC_P / 256) - 8 * 256, LIGHT = 352;
    int p0, p1;
    if ((int)gridDim.x == 256 && N9 > 0 && N9 < 256) {
        const int c = blockIdx.x, rest = PAIRS - N9 * LIGHT, nh = 256 - N9;
        if (c < N9) { p0 = c * LIGHT; p1 = p0 + LIGHT; } else { p0 = N9 * LIGHT + (int)((long)(c - N9) * rest / nh); p1 = N9 * LIGHT + (int)((long)(c - N9 + 1) * rest / nh); }
    } else { p0 = (int)((long)blockIdx.x * PAIRS / gridDim.x); p1 = (int)((long)(blockIdx.x + 1) * PAIRS / gridDim.x); }
    const int n = p1 - p0, g0 = p0 + F.wave * n / NWAVES, g1 = p0 + (F.wave + 1) * n / NWAVES;
    float va[32], vb[32];
    if (g0 < g1) moe_load(va, moe_item(F, 2 * g0), F.lane);
    for (int g = g0; g < g1; ++g) {
        const MoeItem ma = moe_item(F, 2 * g), mb = moe_item(F, 2 * g + 1);
        u32x4 o[4];
        moe_load(vb, mb, F.lane);
        moe_half(va, scr, F.lane, 0, o);
        if (g + 1 < g1) moe_load(va, moe_item(F, 2 * (g + 1)), F.lane);
        moe_half(vb, scr, F.lane, 1, o);
        moe_store_pair(ma, F.lane, o);
    }
    __syncthreads();
}
__device__ __forceinline__ void ph0_weights(Frame& F) {
    LAS float* scr = (LAS float*)(F.lds + F.wave * 16384);
    bf16_t* WinT = (bf16_t*)(F.ws + WS_WIN); bf16_t* WoutT = (bf16_t*)(F.ws + WS_WOUT);
    constexpr int I_IN = (DM / 64) * ((INC + 31) / 32), I_OUT = (3072 / 64) * (DM / 32);
    const int total = I_IN + I_OUT;
    for (int it0 = F.gw * 2; it0 < total; it0 += F.NGW * 2) for (int it = it0; it < it0 + 2 && it < total; ++it) {
        int r = it;
        if (r < I_IN) { transpose_item<false>(F.in[I_WIN], DM, INC, WinT, scr, r, F.lane, [](int n) { return win_remap(n); }); continue; } r -= I_IN;
        { const int k0w = 64 * (r % (3072 / 64));
          transpose_item<false>(F.in[I_WOUT], 3072, DM, WoutT, scr, r, F.lane, [](int n) { return n; }, k0w < AW ? F.in[I_GATT] : F.in[I_GSSM] - AW, A2P); }
    }
    { bf16_t* WrT = (bf16_t*)(F.ws + WS_WRT); const float* WR = F.in[I_WR];
      for (int i = blockIdx.x * NTHREADS + F.tid; i < NE * DM; i += gridDim.x * NTHREADS) { const int e = i / DM, k = i % DM; WrT[i] = (bf16_t)f2bf(WR[(size_t)k * NE + e]); } }
    const int gt = blockIdx.x * NTHREADS + F.tid, GT = gridDim.x * NTHREADS;
    for (int i = gt; i < (INC_P - INC) * (DM / 8); i += GT) *(u32x4*)(WinT + (size_t)INC * DM + (size_t)i * 8) = (u32x4){0u, 0u, 0u, 0u};
}

template <int J> __device__ __forceinline__ float conv_rowm(float cur, float prv) {
    const int ror = __builtin_amdgcn_update_dpp(0, __builtin_bit_cast(int, prv), 0x120 + J, 0xF, 0xF, false);
    return __builtin_bit_cast(float, __builtin_amdgcn_update_dpp(ror, __builtin_bit_cast(int, cur), 0x110 + J, 0xF, 0xF, false));
}
struct EpiInproj {
    static constexpr bool PERM = true, MIDSCALE = false;
    unsigned char* ws; const float* cw; const float* cb;
    __device__ __forceinline__ void conv_tile(const f32x4 (&acc)[2][2][4][2], int pn, int pm, bool meta, int wr, int wc, int fr, int fq) const {
        bf16_t* XC = (bf16_t*)(ws + WS_XC); bf16_t* XBC = (bf16_t*)(ws + WS_XBC);
#pragma unroll
        for (int bj = 0; bj < 2; ++bj) {
            const int c0 = (pn - 20) * 256 + bj * 128 + wc * 32 + 8 * fq;
            float w[4][8], bb[8];
#pragma unroll
            for (int k = 0; k < 4; ++k) { const f32x4 a = *(const f32x4*)(cw + k * CC + c0), b = *(const f32x4*)(cw + k * CC + c0 + 4); w[k][0] = a.x; w[k][1] = a.y; w[k][2] = a.z; w[k][3] = a.w; w[k][4] = b.x; w[k][5] = b.y; w[k][6] = b.z; w[k][7] = b.w; }
            { const f32x4 a = *(const f32x4*)(cb + c0), b = *(const f32x4*)(cb + c0 + 4); bb[0] = a.x; bb[1] = a.y; bb[2] = a.z; bb[3] = a.w; bb[4] = b.x; bb[5] = b.y; bb[6] = b.z; bb[7] = b.w; }
#pragma unroll
            for (int ai = 0; ai < 2; ++ai)
#pragma unroll
                for (int m = 0; m < 4; ++m) { const int r = ai * 128 + wr * 64 + m * 16 + fr;
                    float o[8], raw[8];
#pragma unroll
                    for (int i = 0; i < 8; ++i) { const float cur = acc[ai][bj][m][i >> 2][i & 3], prv = m > 0 ? acc[ai][bj][m > 0 ? m - 1 : 0][i >> 2][i & 3] : 0.f;
                        const float x1 = conv_rowm<1>(cur, prv), x2 = conv_rowm<2>(cur, prv), x3 = conv_rowm<3>(cur, prv);
                        const float a = bb[i] + w[3][i] * cur + w[2][i] * x1 + w[1][i] * x2 + w[0][i] * x3;
                        o[i] = a * __builtin_amdgcn_rcpf(1.f + __expf(-a)); raw[i] = cur; }
                    const u32x4 ov = (u32x4){pk2(o[0], o[1]), pk2(o[2], o[3]), pk2(o[4], o[5]), pk2(o[6], o[7])}, rv = (u32x4){pk2(raw[0], raw[1]), pk2(raw[2], raw[3]), pk2(raw[4], raw[5]), pk2(raw[6], raw[7])};
                    if (!meta) { const int mrow = pm * 256 + r; const size_t drow = (size_t)(mrow + ROW_REAL * ((mrow >> 12) + 1));
                        const bool head = (m == 0 && fr < 3), tail = (m == 3 && fr >= 13);
                        if (!head) *(u32x4*)(XC + drow * CC + c0) = ov;
                        if (head || tail) *(u32x4*)(XBC + drow * CC + c0) = rv; }
                    else if (r < NMETA) {
#pragma unroll
                        for (int b = 0; b < NB; ++b) *(u32x4*)(XBC + (size_t)(b * LP + ROW_META + r) * CC + c0) = rv; }
                }
        }
    }
    __device__ __forceinline__ void operator()(const f32x4 (&acc)[2][2][4][2], const pg8::Unit& u, int wr, int wc, int fr, int fq) const {
        asm volatile("" : "+v"(fr), "+v"(fq));
        const int pn = u.pn, pm = u.pm; const bool meta = pm >= M / 256;
        if (pn >= 20 && pn < 32) { conv_tile(acc, pn, pm, meta, wr, wc, fr, fq); return; }
        if (pn < 32) {
            bf16_t* base; int ld, colt; bool seq; float sc = 1.f;
            if (pn < 4) { base = (bf16_t*)(ws + WS_Q); ld = AW; colt = pn * 256; seq = false; sc = QSCALE; }
            else if (pn < 8) { base = (bf16_t*)(ws + WS_K); ld = AW; colt = (pn - 4) * 256; seq = true; }
            else if (pn < 12) { base = (bf16_t*)(ws + WS_V); ld = AW; colt = (pn - 8) * 256; seq = true; }
            else if (pn < 20) { base = (bf16_t*)(ws + WS_Z); ld = SW; colt = (pn - 12) * 256; seq = false; }
            else { base = (bf16_t*)(ws + WS_XBC); ld = CC; colt = (pn - 20) * 256; seq = true; }
            if (meta && !seq) return;
            const int col0 = colt + wc * 32 + 8 * fq;
#pragma unroll
            for (int ai = 0; ai < 2; ++ai)
#pragma unroll
                for (int m = 0; m < 4; ++m) { const int r = ai * 128 + wr * 64 + m * 16 + fr;
                    u32x4 w[2];
#pragma unroll
                    for (int bj = 0; bj < 2; ++bj) { const f32x4 v0 = acc[ai][bj][m][0] * sc, v1 = acc[ai][bj][m][1] * sc;
                        w[bj].x = pg8::cvt_pk_bf16(v0[0], v0[1]); w[bj].y = pg8::cvt_pk_bf16(v0[2], v0[3]); w[bj].z = pg8::cvt_pk_bf16(v1[0], v1[1]); w[bj].w = pg8::cvt_pk_bf16(v1[2], v1[3]); }
                    if (!meta) { const int mrow = pm * 256 + r; const size_t drow = seq ? (size_t)(mrow + ROW_REAL * ((mrow >> 12) + 1)) : (size_t)mrow;
                        bf16_t* rowp = base + drow * ld + col0; *(u32x4*)rowp = w[0]; *(u32x4*)(rowp + 128) = w[1]; }
                    else if (r < NMETA) {
#pragma unroll
                        for (int b = 0; b < NB; ++b) { bf16_t* rowp = base + (size_t)(b * LP + ROW_META + r) * ld + col0; *(u32x4*)rowp = w[0]; *(u32x4*)(rowp + 128) = w[1]; } }
                }
        } else {
            float* FDT = (float*)(ws + WS_FDT);
            const int col0 = wc * 32 + 8 * fq;
            if (col0 >= 48) return;
#pragma unroll
            for (int ai = 0; ai < 2; ++ai)
#pragma unroll
                for (int m = 0; m < 4; ++m) { const int r = ai * 128 + wr * 64 + m * 16 + fr;
                    if (!meta) { const int mrow = pm * 256 + r; float* rowp = FDT + (size_t)(mrow + ROW_REAL * ((mrow >> 12) + 1)) * 48 + col0;
                        *(f32x4*)rowp = acc[ai][0][m][0]; *(f32x4*)(rowp + 4) = acc[ai][0][m][1]; }
                    else if (r < NMETA) {
#pragma unroll
                        for (int b = 0; b < NB; ++b) { float* rowp = FDT + (size_t)(b * LP + ROW_META + r) * 48 + col0; *(f32x4*)rowp = acc[ai][0][m][0]; *(f32x4*)(rowp + 4) = acc[ai][0][m][1]; } }
                }
        }
    }
};
__device__ __forceinline__ void ph1_inproj(Frame& F) {
    pg8::StaticOrder S; S.init(F.ws + WS_XN, F.ws + WS_WIN, M + 256, INC_P, DM, gridDim.x, blockIdx.x);
    EpiInproj E{F.ws, F.in[I_CW], F.in[I_CB]};
    pg8::gemm_phase<EpiInproj, pg8::StaticOrder, false, true>(F.lds, DM * 2, S, E);
}
struct EpiOutproj {
    static constexpr bool PERM = true, MIDSCALE = true; static constexpr int MID_T = AW / 64;
    bf16_t* MX; const float* SSQA; const float* SSQS; const LAS float* tab;
    __device__ __forceinline__ void row_factors(const pg8::Unit& u, int r, float& f0, float& f1) const { const size_t m = (size_t)(u.pm * 256 + r); float sa = 0.f, ss = 0.f;
#pragma unroll
        for (int j = 0; j < 4; ++j) { const f32x4 v = *(const f32x4*)(SSQA + m * 16 + 4 * j); sa += (v.x + v.y) + (v.z + v.w); }
#pragma unroll
        for (int j = 0; j < 8; ++j) { const f32x4 v = *(const f32x4*)(SSQS + m * 32 + 4 * j); ss += (v.x + v.y) + (v.z + v.w); }
        const float ra = rsqrtf(sa * (1.f / AW) + EPS), rs = rsqrtf(ss * (1.f / SW) + EPS); f0 = ra / rs; f1 = rs; }
    __device__ __forceinline__ void operator()(const f32x4 (&acc)[2][2][4][2], const pg8::Unit& u, int wr, int wc, int fr, int fq) const {
        asm volatile("" : "+v"(fr), "+v"(fq));
        const int col0 = u.pn * 256 + wc * 32 + 8 * fq;
#pragma unroll
        for (int ai = 0; ai < 2; ++ai)
#pragma unroll
            for (int m = 0; m < 4; ++m) { const int tr = ai * 128 + wr * 64 + m * 16 + fr; bf16_t* rowp = MX + (size_t)(u.pm * 256 + tr) * DM + col0; const float rs = tab[u.x * 512 + 256 + tr];
#pragma unroll
                for (int bj = 0; bj < 2; ++bj) { const f32x4 v0 = acc[ai][bj][m][0] * rs, v1 = acc[ai][bj][m][1] * rs;
                    u32x4 w; w.x = pg8::cvt_pk_bf16(v0[0], v0[1]); w.y = pg8::cvt_pk_bf16(v0[2], v0[3]); w.z = pg8::cvt_pk_bf16(v1[0], v1[1]); w.w = pg8::cvt_pk_bf16(v1[2], v1[3]);
                    *(u32x4*)(rowp + bj * 128) = w; } }
    }
};
__device__ __forceinline__ void ph4_outproj(Frame& F) {
    pg8::StaticOrder S; S.init(F.ws + WS_A2, F.ws + WS_WOUT, M, DM, A2P, gridDim.x, blockIdx.x);
    EpiOutproj E{(bf16_t*)(F.ws + WS_MX), (const float*)(F.ws + WS_SSQA), (const float*)(F.ws + WS_SSQS), (const LAS float*)(F.lds + pg8::STAGE_BYTES + 4096)};
    pg8::gemm_phase<EpiOutproj, pg8::StaticOrder, false, true>(F.lds, A2P * 2, S, E, 3072 / 64);
}

__device__ __forceinline__ float softplus_fast(float x) { return x > 20.f ? x : __logf(1.f + __expf(x)); }
__device__ __forceinline__ float logsigmoid_fast(float x) { return x < 0.f ? x - __logf(1.f + __expf(x)) : -__logf(1.f + __expf(-x)); }
template <int PART> __device__ __forceinline__ void ph1b_conv_scan(Frame& F) {
    const bf16_t* XBC = (const bf16_t*)(F.ws + WS_XBC); bf16_t* XC = (bf16_t*)(F.ws + WS_XC);
    const float* FDT = (const float*)(F.ws + WS_FDT); float* DT = (float*)(F.ws + WS_DT); float* CF = (float*)(F.ws + WS_CF); float* CFT = (float*)(F.ws + WS_CFT);
    const float* cw = F.in[I_CW]; const float* cb = F.in[I_CB];
    const int gt = blockIdx.x * NTHREADS + F.tid, GT = gridDim.x * NTHREADS;
    constexpr int FIXB = NMETA + (SEQ / 64) * 3;
    if (PART & 1) for (int it = gt; it < NB * FIXB * (CC / 8); it += GT) {
        const int cv = it % (CC / 8), f = it / (CC / 8), b = f / FIXB, q = f % FIXB, c0 = cv * 8;
        const int pos = q < NMETA ? ROW_META + q : ROW_REAL + 64 * ((q - NMETA) / 3) + (q - NMETA) % 3; const size_t sr = (size_t)b * LP + pos;
        float acc[8];
#pragma unroll
        for (int j = 0; j < 8; ++j) acc[j] = cb[c0 + j];
#pragma unroll
        for (int k = 0; k < 4; ++k) { const u32x4 xv = *(const u32x4*)(XBC + (sr - 3 + k) * CC + c0); const unsigned xw[4] = {xv.x, xv.y, xv.z, xv.w};
#pragma unroll
            for (int j = 0; j < 8; ++j) { const float xf = __uint_as_float((j & 1) ? (xw[j >> 1] & 0xffff0000u) : (xw[j >> 1] << 16)); acc[j] += cw[k * CC + c0 + j] * xf; } }
#pragma unroll
        for (int j = 0; j < 8; ++j) acc[j] = acc[j] * __builtin_amdgcn_rcpf(1.f + __expf(-acc[j]));
        *(u32x4*)(XC + sr * CC + c0) = (u32x4){pk2(acc[0], acc[1]), pk2(acc[2], acc[3]), pk2(acc[4], acc[5]), pk2(acc[6], acc[7])};
    }
    if (PART & 2) for (int i = gt; i < SR * SH; i += GT) { const int sr = i / SH, h = i % SH, pos = sr % LP;
        DT[i] = pos >= ROW_META ? softplus_fast(FDT[(size_t)sr * 48 + 16 + h] + F.in[I_DTB][h]) : 0.f; }
    LAS float* red = (LAS float*)F.lds;
    if (PART & 2) for (int w = (int)gridDim.x - 1 - (int)blockIdx.x; w < NB * AH; w += gridDim.x) {
        const int b = w / AH, h = w % AH; const float fb = F.in[I_FB][h];
        float v[9]; float run = 0.f;
#pragma unroll
        for (int j = 0; j < 9; ++j) { const int pos = F.tid * 9 + j; float lf = 0.f;
            if (pos >= ROW_META && pos < LP) lf = logsigmoid_fast(FDT[(size_t)(b * LP + pos) * 48 + h] + fb);
            run += lf; v[j] = run; }
        float inc = run;
#pragma unroll
        for (int o = 1; o < 64; o <<= 1) { const float t = __shfl_up(inc, o); if (F.lane >= o) inc += t; }
        __syncthreads();
        if (F.lane == 63) red[F.wave] = inc;
        __syncthreads();
        float off = inc - run;
#pragma unroll
        for (int ww = 0; ww < NWAVES; ++ww) if (ww < F.wave) off += red[ww];
#pragma unroll
        for (int j = 0; j < 9; ++j) { const int pos = F.tid * 9 + j;
            if (pos < CFT_LD) CFT[(size_t)w * CFT_LD + pos] = pos < LP ? (v[j] + off) * LOG2E : 0.f; }
    }
}

namespace attn_body {
using bf16=unsigned short;
using bf16x8=__attribute__((ext_vector_type(8)))short;
using s16x4=__attribute__((ext_vector_type(4)))short;
using f32x16=__attribute__((ext_vector_type(16)))float;
using u32x4=__attribute__((ext_vector_type(4)))unsigned;
using f32x4v=__attribute__((ext_vector_type(4)))float;
constexpr int BATCH=4,NHEAD=16,SEQ=4096,D=64,DM=NHEAD*D;
constexpr int NW=8,QBLK=32,QB=QBLK*NW,KVBLK=64,NQB=SEQ/QB;
constexpr int ATTN_PITCH=DM, ATTN_UNIT_ROWS=QB;
__device__ __forceinline__ int crow(int r,int hi){return (r&3)+8*(r>>2)+4*hi;}
#define SBAR() __builtin_amdgcn_sched_barrier(0)
__device__ __forceinline__ void cmask(f32x16&p0,f32x16&p1,int jb,int qrel,int hi){
  const float NEG=-INFINITY; int kb=64*jb+4*hi;
  #pragma unroll
  for(int r=0;r<16;++r){int kv=kb+(r&3)+8*(r>>2); if(kv>qrel)p0[r]=NEG; if(kv+32>qrel)p1[r]=NEG;}
}

constexpr int NSLOT=3, SLOTB=8192;
constexpr int LDS_K=0, LDS_V=NSLOT*SLOTB, LDS_WS=2*NSLOT*SLOTB, LDS_OST=LDS_WS+NW*64*4, LDS_C2=LDS_OST+NW*4096, C2_LEN=4352, LDS_BYTES=LDS_C2+C2_LEN*4;
constexpr float C2=0.125f*1.4426950408889634f;
__device__ __forceinline__ void glds16(const void*gsrc,unsigned lds_dst){unsigned keep;
  asm volatile("s_mov_b32 %0, m0\n\ts_mov_b32 m0, %2\n\ts_nop 0\n\tglobal_load_lds_dwordx4 %1, off\n\ts_mov_b32 m0, %0":"=&s"(keep):"v"(gsrc),"s"(lds_dst):"memory");}
__device__ __forceinline__ float max3f(float a,float b,float c){float r;asm("v_max3_f32 %0, %1, %2, %3":"=v"(r):"v"(a),"v"(b),"v"(c));return r;}
__device__ __forceinline__ float max2f(float a,float b){float r;asm("v_max_f32_e32 %0, %1, %2":"=v"(r):"v"(a),"v"(b));return r;}
__device__ __forceinline__ float fadd_s(float a,float b){float r;asm("v_add_f32_e32 %0, %1, %2":"=v"(r):"v"(a),"v"(b));return r;}
__device__ __forceinline__ float fsub_s(float a,float b){float r;asm("v_sub_f32_e32 %0, %1, %2":"=v"(r):"v"(a),"v"(b));return r;}
typedef float f32x2_t __attribute__((ext_vector_type(2))); typedef __bf16 bf16x2_t __attribute__((ext_vector_type(2)));
__device__ __forceinline__ unsigned cvtpk_s(float lo,float hi){f32x2_t v={lo,hi};bf16x2_t b=__builtin_convertvector(v,bf16x2_t);return __builtin_bit_cast(unsigned,b);}
#define WAIT_BAR(N) asm volatile("s_waitcnt vmcnt(" #N ") lgkmcnt(0)\n\ts_barrier":::"memory")

__device__ __forceinline__ void qkt(f32x16&p0,f32x16&p1,const char*Kslot,const bf16x8*qr,int r32,int hi){
  const char*kb=Kslot+hi*1024+r32*16;
  #pragma unroll
  for(int d0=0;d0<4;++d0){
    const bf16x8 b0=*reinterpret_cast<const bf16x8*>(kb+d0*2048);
    const bf16x8 b1=*reinterpret_cast<const bf16x8*>(kb+d0*2048+512);
    p0=__builtin_amdgcn_mfma_f32_32x32x16_bf16(b0,qr[d0],p0,0,0,0);p1=__builtin_amdgcn_mfma_f32_32x32x16_bf16(b1,qr[d0],p1,0,0,0);}
}
typedef __attribute__((address_space(3))) const char* lds_cptr;
typedef short v4i16_t __attribute__((ext_vector_type(4)));
__device__ __forceinline__ void kload8(bf16x8*kf,lds_cptr kp){
  kf[0]=*(const __attribute__((address_space(3))) bf16x8*)(kp);      kf[1]=*(const __attribute__((address_space(3))) bf16x8*)(kp+512);
  kf[2]=*(const __attribute__((address_space(3))) bf16x8*)(kp+2048); kf[3]=*(const __attribute__((address_space(3))) bf16x8*)(kp+2560);
  kf[4]=*(const __attribute__((address_space(3))) bf16x8*)(kp+4096); kf[5]=*(const __attribute__((address_space(3))) bf16x8*)(kp+4608);
  kf[6]=*(const __attribute__((address_space(3))) bf16x8*)(kp+6144); kf[7]=*(const __attribute__((address_space(3))) bf16x8*)(kp+6656);
}
__device__ __forceinline__ void kload2(bf16x8*kf,lds_cptr kp,int j){ kf[2*j]=*(const __attribute__((address_space(3))) bf16x8*)(kp+j*2048); kf[2*j+1]=*(const __attribute__((address_space(3))) bf16x8*)(kp+j*2048+512); }
__device__ __forceinline__ s16x4 vtr(lds_cptr p){ return __builtin_bit_cast(s16x4,__builtin_amdgcn_ds_read_tr16_b64_v4i16((__attribute__((address_space(3))) v4i16_t*)p)); }
__device__ __forceinline__ float rowmax(const f32x16&p0,const f32x16&p1){
  float a=max3f(p0[0],p0[1],p1[0]),b=max3f(p0[2],p0[3],p1[1]);a=max3f(a,p1[2],p1[3]);
  #pragma unroll
  for(int r=4;r<16;r+=4){a=max3f(a,p0[r],p0[r+1]);b=max3f(b,p0[r+2],p0[r+3]);a=max3f(a,p1[r],p1[r+1]);b=max3f(b,p1[r+2],p1[r+3]);}
  const float m=max2f(a,b);
  auto rr=__builtin_amdgcn_permlane32_swap(__float_as_uint(m),__float_as_uint(m),false,false);
  return max2f(__uint_as_float(rr[0]),__uint_as_float(rr[1]));
}
__device__ __forceinline__ void pv(f32x16*o,int vb,bf16x8 pa0,bf16x8 pa1,bf16x8 pa2,bf16x8 pa3){
  #pragma unroll
  for(int d0=0;d0<2;++d0){s16x4 lo[4],hi[4];
    #pragma unroll
    for(int ks=0;ks<4;++ks){
      asm volatile("ds_read_b64_tr_b16 %0,%1 offset:%c2":"=&v"(lo[ks]):"v"(vb),"i"(d0*4096+ks*1024):"memory");
      asm volatile("ds_read_b64_tr_b16 %0,%1 offset:%c2":"=&v"(hi[ks]):"v"(vb),"i"(d0*4096+ks*1024+512):"memory");}
    asm volatile("s_waitcnt lgkmcnt(0)":::"memory");SBAR();
    #define PK(k) (bf16x8){lo[k][0],lo[k][1],lo[k][2],lo[k][3],hi[k][0],hi[k][1],hi[k][2],hi[k][3]}
    o[d0]=__builtin_amdgcn_mfma_f32_32x32x16_bf16(pa0,PK(0),o[d0],0,0,0);
    o[d0]=__builtin_amdgcn_mfma_f32_32x32x16_bf16(pa1,PK(1),o[d0],0,0,0);
    o[d0]=__builtin_amdgcn_mfma_f32_32x32x16_bf16(pa2,PK(2),o[d0],0,0,0);
    o[d0]=__builtin_amdgcn_mfma_f32_32x32x16_bf16(pa3,PK(3),o[d0],0,0,0);
    #undef PK
  }
}

#ifndef ATTN_STORE16
#define ATTN_STORE16(p,v) (*(u32x4*)(p)=(v))
#endif
constexpr int OPITCH=A2P;
template<int THRL> __device__ __forceinline__ void attn_unit(int b,int h,int qb,const bf16*Q,const bf16*__restrict__ K,const bf16*__restrict__ V,bf16*O,const float*__restrict__ CFT,float*SSQA,char*shm){
  int tid_=threadIdx.x; asm volatile("":"+v"(tid_));
  const int tid=tid_,lane=tid&63,r32=lane&31,hi=lane>>5; const int wid=__builtin_amdgcn_readfirstlane(tid>>6);
  const long rowbase=(long)b*SEQ; const long rowbase_k=(long)b*LP+64; const int q0=qb*QB;
  const bf16*Qw=Q+(rowbase+q0+wid*QBLK)*DM+h*D;
  const int NT0=(q0+QB)/KVBLK+2;
  const float*cft0=CFT+(long)(b*NHEAD+h)*C2_LEN+64;
  int t_start;
  { constexpr float SKIP_T=64.f; const float c2q0=cft0[64+q0];
    const bool n0=(lane<NT0)&&(c2q0-cft0[64*lane+63]>=-SKIP_T), n1=(lane+64<NT0)&&(c2q0-cft0[64*(lane+64)+63]>=-SKIP_T);
    const unsigned long long m0=__ballot(n0),m1=__ballot(n1);
    int tf=m0?__builtin_ctzll(m0):(m1?64+__builtin_ctzll(m1):NT0);
    tf&=~1; if(tf>NT0-6)tf=NT0-6; t_start=__builtin_amdgcn_readfirstlane(tf); }
  const bf16*Kh=K+(rowbase_k+(long)t_start*KVBLK)*DM+h*D,*Vh=V+(rowbase_k+(long)t_start*KVBLK)*DM+h*D;
  const unsigned lds0=(unsigned)(uintptr_t)shm;
  float*wsf=(float*)(shm+LDS_WS)+wid*64;
  const bf16*ksrc=Kh+(long)lane*DM+wid*8;
  const bf16*vsrc=Vh+(long)(16*(wid&3)+(lane>>2))*DM+(wid>>2)*32+(lane&3)*8;
  const unsigned kdst=lds0+LDS_K+wid*1024, vdst=lds0+LDS_V+wid*1024;
  #define DMA_K(t,slot) glds16(ksrc+(long)(t)*KVBLK*DM,(unsigned)__builtin_amdgcn_readfirstlane(kdst+(slot)))
  #define DMA_V(t,slot) glds16(vsrc+(long)(t)*KVBLK*DM,(unsigned)__builtin_amdgcn_readfirstlane(vdst+(slot)))
  const int vb0=(int)(lds0+LDS_V)+((lane>>4)&1)*32+(lane&3)*8+(4*hi+((lane&15)>>2))*64;
  const char*Kbase=shm+LDS_K; bf16x8 kf[8];
  const lds_cptr shm3=(lds_cptr)shm; const lds_cptr kp0=shm3+LDS_K+hi*1024+r32*16; const lds_cptr vp0=shm3+LDS_V+((lane>>4)&1)*32+(lane&3)*8+(4*hi+((lane&15)>>2))*64;
  const int NT=NT0-t_start;
  const float*cft=cft0+KVBLK*t_start;
  { float*c2w=(float*)(shm+LDS_C2); for(int i=tid;i<KVBLK*NT;i+=NW*64)c2w[i]=cft[i]; }
  const float cq2=cft0[64+q0+wid*QBLK+r32];
  const __attribute__((address_space(3))) f32x4v*c2p=(const __attribute__((address_space(3))) f32x4v*)(shm3+LDS_C2)+hi;
  DMA_K(0,0);DMA_V(0,0);DMA_K(1,SLOTB);
  bf16x8 qr[4];
  #pragma unroll
  for(int d0=0;d0<4;++d0)qr[d0]=*reinterpret_cast<const bf16x8*>(&Qw[(long)r32*DM+d0*16+hi*8]);
  float mhat=0.f,l_reg=0.f;f32x16 o[2];o[0]=f32x16{};o[1]=f32x16{};float cqm=cq2;
  const int qrel=wid*QBLK+r32;
  #define CMASK(P0,P1,t) do{int jb_=(t)-(NT-5); if(jb_>=0)cmask(P0,P1,jb_,qrel,hi);}while(0)
  bool resc=false;
  #define START(P0,P1) do{ const float rm=rowmax(P0,P1); resc=false; \
    { const float dl=rm; mhat=fadd_s(mhat,dl); \
      _Pragma("unroll") for(int r=0;r<16;++r){P0[r]=fsub_s(P0[r],dl);P1[r]=fsub_s(P1[r],dl);} \
      cqm=cq2-mhat; } \
    _Pragma("unroll") for(int r=0;r<16;++r)P0[r]=__builtin_amdgcn_exp2f(P0[r]); }while(0)
  #define RESC() do{ if(resc){ asm volatile("s_waitcnt lgkmcnt(0)":::"memory"); \
      _Pragma("unroll") for(int d_=0;d_<2;++d_) _Pragma("unroll") for(int r=0;r<16;++r)o[d_][r]*=wsf[crow(r,hi)]; } }while(0)
  f32x16 pA0,pA1,pB0,pB1;
  int sl_prev=0,sl_cur=0,sl_next=SLOTB;
  #define ROT() do{sl_prev=sl_cur;sl_cur=sl_next;sl_next=(sl_next==(NSLOT-1)*SLOTB)?0:sl_next+SLOTB;}while(0)
  DMA_K(2,2*SLOTB);
  WAIT_BAR(3);
  #define CINIT(P0,P1,t) do{ const __attribute__((address_space(3))) f32x4v*cp_=c2p+16*(t); \
    _Pragma("unroll") for(int g_=0;g_<4;++g_){ const f32x4v a_=cp_[2*g_], b_=cp_[2*g_+8]; \
      P0[4*g_]=cqm-a_[0];P0[4*g_+1]=cqm-a_[1];P0[4*g_+2]=cqm-a_[2];P0[4*g_+3]=cqm-a_[3]; P1[4*g_]=cqm-b_[0];P1[4*g_+1]=cqm-b_[1];P1[4*g_+2]=cqm-b_[2];P1[4*g_+3]=cqm-b_[3]; } }while(0)
  CINIT(pA0,pA1,0); qkt(pA0,pA1,Kbase,qr,r32,hi);asm volatile("s_nop 15\n\ts_nop 7":"+v"(pA0),"+v"(pA1));
  if(t_start==0){ const float NEG_=-INFINITY;
    _Pragma("unroll") for(int r=0;r<16;++r)pA0[r]=NEG_;
    _Pragma("unroll") for(int r=0;r<8;++r)pA1[r]=NEG_; }
  START(pA0,pA1);
  _Pragma("unroll") for(int r=0;r<16;++r)pA1[r]=__builtin_amdgcn_exp2f(pA1[r]);
  WAIT_BAR(0);
  DMA_K(3,0);DMA_V(1,SLOTB);
  ROT();
  kload8(kf,kp0+sl_cur);
  WAIT_BAR(2);
  s16x4 vlo[8],vhi[8]; u32x4 pw0,pw1,pw2,pw3;
  #define PKW(P,B) cvtpk_s(P[B],P[B+1])
  #define PAF(k) __builtin_bit_cast(bf16x8,pw##k)
  #define VFR(i) (bf16x8){vlo[i][0],vlo[i][1],vlo[i][2],vlo[i][3],vhi[i][0],vhi[i][1],vhi[i][2],vhi[i][3]}
  #define PIN(x) asm volatile("":"+v"(x))
  #define MX3(a,b,c) __builtin_fmaxf(__builtin_fmaxf((a),(b)),(c))
  #define GAPA(MF,A0,A1,A2,A3,W0,W1,PW) do{ MF; sacc+=A0; sacc+=A1; sacc+=A2; sacc+=A3; PIN(sacc); W0; W1; PIN(PW); SBAR(); }while(0)
  #define EX(v) __builtin_amdgcn_exp2f(v)
  #define GAPB(MF,X,B) do{ MF; X[B]=EX(X[B]); X[B+1]=EX(X[B+1]); X[B+2]=EX(X[B+2]); X[B+3]=EX(X[B+3]); PIN(X); SBAR(); }while(0)
  #define VRD(i) do{ vlo[i]=vtr(vp_+(((i)>>2)*4096+((i)&3)*1024)); vhi[i]=vtr(vp_+(((i)>>2)*4096+((i)&3)*1024+512)); }while(0)
  #define KRD(G,j) do{ if(G){ kload2(kf,kp0+sl_next,j); SBAR(); } }while(0)
  #define STEP(C0,C1,P0,P1,t,GK,GV,GL) do{ SBAR(); \
    const lds_cptr vp_=vp0+sl_prev; CINIT(C0,C1,t); SBAR(); \
    VRD(0); SBAR(); float sacc=(P0[0]+P0[1]); \
    GAPA(C0=__builtin_amdgcn_mfma_f32_32x32x16_bf16(kf[0],qr[0],C0,0,0,0), P0[2],P0[3],P0[4],P0[5],     pw0[0]=PKW(P0,0), pw0[1]=PKW(P0,2), pw0); \
    VRD(4); SBAR(); GAPA(C1=__builtin_amdgcn_mfma_f32_32x32x16_bf16(kf[1],qr[0],C1,0,0,0), P0[6],P0[7],P0[8],P0[9],     pw0[2]=PKW(P0,4), pw0[3]=PKW(P0,6), pw0); \
    VRD(1); SBAR(); GAPA(C0=__builtin_amdgcn_mfma_f32_32x32x16_bf16(kf[2],qr[1],C0,0,0,0),   P0[10],P0[11],P0[12],P0[13], pw1[0]=PKW(P0,8), pw1[1]=PKW(P0,10), pw1); \
    VRD(5); SBAR(); GAPA(C1=__builtin_amdgcn_mfma_f32_32x32x16_bf16(kf[3],qr[1],C1,0,0,0),   P0[14],P0[15],P1[0],P1[1],   pw1[2]=PKW(P0,12),pw1[3]=PKW(P0,14), pw1); \
    VRD(2); SBAR(); GAPA(C0=__builtin_amdgcn_mfma_f32_32x32x16_bf16(kf[4],qr[2],C0,0,0,0),   P1[2],P1[3],P1[4],P1[5],     pw2[0]=PKW(P1,0), pw2[1]=PKW(P1,2), pw2); \
    VRD(6); SBAR(); GAPA(C1=__builtin_amdgcn_mfma_f32_32x32x16_bf16(kf[5],qr[2],C1,0,0,0),   P1[6],P1[7],P1[8],P1[9],     pw2[2]=PKW(P1,4), pw2[3]=PKW(P1,6), pw2); \
    VRD(3); SBAR(); GAPA(C0=__builtin_amdgcn_mfma_f32_32x32x16_bf16(kf[6],qr[3],C0,0,0,0),   P1[10],P1[11],P1[12],P1[13], pw3[0]=PKW(P1,8), pw3[1]=PKW(P1,10), pw3); \
    VRD(7); SBAR(); GAPA(C1=__builtin_amdgcn_mfma_f32_32x32x16_bf16(kf[7],qr[3],C1,0,0,0),   P1[14],P1[15],0.f,0.f,       pw3[2]=PKW(P1,12),pw3[3]=PKW(P1,14), pw3); \
    l_reg+=sacc; \
    if(GK){DMA_K((t)+3,sl_cur);} if(GV){DMA_V((t)+1,sl_next);} \
    CMASK(C0,C1,t); \
    { float a=MX3(C0[0],C0[1],C1[0]),b=MX3(C0[2],C0[3],C1[1]); a=MX3(a,C1[2],C1[3]); \
      _Pragma("unroll") for(int r=4;r<16;r+=4){a=MX3(a,C0[r],C0[r+1]);b=MX3(b,C0[r+2],C0[r+3]);a=MX3(a,C1[r],C1[r+1]);b=MX3(b,C1[r+2],C1[r+3]);} \
      float rm=__builtin_fmaxf(a,b); { auto rr=__builtin_amdgcn_permlane32_swap(__float_as_uint(rm),__float_as_uint(rm),false,false); rm=__builtin_fmaxf(__uint_as_float(rr[0]),__uint_as_float(rr[1])); } \
      resc=false; \
      if(__builtin_expect(__any(rm>(float)THRL),0)){ const float dl=__builtin_fmaxf(rm,0.f); mhat+=dl; \
        _Pragma("unroll") for(int r=0;r<16;++r){C0[r]-=dl;C1[r]-=dl;} \
        cqm=cq2-mhat; \
        const float f=__builtin_amdgcn_exp2f(-dl); l_reg*=f; if(hi==0)wsf[r32]=f; resc=true; } } \
    SBAR(); \
    GAPB(o[0]=__builtin_amdgcn_mfma_f32_32x32x16_bf16(PAF(0),VFR(0),o[0],0,0,0), C0,0); \
    GAPB(o[1]=__builtin_amdgcn_mfma_f32_32x32x16_bf16(PAF(0),VFR(4),o[1],0,0,0), C0,4); \
    KRD(GL,0); GAPB(o[0]=__builtin_amdgcn_mfma_f32_32x32x16_bf16(PAF(1),VFR(1),o[0],0,0,0), C0,8); \
    KRD(GL,1); GAPB(o[1]=__builtin_amdgcn_mfma_f32_32x32x16_bf16(PAF(1),VFR(5),o[1],0,0,0), C0,12); \
    KRD(GL,2); GAPB(o[0]=__builtin_amdgcn_mfma_f32_32x32x16_bf16(PAF(2),VFR(2),o[0],0,0,0), C1,0); \
    KRD(GL,3); GAPB(o[1]=__builtin_amdgcn_mfma_f32_32x32x16_bf16(PAF(2),VFR(6),o[1],0,0,0), C1,4); \
    GAPB(o[0]=__builtin_amdgcn_mfma_f32_32x32x16_bf16(PAF(3),VFR(3),o[0],0,0,0), C1,8); \
    GAPB(o[1]=__builtin_amdgcn_mfma_f32_32x32x16_bf16(PAF(3),VFR(7),o[1],0,0,0), C1,12); \
    }while(0)
  int t=1;
  #undef CMASK
  #define CMASK(P0,P1,t) do{}while(0)
  for(;t+5<NT;t+=2){
    STEP(pB0,pB1,pA0,pA1,t,true,true,true);     WAIT_BAR(2); RESC(); ROT();
    STEP(pA0,pA1,pB0,pB1,t+1,true,true,true);   WAIT_BAR(2); RESC(); ROT();
  }
  #undef CMASK
  #define CMASK(P0,P1,t) do{int jb_=(t)-(NT-5); if(jb_>=0)cmask(P0,P1,jb_,qrel,hi);}while(0)
  #define ENDW(tt) do{ if((tt)+3<NT){WAIT_BAR(2);} else if((tt)+2<NT){WAIT_BAR(1);} else {WAIT_BAR(0);} }while(0)
  for(;t+1<NT;t+=2){
    STEP(pB0,pB1,pA0,pA1,t,(t+3<NT),(t+1<NT),(t+1<NT));       ENDW(t);   RESC(); ROT();
    STEP(pA0,pA1,pB0,pB1,t+1,(t+4<NT),(t+2<NT),(t+2<NT));     ENDW(t+1); RESC(); ROT();
  }
  STEP(pB0,pB1,pA0,pA1,NT-1,false,false,false); RESC();
  { float sacc=pB0[0]+pB0[1]; _Pragma("unroll") for(int r=2;r<16;++r)sacc+=pB0[r]; _Pragma("unroll") for(int r=0;r<16;++r)sacc+=pB1[r]; l_reg+=sacc;
    pw0=(u32x4){PKW(pB0,0),PKW(pB0,2),PKW(pB0,4),PKW(pB0,6)};pw1=(u32x4){PKW(pB0,8),PKW(pB0,10),PKW(pB0,12),PKW(pB0,14)};pw2=(u32x4){PKW(pB1,0),PKW(pB1,2),PKW(pB1,4),PKW(pB1,6)};pw3=(u32x4){PKW(pB1,8),PKW(pB1,10),PKW(pB1,12),PKW(pB1,14)};
    SBAR(); pv(o,vb0+sl_cur,PAF(0),PAF(1),PAF(2),PAF(3)); }
  #undef PKW
  #undef PAF
  #undef VFR
  #undef PIN
  #undef MX3
  #undef GAPA
  #undef GAPB
  #undef EX
  #undef VRD
  #undef KRD
  #undef STEP
  #undef ENDW
  {auto rr=__builtin_amdgcn_permlane32_swap(__float_as_uint(l_reg),__float_as_uint(l_reg),false,false);l_reg=__uint_as_float(rr[0])+__uint_as_float(rr[1]);}
  if(hi==0)wsf[32+r32]=l_reg;asm volatile("s_waitcnt lgkmcnt(0)":::"memory");
  int lane_e=lane; asm volatile("":"+v"(lane_e));
  const int r32e=lane_e&31, hie=lane_e>>5;
  float rli[16];
  #pragma unroll
  for(int r=0;r<16;++r)rli[r]=__builtin_amdgcn_rcpf(wsf[32+crow(r,hie)]);
  bf16*Ow=O+(rowbase+q0+wid*QBLK)*OPITCH+h*D;
  { bf16*stg=(bf16*)(shm+LDS_OST)+wid*2048;
    #pragma unroll
    for(int r=0;r<16;++r){const int orow=crow(r,hie);
      #pragma unroll
      for(int d0=0;d0<2;++d0)stg[orow*64+d0*32+r32e]=(bf16)f2bf(o[d0][r]*rli[r]);}
    asm volatile("s_waitcnt lgkmcnt(0)":::"memory");
    #pragma unroll
    for(int i=0;i<4;++i){const int row=i*8+(lane_e>>3),ch=lane_e&7; const u32x4 v=*(const u32x4*)(stg+row*64+ch*8); ATTN_STORE16(Ow+(long)row*OPITCH+ch*8,v);
      float s=0.f; { const unsigned w_[4]={v.x,v.y,v.z,v.w};
        _Pragma("unroll") for(int e=0;e<4;++e){const float a=__uint_as_float(w_[e]<<16),c=__uint_as_float(w_[e]&0xffff0000u); s+=a*a+c*c;} }
      s+=__builtin_bit_cast(float,__builtin_amdgcn_mov_dpp(__builtin_bit_cast(int,s),0xB1,0xF,0xF,true));
      s+=__builtin_bit_cast(float,__builtin_amdgcn_mov_dpp(__builtin_bit_cast(int,s),0x4E,0xF,0xF,true));
      s+=__builtin_bit_cast(float,__builtin_amdgcn_mov_dpp(__builtin_bit_cast(int,s),0x141,0xF,0xF,true));
      if(ch==0)SSQA[(rowbase+q0+wid*QBLK+row)*NHEAD+h]=s; } }
  asm volatile("s_waitcnt lgkmcnt(0)\n\ts_barrier":::"memory");
  #undef DMA_K
  #undef CINIT
  #undef DMA_V
  #undef CMASK
  #undef START
  #undef RESC
  #undef ROT
}
constexpr int ATTN_LDS_BYTES=LDS_BYTES;
struct AttnTensors { const bf16* Q; const bf16* K; const bf16* V; bf16* O; const float* CFT; float* SSQA; };
struct AttnUnit { int bh; int qb; };
struct StaticOrder {
  int vcu;
  __device__ __forceinline__ explicit StaticOrder(int grid,int block):vcu((block%8)*(grid/8)+block/8){}
  __device__ __forceinline__ bool next(int i,AttnUnit&u)const{ if(i>=4||vcu>=256)return false; const int s=vcu&3; u.bh=vcu>>2; u.qb=(i==0)?15-s:(i==1)?8+s:(i==2)?7-s:s; return true; }
  __device__ __forceinline__ void a_ready(const AttnUnit&)const{}
  __device__ __forceinline__ void done(const AttnUnit&)const{}
};
template<class Sched,int THRL=8> __device__ __forceinline__ void attn_phase(char*lds,const AttnTensors&T,const Sched&S){
  AttnUnit u;
  for(int i=0;S.next(i,u);++i){ S.a_ready(u); attn_unit<THRL>(u.bh/NHEAD,u.bh%NHEAD,u.qb,T.Q,T.K,T.V,T.O,T.CFT,T.SSQA,lds); S.done(u); }
}
#undef SBAR
#undef WAIT_BAR
}


namespace ssd {
typedef short bf16x8 __attribute__((ext_vector_type(8)));
typedef short s16x4 __attribute__((ext_vector_type(4)));
constexpr int CH = 64, NCH = LP / CH;
constexpr int PB = 144, PX = 160, PY = 128;
constexpr int L_CM = 0, L_BM = L_CM + 64 * 256, L_HB = L_BM + 64 * 256, L_XD = L_HB + 2 * 64 * 256, L_XW = L_XD + 64 * PX, L_MT = L_XW + 64 * PX, L_XS = L_MT + 64 * PB, L_SC = L_XS + 64 * PY, L_YT = L_SC + 2 * 1024, L_DTA = L_YT + 64 * PY, L_END = L_DTA + (NCH - 1) * CH * 4;
static_assert(L_END <= MISC_OFF, "ssd LDS map");
__device__ __forceinline__ int crow(int r, int hi) { return (r & 3) + 8 * (r >> 2) + 4 * hi; }
__device__ __forceinline__ int offb(int row, int ch) { return 256 * row + 16 * (ch ^ (((row & 3) << 2) | ((row >> 2) & 3))); }
__device__ __forceinline__ bf16x8 rowfrag_b(const LAS unsigned char* T, int row, int kk, int hi) { return *(const LAS bf16x8*)(T + offb(row, 2 * kk + hi)); }
__device__ __forceinline__ bf16x8 rowfrag_p(const LAS unsigned char* T, int row, int pitch, int kk, int hi) { return *(const LAS bf16x8*)(T + row * pitch + (16 * kk + 8 * hi) * 2); }
__device__ __forceinline__ s16x4 tr4(const LAS unsigned char* p) { return __builtin_bit_cast(s16x4, __builtin_amdgcn_ds_read_tr16_b64_v4i16((LAS s16x4*)p)); }
__device__ __forceinline__ bf16x8 trfrag_p(const LAS unsigned char* T, int pitch, int kk, int cb, int lane) {
    const int hi = lane >> 5, g16 = (lane >> 4) & 1, i = lane & 15; const LAS unsigned char* a = T + (16 * kk + 8 * hi + (i >> 2)) * pitch + (cb + 16 * g16 + 4 * (i & 3)) * 2;
    const s16x4 lo = tr4(a), hh = tr4(a + 4 * pitch); return (bf16x8){lo[0], lo[1], lo[2], lo[3], hh[0], hh[1], hh[2], hh[3]}; }
__device__ __forceinline__ bf16x8 trfrag_b(const LAS unsigned char* T, int kk, int cb, int lane) {
    const int hi = lane >> 5, g16 = (lane >> 4) & 1, i = lane & 15, r0 = 16 * kk + 8 * hi + (i >> 2), ch = (cb >> 3) + 2 * g16 + ((i & 3) >> 1), sub = 8 * (i & 1);
    const s16x4 lo = tr4(T + offb(r0, ch) + sub), hh = tr4(T + offb(r0 + 4, ch) + sub); return (bf16x8){lo[0], lo[1], lo[2], lo[3], hh[0], hh[1], hh[2], hh[3]}; }
__device__ __forceinline__ void unit(Frame& F, int b, int h) {
    LAS unsigned char* lds = F.lds;
    const int tid = F.tid, lane = F.lane, wave = F.wave, r = lane & 31, hi = lane >> 5, g = h / (SH / SG);
    const bf16_t* XC = (const bf16_t*)(F.ws + WS_XC); const float* DT = (const float*)(F.ws + WS_DT); bf16_t* A2 = (bf16_t*)(F.ws + WS_A2); const bf16_t* Zg = (const bf16_t*)(F.ws + WS_Z); float* SSQS = (float*)(F.ws + WS_SSQS);
    const float A = -expf(F.in[I_ALOG][h]), Dh = F.in[I_DSKIP][h];
#define SC_ACS(c) ((LAS float*)(lds + L_SC + ((c) & 1) * 1024))
#define SC_DT(c)  ((LAS float*)(lds + L_SC + ((c) & 1) * 1024 + 256))
#define SC_W(c)   ((LAS float*)(lds + L_SC + ((c) & 1) * 1024 + 512))
#define SC_DEC(c) ((LAS float*)(lds + L_SC + ((c) & 1) * 1024 + 768))
#define SSD_SCAN(c, dtval) do { float cs_ = (dtval) * A; \
        _Pragma("unroll") for (int o = 1; o < 64; o <<= 1) { const float t_ = __shfl_up(cs_, o); if (lane >= o) cs_ += t_; } \
        const float last_ = __shfl(cs_, 63); SC_ACS(c)[lane] = cs_; SC_DT(c)[lane] = (dtval); SC_W(c)[lane] = __expf(last_ - cs_); if (lane == 0) SC_DEC(c)[0] = __expf(last_); } while (0)
    for (int i = tid; i < 64 * 256 / 16; i += NTHREADS) *(LAS u32x4*)(lds + L_HB + i * 16) = (u32x4){0u, 0u, 0u, 0u};
    f32x16 accH[2];
#pragma unroll
    for (int i = 0; i < 16; ++i) { accH[0][i] = 0.f; accH[1][i] = 0.f; }
    const int rowBC0 = tid >> 4, chBC = tid & 15, rowX = tid >> 3, pX = (tid & 7) * 8;
    u32x4 rb[2], rc[2], rx;
    LAS float* dta = (LAS float*)(lds + L_DTA);
    for (int i = tid; i < (NCH - 1) * CH; i += NTHREADS) dta[i] = DT[((size_t)b * LP + CH + i) * SH + h];
    __syncthreads();
#define SSD_LOAD(c) do { const size_t sr0_ = (size_t)b * LP + (size_t)(c) * CH; int t_ = tid; asm volatile("" : "+v"(t_));     \
        _Pragma("unroll") for (int j = 0; j < 2; ++j) { const bf16_t* rowp = XC + (sr0_ + (t_ >> 4) + 32 * j) * CC; rb[j] = *(const u32x4*)(rowp + SW + g * SN + (t_ & 15) * 8); rc[j] = *(const u32x4*)(rowp + SW + SG * SN + g * SN + (t_ & 15) * 8); } \
        rx = *(const u32x4*)(XC + (sr0_ + (t_ >> 3)) * CC + h * SP + (t_ & 7) * 8); } while (0)
#define SSD_FLUSH(cc) do { const u32x4 yv_ = *(const LAS u32x4*)(lds + L_YT + rowX * PY + pX * 2); const size_t m_ = (size_t)b * SEQ + (size_t)((cc) * CH - ROW_REAL) + rowX; \
        const unsigned yw_[4] = {yv_.x, yv_.y, yv_.z, yv_.w}, zw_[4] = {rz.x, rz.y, rz.z, rz.w}; unsigned ow_[4]; float s_ = 0.f; \
        _Pragma("unroll") for (int e = 0; e < 4; ++e) { const float g0 = __uint_as_float(yw_[e] << 16) * siluf_(__uint_as_float(zw_[e] << 16)), g1 = __uint_as_float(yw_[e] & 0xffff0000u) * siluf_(__uint_as_float(zw_[e] & 0xffff0000u)); \
            ow_[e] = pk2(g0, g1); const float r0_ = __uint_as_float(ow_[e] << 16), r1_ = __uint_as_float(ow_[e] & 0xffff0000u); s_ += r0_ * r0_ + r1_ * r1_; } \
        *(u32x4*)(A2 + m_ * A2P + AW + h * SP + pX) = (u32x4){ow_[0], ow_[1], ow_[2], ow_[3]}; \
        s_ += __shfl_xor(s_, 1); s_ += __shfl_xor(s_, 2); s_ += __shfl_xor(s_, 4); if ((tid & 7) == 0) SSQS[m_ * SH + h] = s_; } while (0)
#define SSD_LOADZ(cc) do { rz = *(const u32x4*)(Zg + ((size_t)b * SEQ + (size_t)((cc) * CH - ROW_REAL) + rowX) * SW + h * SP + pX); } while (0)
    u32x4 rz = (u32x4){0u, 0u, 0u, 0u};
    unsigned long long pacc_ = 0, pt_ = 0;
#define SP_T0(bit) do { if ((PROBE_MASK >> (bit)) & 1) pt_ = __builtin_amdgcn_s_memrealtime(); } while (0)
#define SP_T1(bit) do { if ((PROBE_MASK >> (bit)) & 1) pacc_ += __builtin_amdgcn_s_memrealtime() - pt_; } while (0)
    if (wave == 0) SSD_SCAN(1, dta[lane]);
    __syncthreads();
    auto chunk = [&](const int c, u32x4 (&rb)[2], u32x4 (&rc)[2], u32x4& rx, u32x4& rz) {
        const int hb_old = L_HB + ((c + 1) & 1) * 64 * 256, hb_new = L_HB + (c & 1) * 64 * 256;
        SP_T0(16);
#pragma unroll
        for (int j = 0; j < 2; ++j) { const int row = rowBC0 + 32 * j; *(LAS u32x4*)(lds + L_BM + offb(row, chBC)) = rb[j]; *(LAS u32x4*)(lds + L_CM + offb(row, chBC)) = rc[j]; }
        { const float d = SC_DT(c)[rowX], dw = d * SC_W(c)[rowX]; const unsigned w[4] = {rx.x, rx.y, rx.z, rx.w}; float xf[8];
#pragma unroll
            for (int i = 0; i < 8; ++i) xf[i] = __uint_as_float((i & 1) ? (w[i >> 1] & 0xffff0000u) : (w[i >> 1] << 16));
            *(LAS u32x4*)(lds + L_XS + rowX * PY + pX * 2) = rx;
            *(LAS u32x4*)(lds + L_XD + rowX * PX + pX * 2) = (u32x4){pk2(xf[0] * d, xf[1] * d), pk2(xf[2] * d, xf[3] * d), pk2(xf[4] * d, xf[5] * d), pk2(xf[6] * d, xf[7] * d)};
            *(LAS u32x4*)(lds + L_XW + rowX * PX + pX * 2) = (u32x4){pk2(xf[0] * dw, xf[1] * dw), pk2(xf[2] * dw, xf[3] * dw), pk2(xf[4] * dw, xf[5] * dw), pk2(xf[6] * dw, xf[7] * dw)}; }
        if (c >= 3) SSD_FLUSH(c - 1);
        if (c + 1 >= 2 && c + 1 < NCH) SSD_LOADZ(c + 1);
        if (c + 2 < NCH) SSD_LOAD(c + 2);
        __syncthreads();
        SP_T1(16); SP_T0(17);
        const LAS float* acs = SC_ACS(c);
        f32x16 accy;
#pragma unroll
        for (int i = 0; i < 16; ++i) accy[i] = 0.f;
        if (wave < 4) {
            const int lt = wave >> 1, st = wave & 1, l = 32 * lt + r;
            { f32x4 cs4[4];
#pragma unroll
                for (int gq = 0; gq < 4; ++gq) cs4[gq] = *(const LAS f32x4*)(acs + 32 * st + 8 * gq + 4 * hi);
                const float cs_l = acs[l];
#pragma unroll
                for (int k0 = 0; k0 < 8; k0 += 4) { bf16x8 fa[4], fb[4];
#pragma unroll
                    for (int k = 0; k < 4; ++k) { fa[k] = rowfrag_b(lds + L_BM, 32 * st + r, k0 + k, hi); fb[k] = rowfrag_b(lds + L_CM, l, k0 + k, hi); }
#pragma unroll
                    for (int k = 0; k < 4; ++k) accy = __builtin_amdgcn_mfma_f32_32x32x16_bf16(fa[k], fb[k], accy, 0, 0, 0); }
#pragma unroll
                for (int gq = 0; gq < 4; ++gq) { const int s0 = 32 * st + 8 * gq + 4 * hi; float m[4];
#pragma unroll
                    for (int i = 0; i < 4; ++i) { const float e = __expf(fminf(cs_l - cs4[gq][i], 0.f)); m[i] = (s0 + i <= l) ? accy[4 * gq + i] * e : 0.f; }
                    *(LAS u32x2*)(lds + L_MT + l * PB + s0 * 2) = (u32x2){pk2(m[0], m[1]), pk2(m[2], m[3])}; } }
        } else {
            const int lt = (wave - 4) >> 1, pt = wave & 1;
            f32x4 cs4[4];
#pragma unroll
            for (int gq = 0; gq < 4; ++gq) cs4[gq] = *(const LAS f32x4*)(acs + 32 * lt + 8 * gq + 4 * hi);
#pragma unroll
            for (int k0 = 0; k0 < 8; k0 += 4) { bf16x8 fa[4], fb[4];
#pragma unroll
                for (int k = 0; k < 4; ++k) { fa[k] = rowfrag_b(lds + L_CM, 32 * lt + r, k0 + k, hi); fb[k] = rowfrag_b(lds + hb_old, 32 * pt + r, k0 + k, hi); }
#pragma unroll
                for (int k = 0; k < 4; ++k) accy = __builtin_amdgcn_mfma_f32_32x32x16_bf16(fa[k], fb[k], accy, 0, 0, 0); }
#pragma unroll
            for (int i = 0; i < 16; ++i) accy[i] *= __expf(cs4[i >> 2][i & 3]);
        }
        __syncthreads();
        SP_T1(17); SP_T0(18);
        if (wave >= 4) {
            const int lt = (wave - 4) >> 1, pt = wave & 1;
            { bf16x8 fa[4], fb[4];
#pragma unroll
                for (int k = 0; k < 4; ++k) { fa[k] = rowfrag_p(lds + L_MT, 32 * lt + r, PB, k, hi); fb[k] = trfrag_p(lds + L_XD, PX, k, 32 * pt, lane); }
#pragma unroll
                for (int k = 0; k < 4; ++k) accy = __builtin_amdgcn_mfma_f32_32x32x16_bf16(fa[k], fb[k], accy, 0, 0, 0); }
            if (c >= 2) {
#pragma unroll
                for (int i = 0; i < 16; ++i) { const int l = 32 * lt + crow(i, hi), p = 32 * pt + r;
                    const float xv = bf2f(*(const LAS bf16_t*)(lds + L_XS + l * PY + p * 2));
                    *(LAS bf16_t*)(lds + L_YT + l * PY + p * 2) = (bf16_t)f2bf(accy[i] + Dh * xv); }
            }
        } else {
            const int pt = wave & 1, nt0 = 2 * (wave >> 1); const float dec = SC_DEC(c)[0];
#pragma unroll
            for (int i = 0; i < 16; ++i) { accH[0][i] *= dec; accH[1][i] *= dec; }
            { bf16x8 fx[4], fn[2][4];
#pragma unroll
                for (int k = 0; k < 4; ++k) { fx[k] = trfrag_p(lds + L_XW, PX, k, 32 * pt, lane); fn[0][k] = trfrag_b(lds + L_BM, k, 32 * nt0, lane); fn[1][k] = trfrag_b(lds + L_BM, k, 32 * (nt0 + 1), lane); }
#pragma unroll
                for (int k = 0; k < 4; ++k)
#pragma unroll
                    for (int j = 0; j < 2; ++j) accH[j] = __builtin_amdgcn_mfma_f32_32x32x16_bf16(fn[j][k], fx[k], accH[j], 0, 0, 0); }
            const int p = 32 * pt + r;
#pragma unroll
            for (int j = 0; j < 2; ++j)
#pragma unroll
                for (int gq = 0; gq < 4; ++gq) { const int n0 = 32 * (nt0 + j) + 8 * gq + 4 * hi;
                    *(LAS u32x2*)(lds + hb_new + offb(p, n0 >> 3) + (n0 & 7) * 2) = (u32x2){pk2(accH[j][4 * gq], accH[j][4 * gq + 1]), pk2(accH[j][4 * gq + 2], accH[j][4 * gq + 3])}; }
            if (wave == 0 && c + 1 < NCH) SSD_SCAN(c + 1, dta[c * CH + lane]);
        }
        __syncthreads();
        SP_T1(18);
    };
    u32x4 rbB[2], rcB[2], rxB, rzO = (u32x4){0u, 0u, 0u, 0u};
    SSD_LOAD(1);
    { u32x4 (&rb)[2] = rbB; u32x4 (&rc)[2] = rcB; u32x4& rx = rxB; SSD_LOAD(2); }
    for (int c = 1; c + 1 < NCH; c += 2) { chunk(c, rb, rc, rx, rz); chunk(c + 1, rbB, rcB, rxB, rzO); }
    chunk(NCH - 1, rb, rc, rx, rz);
    { u32x4& rz = rzO;
    if (PROBE_MASK & (7 << 16)) { const unsigned long long t1_ = __builtin_amdgcn_s_memrealtime(); while (__builtin_amdgcn_s_memrealtime() - t1_ < pacc_) __builtin_amdgcn_s_sleep(8); }
    SSD_FLUSH(NCH - 1); }
    __syncthreads();
#undef SSD_FLUSH
#undef SSD_LOADZ
#undef SSD_LOAD
#undef SSD_SCAN
#undef SC_ACS
#undef SC_DT
#undef SC_W
#undef SC_DEC
}
}
constexpr int WQ_SSD = NB * SH, WQ_TOTAL = WQ_SSD + NB * AH * 16;
__device__ __forceinline__ void ph2_queue(Frame& F) {
    const attn_body::AttnTensors AT{(const bf16_t*)(F.ws + WS_Q), (const bf16_t*)(F.ws + WS_K), (const bf16_t*)(F.ws + WS_V), (bf16_t*)(F.ws + WS_A2), (const float*)(F.ws + WS_CFT), (float*)(F.ws + WS_SSQA)};
    volatile LAS unsigned* slot = (volatile LAS unsigned*)(F.lds + MISC_OFF + 64);
    for (;;) {
        if (F.tid == 0) slot[0] = __hip_atomic_fetch_add(F.ctl + CW_WQ, 1u, __ATOMIC_RELAXED, __HIP_MEMORY_SCOPE_AGENT);
        __syncthreads();
        const int u = __builtin_amdgcn_readfirstlane((int)slot[0]);
        __syncthreads();
        if (u >= WQ_SSD) break;
        ssd::unit(F, u / SH, u % SH);
    }
    unsigned nxt = 0u;
    if (F.tid == 0) nxt = __hip_atomic_fetch_add(F.ctl + CW_WQ + 64, 1u, __ATOMIC_RELAXED, __HIP_MEMORY_SCOPE_AGENT);
    for (;;) {
        if (F.tid == 0) slot[0] = nxt;
        __syncthreads();
        const int a = __builtin_amdgcn_readfirstlane((int)slot[0]);
        __syncthreads();
        if (a >= WQ_TOTAL - WQ_SSD) break;
        if (F.tid == 0) nxt = __hip_atomic_fetch_add(F.ctl + CW_WQ + 64, 1u, __ATOMIC_RELAXED, __HIP_MEMORY_SCOPE_AGENT);
        const int qb = 15 - (a >> 6), bh = a & 63;
        attn_body::attn_unit<8>(bh / AH, bh % AH, qb, AT.Q, AT.K, AT.V, AT.O, AT.CFT, AT.SSQA, (char*)F.lds);
    }
}
__device__ __forceinline__ void ph5_router(Frame& F) {
    typedef short bf16x8 __attribute__((ext_vector_type(8)));
    const float* X = F.in[I_X]; const bf16_t* MX = (const bf16_t*)(F.ws + WS_MX); unsigned char* XN2 = F.ws + WS_XN2; bf16_t* H1B = (bf16_t*)(F.ws + WS_H1B); const float* g = F.in[I_GFFN]; const float* BR = F.in[I_BR]; const bf16_t* WrT = (const bf16_t*)(F.ws + WS_WRT);
    int* TOKE = (int*)(F.ws + WS_TOKE); int* TOKP = (int*)(F.ws + WS_TOKP); int* LIST = (int*)(F.ws + WS_LIST); float* LISTW = (float*)(F.ws + WS_LISTW);
    constexpr int PITCH = DM * 2 + 16;
    LAS unsigned char* n2t = F.lds; LAS float* part = (LAS float*)(F.lds + 16 * PITCH);
    const int lane = F.lane, w = F.wave, q = lane >> 4, c16 = lane & 15;
    bf16x8 bw[8][2];
#pragma unroll
    for (int ks = 0; ks < 8; ++ks)
#pragma unroll
        for (int blk = 0; blk < 2; ++blk) bw[ks][blk] = *(const bf16x8*)(WrT + (size_t)(c16 + 16 * blk) * DM + 256 * w + 32 * ks + 8 * q);
    f32x4 gg[8];
#pragma unroll
    for (int j = 0; j < 8; ++j) gg[j] = *(const f32x4*)(g + 4 * lane + 256 * j);
    for (int it = blockIdx.x; it < M / 16; it += gridDim.x) {
        const int r0 = it * 16;
#pragma unroll
        for (int rr = 0; rr < 2; ++rr) { const int row = 2 * w + rr, m = r0 + row;
            f32x4 v[8]; float ss = 0.f;
#pragma unroll
            for (int j = 0; j < 8; ++j) { v[j] = *(const f32x4*)(X + (size_t)m * DM + 4 * lane + 256 * j); const u32x2 mw = *(const u32x2*)(MX + (size_t)m * DM + 4 * lane + 256 * j);
                v[j].x += __uint_as_float(mw.x << 16); v[j].y += __uint_as_float(mw.x & 0xffff0000u); v[j].z += __uint_as_float(mw.y << 16); v[j].w += __uint_as_float(mw.y & 0xffff0000u);
                ss += (v[j].x * v[j].x + v[j].y * v[j].y) + (v[j].z * v[j].z + v[j].w * v[j].w); }
            const float rstd = rsqrtf(wave_sum(ss) * (1.f / DM) + EPS);
#pragma unroll
            for (int j = 0; j < 8; ++j) { const float a0 = v[j].x * rstd * gg[j].x, a1 = v[j].y * rstd * gg[j].y, a2 = v[j].z * rstd * gg[j].z, a3 = v[j].w * rstd * gg[j].w;
                u32x2 o; o.x = pk2(a0, a1); o.y = pk2(a2, a3);
                *(u32x2*)(H1B + (size_t)m * DM + 4 * lane + 256 * j) = (u32x2){pk2(v[j].x, v[j].y), pk2(v[j].z, v[j].w)};
                *(unsigned*)(XN2 + (size_t)m * DM + 4 * lane + 256 * j) = pg8::pk4_fp8(a0, a1, a2, a3); *(LAS u32x2*)(n2t + row * PITCH + (4 * lane + 256 * j) * 2) = o; } }
        __syncthreads();
        f32x4 acc[2] = {(f32x4){0.f, 0.f, 0.f, 0.f}, (f32x4){0.f, 0.f, 0.f, 0.f}};
#pragma unroll
        for (int ks = 0; ks < 8; ++ks) { const bf16x8 a = *(const LAS bf16x8*)(n2t + c16 * PITCH + (256 * w + 32 * ks + 8 * q) * 2);
            acc[0] = __builtin_amdgcn_mfma_f32_16x16x32_bf16(a, bw[ks][0], acc[0], 0, 0, 0); acc[1] = __builtin_amdgcn_mfma_f32_16x16x32_bf16(a, bw[ks][1], acc[1], 0, 0, 0); }
#pragma unroll
        for (int blk = 0; blk < 2; ++blk)
#pragma unroll
            for (int i = 0; i < 4; ++i) part[(w * 16 + 4 * q + i) * 32 + 16 * blk + c16] = acc[blk][i];
        __syncthreads();
        { const int row = F.tid >> 5, e = F.tid & 31, m = r0 + row;
            float logit = BR[e];
#pragma unroll
            for (int ww = 0; ww < 8; ++ww) logit += part[(ww * 16 + row) * 32 + e];
            float tv[4]; int ti[4]; float cur = logit;
#pragma unroll
            for (int k = 0; k < 4; ++k) { float bv = cur; int bi = e;
#pragma unroll
                for (int o = 1; o < 32; o <<= 1) { const float ov = __shfl_xor(bv, o); const int oi = __shfl_xor(bi, o); if (ov > bv || (ov == bv && oi < bi)) { bv = ov; bi = oi; } }
                tv[k] = bv; ti[k] = bi; if (e == bi) cur = -INFINITY; }
            const float e1 = __expf(tv[1] - tv[0]), e2 = __expf(tv[2] - tv[0]), e3 = __expf(tv[3] - tv[0]); const float rs = 1.f / (1.f + e1 + e2 + e3);
            if (e < 4) { const int ex = e == 0 ? ti[0] : e == 1 ? ti[1] : e == 2 ? ti[2] : ti[3]; const float wg = (e == 0 ? 1.f : e == 1 ? e1 : e == 2 ? e2 : e3) * rs;
                const int pos = (int)__hip_atomic_fetch_add(F.ctl + CW_CNT + 64 * ex, 1u, __ATOMIC_RELAXED, __HIP_MEMORY_SCOPE_AGENT);
                TOKE[m * 4 + e] = ex; TOKP[m * 4 + e] = pos; LIST[(size_t)ex * M + pos] = m; LISTW[(size_t)ex * M + pos] = wg; } }
    }
}

constexpr int TAB_OFF = MISC_OFF + 256;
__device__ __forceinline__ void load_expert_tables(Frame& F, LAS int* tab) {
    __syncthreads();
    if (F.tid == 0) { int rb = 0, tb = 0, t2 = 0;
        for (int e = 0; e < NE; ++e) { const int c = (int)__hip_atomic_load(F.ctl + CW_CNT + 64 * e, __ATOMIC_RELAXED, __HIP_MEMORY_SCOPE_AGENT);
            tab[e] = c; tab[32 + e] = rb; tab[64 + e] = tb; tab[128 + e] = t2; rb += ((c + 255) / 256) * 256; tb += (c + 63) / 64; t2 += (c + 255) / 256; }
        tab[96] = tb; tab[160] = t2; }
    __syncthreads();
}
constexpr float YSCALE = 32.f, YSCALE_INV = 1.f / 32.f;
constexpr float WSCALE = 64.f, WSCALE_INV = 1.f / 64.f;
struct GroupedOrder {
    const LAS int* tab; int NT, G, c, nwg; const char* A; const char* W; size_t wstride, tstep; const int* LIST; bool gather;
    __device__ __forceinline__ bool next(int i, pg8::Unit& u) const {
        const int L = i * G + c; if (L >= nwg) return false;
        int wgid = L; { const int q = nwg / 8, r = nwg % 8, xcd = wgid % 8, off = wgid / 8; wgid = (xcd < r ? xcd * (q + 1) : r * (q + 1) + (xcd - r) * q) + off; }
        int e = 0;
        for (int k = 1; k < NE; ++k) if (tab[128 + k] * NT <= wgid) e = k;
        e = __builtin_amdgcn_readfirstlane(e);
        const int t0 = __builtin_amdgcn_readfirstlane(tab[128 + e]), t1 = __builtin_amdgcn_readfirstlane(tab[128 + e + 1]);
        const int idx = wgid - t0 * NT, tiles = t1 - t0;
        u.x = idx % tiles; u.pn = idx / tiles; u.e = e; u.pm = t0 + u.x; return true;
    }
    __device__ __forceinline__ const char* a_base(const pg8::Unit& u) const { return gather ? A : A + (size_t)u.pm * tstep; }
    __device__ __forceinline__ const char* b_base(const pg8::Unit& u) const { return W + (size_t)u.e * wstride + (size_t)u.pn * tstep; }
    __device__ __forceinline__ int a_row(const pg8::Unit& u, int R) const { const int cnt = __builtin_amdgcn_readfirstlane(tab[u.e]); int pos = u.x * 256 + R; pos = pos < cnt ? pos : cnt - 1; return LIST[(size_t)u.e * M + pos]; }
};
struct EpiGateUp {
    static constexpr bool PERM = true, MIDSCALE = false;
    unsigned char* H; const float* Bgu;
    __device__ __forceinline__ void operator()(const f32x4 (&acc)[2][2][4][2], const pg8::Unit& u, int wr, int wc, int fr, int fq) const {
        asm volatile("" : "+v"(fr), "+v"(fq));
        const int j0 = u.pn * 128 + wc * 32 + 8 * fq; const float* bg = Bgu + (size_t)u.e * 4096 + j0;
        const f32x4 bg0 = *(const f32x4*)bg, bg1 = *(const f32x4*)(bg + 4), bu0 = *(const f32x4*)(bg + 2048), bu1 = *(const f32x4*)(bg + 2052);
#pragma unroll
        for (int ai = 0; ai < 2; ++ai)
#pragma unroll
            for (int m = 0; m < 4; ++m) { const int r = ai * 128 + wr * 64 + m * 16 + fr; float h[8];
#pragma unroll
                for (int n = 0; n < 2; ++n) { const f32x4 gv = acc[ai][0][m][n] * WSCALE_INV + (n ? bg1 : bg0), uv = acc[ai][1][m][n] * WSCALE_INV + (n ? bu1 : bu0);
#pragma unroll
                    for (int i = 0; i < 4; i += 2) { f32x2_cv g = {fminf(gv[i], 7.f), fminf(gv[i + 1], 7.f)}, uu = {fminf(fmaxf(uv[i], -7.f), 7.f), fminf(fmaxf(uv[i + 1], -7.f), 7.f)};
                        const f32x2_cv t = g * (-1.702f * LOG2E); f32x2_cv e = {__builtin_amdgcn_exp2f(t.x), __builtin_amdgcn_exp2f(t.y)}; e = e + 1.0f;
                        const f32x2_cv rr = {__builtin_amdgcn_rcpf(e.x), __builtin_amdgcn_rcpf(e.y)}; const f32x2_cv hv = (g * rr) * (uu + 1.0f);
                        h[4 * n + i] = hv.x; h[4 * n + i + 1] = hv.y; } }
                u32x2 w; w.x = pg8::pk4_fp8(h[0], h[1], h[2], h[3]); w.y = pg8::pk4_fp8(h[4], h[5], h[6], h[7]);
                *(u32x2*)(H + (size_t)(u.pm * 256 + r) * FF + j0) = w; }
    }
};
__device__ __forceinline__ void ph6_gateup(Frame& F) {
    LAS int* tab = (LAS int*)(F.lds + TAB_OFF);
    load_expert_tables(F, tab);
    GroupedOrder S{tab, 16, (int)gridDim.x, (int)blockIdx.x, __builtin_amdgcn_readfirstlane(tab[160]) * 16, (const char*)(F.ws + WS_XN2), (const char*)(F.ws + WS_WGU), (size_t)4096 * DM, (size_t)256 * DM, (const int*)(F.ws + WS_LIST), true};
    EpiGateUp E{F.ws + WS_H, F.in[I_BGU]};
    pg8::gemm_phase<EpiGateUp, GroupedOrder, true, true, true>(F.lds, DM, S, E);
}
struct EpiDown {
    static constexpr bool PERM = true, MIDSCALE = false;
    unsigned char* Y; const float* Bd; const float* LISTW;
    __device__ __forceinline__ void operator()(const f32x4 (&acc)[2][2][4][2], const pg8::Unit& u, int wr, int wc, int fr, int fq) const {
        asm volatile("" : "+v"(fr), "+v"(fq));
        const int col0 = u.pn * 256 + wc * 32 + 8 * fq; const float* bd = Bd + (size_t)u.e * DM + col0;
        f32x4 bv[2][2];
#pragma unroll
        for (int bj = 0; bj < 2; ++bj)
#pragma unroll
            for (int n = 0; n < 2; ++n) bv[bj][n] = *(const f32x4*)(bd + bj * 128 + 4 * n);
#pragma unroll
        for (int ai = 0; ai < 2; ++ai)
#pragma unroll
            for (int m = 0; m < 4; ++m) { const int r = ai * 128 + wr * 64 + m * 16 + fr; const float gw = LISTW[(size_t)u.e * M + u.x * 256 + r];
                unsigned char* rowp = Y + (size_t)(u.pm * 256 + r) * DM + col0; const float gs = gw * YSCALE;
#pragma unroll
                for (int bj = 0; bj < 2; ++bj) { const f32x4 v0 = (acc[ai][bj][m][0] * WSCALE_INV + bv[bj][0]) * gs, v1 = (acc[ai][bj][m][1] * WSCALE_INV + bv[bj][1]) * gs;
                    u32x2 w; w.x = pg8::pk4_fp8(v0[0], v0[1], v0[2], v0[3]); w.y = pg8::pk4_fp8(v1[0], v1[1], v1[2], v1[3]);
                    *(u32x2*)(rowp + bj * 128) = w; } }
    }
};
__device__ __forceinline__ void ph7_down(Frame& F) {
    LAS int* tab = (LAS int*)(F.lds + TAB_OFF);
    load_expert_tables(F, tab);
    GroupedOrder S{tab, 8, (int)gridDim.x, (int)blockIdx.x, __builtin_amdgcn_readfirstlane(tab[160]) * 8, (const char*)(F.ws + WS_H), (const char*)(F.ws + WS_WD), (size_t)DM * FF, (size_t)256 * FF, nullptr, false};
    EpiDown E{F.ws + WS_Y, F.in[I_BD], (const float*)(F.ws + WS_LISTW)};
    pg8::gemm_phase<EpiDown, GroupedOrder, false, true, true>(F.lds, FF, S, E);
}


__device__ __forceinline__ void ph8_final(Frame& F) {
    const bf16_t* H1B = (const bf16_t*)(F.ws + WS_H1B); float* OUT = F.out; const unsigned char* Y = F.ws + WS_Y;
    const int* TOKE = (const int*)(F.ws + WS_TOKE); const int* TOKP = (const int*)(F.ws + WS_TOKP); const float* g = F.in[I_GFIN];
    LAS int* tab = (LAS int*)(F.lds + TAB_OFF);
    load_expert_tables(F, tab);
    for (int m = F.gw; m < M; m += F.NGW) {
        size_t rows[4];
#pragma unroll
        for (int k = 0; k < 4; ++k) rows[k] = (size_t)(tab[32 + TOKE[m * 4 + k]] + TOKP[m * 4 + k]);
        f32x4 v[8]; float ss = 0.f;
#pragma unroll
        for (int j = 0; j < 8; ++j) { const int c = 4 * F.lane + 256 * j; v[j] = (f32x4){0.f, 0.f, 0.f, 0.f}; const u32x2 mw = *(const u32x2*)(H1B + (size_t)m * DM + c);
            f32x4 ys = (f32x4){0.f, 0.f, 0.f, 0.f};
#pragma unroll
            for (int k = 0; k < 4; ++k) { const int w = *(const int*)(Y + rows[k] * DM + c); const auto lo = __builtin_amdgcn_cvt_pk_f32_fp8(w, false), hi = __builtin_amdgcn_cvt_pk_f32_fp8(w, true);
                ys.x += lo[0]; ys.y += lo[1]; ys.z += hi[0]; ys.w += hi[1]; }
            v[j].x += __uint_as_float(mw.x << 16) + ys.x * YSCALE_INV; v[j].y += __uint_as_float(mw.x & 0xffff0000u) + ys.y * YSCALE_INV;
            v[j].z += __uint_as_float(mw.y << 16) + ys.z * YSCALE_INV; v[j].w += __uint_as_float(mw.y & 0xffff0000u) + ys.w * YSCALE_INV;
            ss += (v[j].x * v[j].x + v[j].y * v[j].y) + (v[j].z * v[j].z + v[j].w * v[j].w); }
        const float rstd = rsqrtf(wave_sum(ss) * (1.f / DM) + EPS);
#pragma unroll
        for (int j = 0; j < 8; ++j) { const int c = 4 * F.lane + 256 * j; const f32x4 gg = *(const f32x4*)(g + c);
            *(f32x4*)(OUT + (size_t)m * DM + c) = (f32x4){v[j].x * rstd * gg.x, v[j].y * rstd * gg.y, v[j].z * rstd * gg.z, v[j].w * rstd * gg.w}; }
    }
}

constexpr int NPHASES = 10;
__global__ void __launch_bounds__(NTHREADS, 2) fwd(Params p) {
    extern __shared__ __attribute__((aligned(16))) unsigned char lds_raw[];
    Frame F;
    F.lds = (LAS unsigned char*)lds_raw;
    F.tid = threadIdx.x; F.lane = F.tid & 63; F.wave = __builtin_amdgcn_readfirstlane(F.tid >> 6);
    F.gw = blockIdx.x * NWAVES + F.wave; F.NGW = gridDim.x * NWAVES;
    F.in = p.in; F.out = p.out; F.ws = p.ws; F.ctl = (unsigned*)(p.ws + WS_CTL);
    volatile LAS unsigned* MISC = (volatile LAS unsigned*)(F.lds + MISC_OFF);
    if (F.tid < 32) MISC[F.tid] = 0u;
    __syncthreads();
    const int lo = p.ph_lo, hi = p.ph_hi;
    XcdBarrier bar; bar.bar = F.ctl + CW_BAR; bar.x = 0; bar.st = nullptr;
    if (hi - lo > 1) bar = xcd_barrier_post(F.ctl + CW_BAR, MISC + 8);
#define IN(k) (lo <= (k) && (k) < hi)
#ifndef PROBE_MASK
#define PROBE_MASK 0
#endif
    unsigned long long pt0_ = 0;
#define PSTART(k) do { if ((PROBE_MASK >> (k)) & 1) pt0_ = __builtin_amdgcn_s_memrealtime(); } while (0)
#define PEND(k) do { if ((PROBE_MASK >> (k)) & 1) { const unsigned long long t1_ = __builtin_amdgcn_s_memrealtime(); while (__builtin_amdgcn_s_memrealtime() - t1_ < t1_ - pt0_) __builtin_amdgcn_s_sleep(8); } } while (0)
#define SEAM(k) do { if (IN(k) && IN((k) + 1)) xcd_barrier(bar); } while (0)
    if (IN(0)) { PSTART(0); ph0_prologue(F); ph0_weights(F); PEND(0); } SEAM(0);
    if (IN(1)) { PSTART(1); { const bool conv_first = (blockIdx.x & 1) != 0; if (conv_first) moe_weights(F); ph1_inproj(F); if (!conv_first) moe_weights(F); } PEND(1); } SEAM(1);
    if (IN(2)) { PSTART(2); PSTART(14); ph1b_conv_scan<1>(F); PEND(14); PSTART(15); ph1b_conv_scan<2>(F); PEND(15); PEND(2); } SEAM(2);
    if (IN(3)) { PSTART(3); ph2_queue(F); PEND(3); } if (IN(3) && IN(5)) xcd_barrier(bar);
    if (IN(5)) { PSTART(5); ph4_outproj(F); PEND(5); } SEAM(5);
    if (IN(6)) { PSTART(6); ph5_router(F); PEND(6); } SEAM(6);
    if (IN(7)) { PSTART(7); ph6_gateup(F); PEND(7); } SEAM(7);
    if (IN(8)) { PSTART(8); ph7_down(F); PEND(8); } SEAM(8);
    if (IN(9)) { PSTART(9); ph8_final(F); PEND(9); }
#undef IN
#undef SEAM
}

extern "C" void kernel_launch(void* const* d_in, const int* in_sizes, int n_in, void* d_out, int out_size, void* d_ws, size_t ws_size, hipStream_t stream) {
    static int grid = 0;
    if (grid == 0) {
        if (n_in != 21 || out_size != M * DM || ws_size < WS_END) { fprintf(stderr, "kernel_launch: unexpected shapes (n_in %d, out %d, ws %zu < %zu)\n", n_in, out_size, ws_size, (size_t)WS_END); grid = -1; return; }
        int dev = 0, cus = 0, per_cu = 0;
        if (hipGetDevice(&dev) != hipSuccess || hipDeviceGetAttribute(&cus, hipDeviceAttributeMultiprocessorCount, dev) != hipSuccess) { grid = -1; return; }
        if (hipFuncSetAttribute((const void*)fwd, hipFuncAttributeMaxDynamicSharedMemorySize, LDS_BYTES) != hipSuccess) { fprintf(stderr, "kernel_launch: hipFuncSetAttribute failed\n"); grid = -1; return; }
        if (hipOccupancyMaxActiveBlocksPerMultiprocessor(&per_cu, (const void*)fwd, NTHREADS, LDS_BYTES) != hipSuccess || per_cu < 1) fprintf(stderr, "kernel_launch: occupancy query says %d\n", per_cu);
        (void)hipGetLastError();
        grid = cus;
    }
    if (grid < 0) return;
    (void)hipMemsetAsync((char*)d_ws + WS_CTL, 0, CTL_ZERO_BYTES, stream);
    Params p{};
    for (int i = 0; i < 21; ++i) p.in[i] = (const float*)d_in[i];
    p.out = (float*)d_out; p.ws = (unsigned char*)d_ws;
#if MK_ONE_LAUNCH
    p.ph_lo = 0; p.ph_hi = NPHASES;
    hipLaunchKernelGGL(fwd, dim3(grid), dim3(NTHREADS), LDS_BYTES, stream, p);
#else
    for (int k = 0; k < NPHASES; ++k) { p.ph_lo = k; p.ph_hi = k + 1; hipLaunchKernelGGL(fwd, dim3(grid), dim3(NTHREADS), LDS_BYTES, stream, p); }
#endif
}
```
